# Optimizing an MI355X kernel written in HIP

```python
import jax, jax.numpy as jnp
from jax import lax
import numpy as np

D_MODEL = 2048
BATCH = 2
SEQ = 8192
DEPTH = 4

CHUNK = 64
EPS = 1e-6
POOL_WIDTH = D_MODEL // 2
POOL_GROUPS = 4
POOL_GROUP_DIM = POOL_WIDTH // POOL_GROUPS
POOL_WINDOWS = (2, 4, 8, 16)
RET_HEADS = 4
RET_HEAD_DIM = D_MODEL // 2 // RET_HEADS
RET_WIDTH = RET_HEADS * RET_HEAD_DIM
EVEN_IN_WIDTH = POOL_WIDTH + 4 * RET_WIDTH
ROPE_BASE = 10000.0
CONV_WIDTH = 3
CONV_DIM = D_MODEL
FFN_DIM = 5632
N_EXPERTS = 8
TOP_K = 2
EXPERT_DIM = FFN_DIM // TOP_K
N_EVEN = (DEPTH + 1) // 2
N_ODD = DEPTH // 2

kernel_name = "hybrid_pool_retention_shortconv_moe"


def rmsnorm(x, g):
    xf = x.astype(jnp.float32)
    y = xf * lax.rsqrt(jnp.mean(xf * xf, axis=-1, keepdims=True) + EPS)
    return (y * g.astype(jnp.float32)).astype(x.dtype)


def pool_mixer(u, w_pool, scale):
    b, s, _ = u.shape
    uf = u.astype(jnp.float32)
    cs = jnp.pad(jnp.cumsum(uf, axis=1), ((0, 0), (1, 0), (0, 0)))
    t = jnp.arange(s)
    outs = []
    for g, w in enumerate(POOL_WINDOWS):
        c = cs[..., g * POOL_GROUP_DIM:(g + 1) * POOL_GROUP_DIM]
        c_lo = jnp.pad(c, ((0, 0), (w - 1, 0), (0, 0)))[:, :s]
        count = jnp.minimum(t + 1, w).astype(jnp.float32)[None, :, None]
        mean = (c[:, 1:] - c_lo) / count
        outs.append(mean - uf[..., g * POOL_GROUP_DIM:(g + 1) * POOL_GROUP_DIM])
    p = jnp.stack(outs, axis=2).astype(u.dtype)
    y = jnp.einsum('bsgc,gcd->bsgd', p, w_pool).reshape(b, s, POOL_WIDTH)
    return y * scale


def rope(x, pos):
    half = x.shape[-1] // 2
    inv = ROPE_BASE ** (-jnp.arange(half, dtype=jnp.float32) / half)
    ang = pos.astype(jnp.float32)[:, None] * inv[None, :]
    cos = jnp.cos(ang)[None, :, None, :]
    sin = jnp.sin(ang)[None, :, None, :]
    x1, x2 = x[..., :half], x[..., half:]
    return jnp.concatenate([x1 * cos - x2 * sin, x2 * cos + x1 * sin], axis=-1)


def retention(q, k, v):
    b, s, h, dk = q.shape
    dv = v.shape[-1]
    nc = s // CHUNK
    log_g = jnp.log(1.0 - 2.0 ** (-5.0 - jnp.arange(h, dtype=jnp.float32)))
    idx = jnp.arange(CHUNK, dtype=jnp.float32)
    intra = jnp.exp(log_g[:, None, None] * jnp.abs(idx[:, None] - idx[None, :]))
    q_decay = jnp.exp(log_g[:, None] * (idx + 1.0))[None, :, :, None]
    k_decay = jnp.exp(log_g[:, None] * (CHUNK - 1.0 - idx))[None, :, :, None]
    chunk_decay = jnp.exp(log_g * CHUNK)[None, :, None, None]

    def to_chunks(a):
        return a.reshape(b, nc, CHUNK, h, a.shape[-1]).transpose(1, 0, 3, 2, 4)

    qc = to_chunks(q) * (dk ** -0.5)
    kc = to_chunks(k)
    vc = to_chunks(v)

    def step(state, inp):
        qi, ki, vi = inp
        scores = jnp.einsum('bhid,bhjd->bhij', qi, ki) * intra
        o = (jnp.einsum('bhij,bhjd->bhid', scores, vi)
             + jnp.einsum('bhid,bhde->bhie', qi * q_decay, state))
        state = state * chunk_decay + jnp.einsum('bhjd,bhje->bhde', ki * k_decay, vi)
        return state, o

    state0 = jnp.zeros((b, h, dk, dv), jnp.float32)
    _, o = lax.scan(step, state0, (qc, kc, vc))
    return o.transpose(1, 0, 3, 2, 4).reshape(b, s, h, dv)


def head_groupnorm(o):
    mu = jnp.mean(o, axis=-1, keepdims=True)
    var = jnp.mean(jnp.square(o - mu), axis=-1, keepdims=True)
    return (o - mu) * lax.rsqrt(var + 1e-5)


def even_mixer(xn, w_in, w_pool, pool_scale, w_out, pos):
    b, s, _ = xn.shape
    proj = xn @ w_in
    u, q, k, v, g = jnp.split(
        proj, [POOL_WIDTH, POOL_WIDTH + RET_WIDTH, POOL_WIDTH + 2 * RET_WIDTH,
               POOL_WIDTH + 3 * RET_WIDTH], axis=-1)
    y_pool = pool_mixer(u, w_pool, pool_scale)
    heads = lambda a: a.astype(jnp.float32).reshape(b, s, RET_HEADS, RET_HEAD_DIM)
    qh = rope(heads(q), pos)
    kh = rope(heads(k), pos)
    o = head_groupnorm(retention(qh, kh, heads(v))).reshape(b, s, RET_WIDTH)
    y_ret = (o * jax.nn.silu(g.astype(jnp.float32))).astype(xn.dtype)
    return jnp.concatenate([y_pool, y_ret], axis=-1) @ w_out


def short_conv_mixer(xn, w_in, conv_w, w_out):
    s = xn.shape[1]
    bg, cg, hx = jnp.split(xn @ w_in, 3, axis=-1)
    z = cg * hx
    zp = jnp.pad(z, ((0, 0), (CONV_WIDTH - 1, 0), (0, 0)))
    conv = zp[:, 0:s] * conv_w[0]
    for i in range(1, CONV_WIDTH):
        conv = conv + zp[:, i:i + s] * conv_w[i]
    return (bg * conv) @ w_out


def swiglu(x, w_gu, w_down):
    gate, up = jnp.split(x @ w_gu, 2, axis=-1)
    return (jax.nn.silu(gate) * up) @ w_down


def moe_swiglu(xn, router, w_gu, w_down):
    b, s, d = xn.shape
    t = xn.reshape(b * s, d)
    logits = (t @ router).astype(jnp.float32)
    top_val, top_idx = lax.top_k(logits, TOP_K)
    weights = jax.nn.softmax(top_val, axis=-1)
    gate = jnp.sum(jax.nn.one_hot(top_idx, N_EXPERTS, dtype=jnp.float32)
                   * weights[..., None], axis=1).astype(t.dtype)
    y = jnp.zeros_like(t)
    for e in range(N_EXPERTS):
        y = y + gate[:, e:e + 1] * swiglu(t, w_gu[e], w_down[e])
    return y.reshape(b, s, d)


def setup_inputs(seed: int = 0) -> dict:
    key = jax.random.key(seed)
    ks = jax.random.split(key, 20)
    f32 = jnp.float32

    def w(k, shape, fan_in):
        return jax.random.normal(k, shape, f32) * (fan_in ** -0.5)

    def gain(k, shape):
        return 1.0 + 0.02 * jax.random.normal(k, shape, f32)

    return {
        "x": jax.random.normal(ks[0], (BATCH, SEQ, D_MODEL), f32),
        "norm_mix": gain(ks[1], (DEPTH, D_MODEL)),
        "norm_ffn": gain(ks[2], (DEPTH, D_MODEL)),
        "norm_final": gain(ks[3], (D_MODEL,)),
        "ev_w_in": w(ks[4], (N_EVEN, D_MODEL, EVEN_IN_WIDTH), D_MODEL),
        "ev_pool_w": w(ks[5], (N_EVEN, POOL_GROUPS, POOL_GROUP_DIM, POOL_GROUP_DIM), POOL_GROUP_DIM),
        "ev_pool_scale": gain(ks[6], (N_EVEN, POOL_WIDTH)),
        "ev_w_out": w(ks[7], (N_EVEN, POOL_WIDTH + RET_WIDTH, D_MODEL), POOL_WIDTH + RET_WIDTH),
        "od_w_in": w(ks[8], (N_ODD, D_MODEL, 3 * CONV_DIM), D_MODEL),
        "od_conv_w": w(ks[9], (N_ODD, CONV_WIDTH, CONV_DIM), CONV_WIDTH),
        "od_w_out": w(ks[10], (N_ODD, CONV_DIM, D_MODEL), CONV_DIM),
        "ffn_w_gu": w(ks[11], (N_EVEN, D_MODEL, 2 * FFN_DIM), D_MODEL),
        "ffn_w_down": w(ks[12], (N_EVEN, FFN_DIM, D_MODEL), FFN_DIM),
        "moe_router": w(ks[13], (N_ODD, D_MODEL, N_EXPERTS), D_MODEL),
        "moe_w_gu": w(ks[14], (N_ODD, N_EXPERTS, D_MODEL, 2 * EXPERT_DIM), D_MODEL),
        "moe_w_down": w(ks[15], (N_ODD, N_EXPERTS, EXPERT_DIM, D_MODEL), EXPERT_DIM),
    }


def reference(x, norm_mix, norm_ffn, norm_final, ev_w_in, ev_pool_w, ev_pool_scale, ev_w_out,
              od_w_in, od_conv_w, od_w_out, ffn_w_gu, ffn_w_down, moe_router, moe_w_gu,
              moe_w_down):
    pos = jnp.arange(x.shape[1])
    h = x
    for layer in range(DEPTH):
        i = layer // 2
        hn = rmsnorm(h, norm_mix[layer])
        if layer % 2 == 0:
            h = h + even_mixer(hn, ev_w_in[i], ev_pool_w[i], ev_pool_scale[i], ev_w_out[i], pos)
            h = h + swiglu(rmsnorm(h, norm_ffn[layer]), ffn_w_gu[i], ffn_w_down[i])
        else:
            h = h + short_conv_mixer(hn, od_w_in[i], od_conv_w[i], od_w_out[i])
            h = h + moe_swiglu(rmsnorm(h, norm_ffn[layer]), moe_router[i], moe_w_gu[i], moe_w_down[i])
    return rmsnorm(h, norm_final)
```

```cpp
#include <hip/hip_runtime.h>
#include <cstdio>
#include <cstdint>

#define LAS __attribute__((address_space(3)))
#define GAS __attribute__((address_space(1)))
typedef unsigned short bf16_t;
typedef short bf16x8 __attribute__((ext_vector_type(8)));
typedef float f32x4 __attribute__((ext_vector_type(4)));
typedef float f32x2 __attribute__((ext_vector_type(2)));
typedef unsigned u32x4 __attribute__((ext_vector_type(4)));
typedef unsigned u32x2 __attribute__((ext_vector_type(2)));
typedef GAS unsigned gu32;

#ifndef MK_FAST_GEMM
#define MK_FAST_GEMM 1
#endif
#ifndef MK_ONE_LAUNCH
#define MK_ONE_LAUNCH 1
#endif

namespace pg8 {
constexpr int BM = 256, BK = 64, HALF = 128, HTB = HALF * BK * 2  , STAGE_BYTES = 8 * HTB, NXCD = 8, WGM = 8;

__host__ __device__ __forceinline__ int lds_byte(int r, int c) { const int st = (r >> 4) * 2 + (c >> 5), rr = r & 15, cc = c & 31, ob = rr * 64 + cc * 2; return st * 1024 + (ob ^ (((ob >> 9) & 1) << 5)); }
__host__ __device__ __forceinline__ void stage_rc(int b, int& R, int& C) { const int st = b / 1024, sb = b % 1024, swz = sb ^ (((sb >> 9) & 1) << 5); R = (st >> 1) * 16 + swz / 64; C = (st & 1) * 32 + (swz % 64) / 2; }
__host__ __device__ __forceinline__ int perm32(int rho) { const int n = rho >> 4, i = rho & 15; return 8 * (i >> 2) + 4 * n + (i & 3); }

struct Unit { int pm, pn; const char* a; const char* b; int x0, x1, x2; };

__device__ __forceinline__ void tile_of(int L, int nM, int nN, int& pm, int& pn) {
    const int nwg = nM * nN; int wgid = L;
    { const int q = nwg / NXCD, r = nwg % NXCD, xcd = wgid % NXCD, off = wgid / NXCD; wgid = (xcd < r ? xcd * (q + 1) : r * (q + 1) + (xcd - r) * q) + off; }
    const int nig = WGM * nN, gid = wgid / nig, fm = gid * WGM, gsz = (nM - fm) < WGM ? (nM - fm) : WGM;
    pm = fm + ((wgid % nig) % gsz); pn = (wgid % nig) / gsz;
}

struct GridOrder {
    static constexpr bool GATHER = false;
    int nM, nN, G, c, skip_from, skip_by;
    const char *A0, *B0; long a_sm, a_sn, b_sm, b_sn;
    __device__ __forceinline__ bool next(int i, Unit& u) const {
        const long L = (long)i * G + c; if (L >= (long)nM * nN) return false;
        int pm, pn; tile_of((int)L, nM, nN, pm, pn); if (pn >= skip_from) pn += skip_by;
        u.pm = pm; u.pn = pn; u.a = A0 + pm * a_sm + pn * a_sn; u.b = B0 + pm * b_sm + pn * b_sn; u.x0 = u.x1 = u.x2 = 0; return true;
    }
    __device__ __forceinline__ unsigned goff(const Unit&, int) const { return 0u; }
};
__device__ __forceinline__ GridOrder grid_order(int nM, int nN, int G, int c, const void* A0, long a_sm, long a_sn, const void* B0, long b_sm, long b_sn, int skip_from = 1 << 30, int skip_by = 0) {
    GridOrder S; S.nM = nM; S.nN = nN; S.G = G; S.c = c; S.skip_from = skip_from; S.skip_by = skip_by; S.A0 = (const char*)A0; S.B0 = (const char*)B0; S.a_sm = a_sm; S.a_sn = a_sn; S.b_sm = b_sm; S.b_sn = b_sn; return S;
}

__device__ __forceinline__ unsigned cvt_pk_bf16(float lo, float hi) { unsigned r; asm volatile("v_cvt_pk_bf16_f32 %0, %1, %2" : "=v"(r) : "v"(lo), "v"(hi)); return r; }
__device__ __forceinline__ float bf2f(unsigned short b) { return __uint_as_float(((unsigned)b) << 16); }
__device__ __forceinline__ float bflo(unsigned w) { return __uint_as_float(w << 16); }
__device__ __forceinline__ float bfhi(unsigned w) { return __uint_as_float(w & 0xffff0000u); }

typedef int i32x8 __attribute__((ext_vector_type(8)));
typedef int i32x4 __attribute__((ext_vector_type(4)));
typedef float f32x8 __attribute__((ext_vector_type(8)));
__device__ __forceinline__ i32x8 frag8(bf16x8 lo, bf16x8 hi) { const i32x4 a = __builtin_bit_cast(i32x4, lo), b = __builtin_bit_cast(i32x4, hi); return (i32x8){a[0], a[1], a[2], a[3], b[0], b[1], b[2], b[3]}; }

constexpr int PF_SIDE_OFF = 131072 + 4096, PF_SIDE_BYTES = 2048;
template <class E, class = void> struct epi_pf { static constexpr int value = 0; };
template <class E> struct epi_pf<E, decltype((void)E::PF_BYTES)> { static constexpr int value = E::PF_BYTES; };
template <class Epi, class Sched, bool ALIGN_EPI = true>
__device__ __forceinline__ void gemm_phase_ref(LAS unsigned char* lds, const int K, const int lda, const int ldb, const Sched& S, const Epi& E) {
    const int tid = threadIdx.x, wid = __builtin_amdgcn_readfirstlane(tid >> 6), lane = tid & 63, wr = wid >> 2, wc = wid & 3, fr = lane & 15, fq = lane >> 4;
    constexpr int KT = 32, LDR = KT + 8;
    LAS bf16_t* As = (LAS bf16_t*)lds; LAS bf16_t* Bs = As + 256 * LDR;
    for (int ui = 0;; ++ui) {
        Unit u; if (!S.next(ui, u)) break;
        f32x4 acc[2][2][4][2];
#pragma unroll
        for (int a = 0; a < 2; ++a)
#pragma unroll
            for (int b = 0; b < 2; ++b)
#pragma unroll
                for (int m = 0; m < 4; ++m)
#pragma unroll
                    for (int n = 0; n < 2; ++n) acc[a][b][m][n] = (f32x4){0.f, 0.f, 0.f, 0.f};
        for (int k0 = 0; k0 < K; k0 += KT) {
            __syncthreads();
            for (int c = tid; c < 1024; c += 512) { const int row = c >> 2, ch = c & 3;
                const char* ap = Sched::GATHER ? (u.a + S.goff(u, row)) : (u.a + (size_t)row * lda * 2);
                const u32x4 va = *(const GAS u32x4*)(ap + (size_t)k0 * 2 + ch * 16); *(LAS u32x4*)(As + row * LDR + ch * 8) = va;
                const u32x4 vb = *(const GAS u32x4*)(u.b + (size_t)row * ldb * 2 + (size_t)k0 * 2 + ch * 16); *(LAS u32x4*)(Bs + row * LDR + ch * 8) = vb; }
            __syncthreads();
            for (int kk = 0; kk < KT; ++kk) {
                float av[2][4], bv[2][2][4];
#pragma unroll
                for (int ai = 0; ai < 2; ++ai)
#pragma unroll
                    for (int m = 0; m < 4; ++m) av[ai][m] = bf2f(As[(ai * 128 + wr * 64 + m * 16 + fr) * LDR + kk]);
#pragma unroll
                for (int bj = 0; bj < 2; ++bj)
#pragma unroll
                    for (int n = 0; n < 2; ++n)
#pragma unroll
                        for (int j = 0; j < 4; ++j) { const int col = Epi::PERM ? (bj * 128 + wc * 32 + 8 * fq + 4 * n + j) : (bj * 128 + wc * 32 + 16 * n + 4 * fq + j); bv[bj][n][j] = bf2f(Bs[col * LDR + kk]); }
#pragma unroll
                for (int ai = 0; ai < 2; ++ai)
#pragma unroll
                    for (int bj = 0; bj < 2; ++bj)
#pragma unroll
                        for (int m = 0; m < 4; ++m)
#pragma unroll
                            for (int n = 0; n < 2; ++n)
#pragma unroll
                                for (int j = 0; j < 4; ++j) acc[ai][bj][m][n][j] += av[ai][m] * bv[bj][n][j];
            }
        }
        if constexpr (Epi::AFTER_DRAIN) { __syncthreads(); E.fused(acc, u, wr, wc, fr, fq, lds, wid, lane); __syncthreads(); }
        else E(acc, u, wr, wc, fr, fq);
    }
    __syncthreads();
}

template <class Epi, class Sched, bool ALIGN_EPI = true, bool FP8 = false>
__device__ __forceinline__ void gemm_phase_fast(LAS unsigned char* lds, const int K, const int lda, const int ldb, const Sched& S, const Epi& E) {
    int tid_ = threadIdx.x; asm volatile("" : "+v"(tid_));
    const int tid = tid_, wid = __builtin_amdgcn_readfirstlane(tid >> 6), lane = tid & 63, wr = wid >> 2, wc = wid & 3, fr = lane & 15, fq = lane >> 4;
    constexpr int ESZ = FP8 ? 1 : 2;
    const int nt = K * ESZ / (BK * 2);
    constexpr bool GA = Sched::GATHER;
    unsigned voffA[2], voffB[2], colA[2]; int rowA[2];
#pragma unroll
    for (int i = 0; i < 2; ++i) { int R, C; stage_rc(tid * 16 + i * 8192, R, C); const int Rb = Epi::PERM ? ((R & ~31) + perm32(R & 31)) : R;
        voffA[i] = (unsigned)(R * lda * ESZ + C * 2); voffB[i] = (unsigned)(Rb * ldb * ESZ + C * 2); colA[i] = (unsigned)C * 2u; rowA[i] = R; }
    const size_t kstep = (size_t)(BK * 2);
    const size_t hstepA = GA ? (size_t)0 : (size_t)HALF * lda * ESZ, hstepB = (size_t)HALF * ldb * ESZ;
    const unsigned ldsw = (unsigned)wid * 1024u;
    const int aoff = FP8 ? lds_byte(wr * 64 + fr, fq * 16) : lds_byte(wr * 64 + fr, fq * 8), boff = FP8 ? lds_byte(wc * 32 + fr, fq * 16) : lds_byte(wc * 32 + fr, fq * 8);
    unsigned gC[2][2], gN[2][2];
#define PG8_SA(b, h) (((b) * 2 + (h)) * HTB)
#define PG8_SB(b, h) ((4 + (b) * 2 + (h)) * HTB)
#define PG8_GLDS(gp, bufoff, _i) __builtin_amdgcn_global_load_lds((const unsigned*)(gp), (LAS unsigned*)(lds + (bufoff) + ldsw + (_i) * 8192), 16, 0, 0)
#define PG8_STAGE_B(bufoff, gbase) do { _Pragma("unroll") for (int _i = 0; _i < 2; ++_i) PG8_GLDS((const char*)(gbase) + voffB[_i], bufoff, _i); } while (0)
#define PG8_STAGE_A(bufoff, gbase, h, nx) do { _Pragma("unroll") for (int _i = 0; _i < 2; ++_i) { \
        if constexpr (GA) PG8_GLDS((const char*)(gbase) + ((nx) ? gN[h][_i] : gC[h][_i]), bufoff, _i); \
        else PG8_GLDS((const char*)(gbase) + (h) * hstepA + voffA[_i], bufoff, _i); } } while (0)
#define PG8_LDA(dst, b, h) do { if constexpr (FP8) { _Pragma("unroll") for (int m = 0; m < 4; ++m) { dst##8[m].lo = *(const LAS i32x4*)(lds + PG8_SA(b, h) + aoff + m * 2048); dst##8[m].hi = *(const LAS i32x4*)(lds + PG8_SA(b, h) + aoff + m * 2048 + 16); } } \
        else { _Pragma("unroll") for (int m = 0; m < 4; ++m) _Pragma("unroll") for (int k = 0; k < 2; ++k) dst[m][k] = *(const LAS bf16x8*)(lds + PG8_SA(b, h) + aoff + m * 2048 + k * 1024); } } while (0)
#define PG8_LDB(dst, b, h) do { if constexpr (FP8) { _Pragma("unroll") for (int n = 0; n < 2; ++n) { dst##8[n].lo = *(const LAS i32x4*)(lds + PG8_SB(b, h) + boff + n * 2048); dst##8[n].hi = *(const LAS i32x4*)(lds + PG8_SB(b, h) + boff + n * 2048 + 16); } } \
        else { _Pragma("unroll") for (int n = 0; n < 2; ++n) _Pragma("unroll") for (int k = 0; k < 2; ++k) dst[n][k] = *(const LAS bf16x8*)(lds + PG8_SB(b, h) + boff + n * 2048 + k * 1024); } } while (0)
#define PG8_MMA(ai, bj, At, Bt) do { __builtin_amdgcn_s_setprio(1); _Pragma("unroll") for (int m = 0; m < 4; ++m) _Pragma("unroll") for (int n = 0; n < 2; ++n) { \
        if constexpr (FP8) asm volatile("v_mfma_scale_f32_16x16x128_f8f6f4 %0, %1, %2, %0, %3, %3 op_sel_hi:[0,0,0]" : "+v"(acc[ai][bj][m][n]) : "v"(Bt##8[n]), "v"(At##8[m]), "v"(sc1)); \
        else { _Pragma("unroll") for (int k = 0; k < 2; ++k) acc[ai][bj][m][n] = __builtin_amdgcn_mfma_f32_16x16x32_bf16(Bt[n][k], At[m][k], acc[ai][bj][m][n], 0, 0, 0); } } __builtin_amdgcn_s_setprio(0); } while (0)
#define PG8_WAIT_V(n) asm volatile("s_waitcnt vmcnt(" #n ")" ::: "memory")
#define PG8_WAIT_L(n) asm volatile("s_waitcnt lgkmcnt(" #n ")" ::: "memory")
#define PG8_BAR __builtin_amdgcn_s_barrier()
#define PG8_SCHED __builtin_amdgcn_sched_barrier(0)
    Unit cur, nxt; int ui = 0;
    if (!S.next(0, cur)) return;
    f32x4 acc[2][2][4][2];
#pragma unroll
    for (int a = 0; a < 2; ++a)
#pragma unroll
        for (int b = 0; b < 2; ++b)
#pragma unroll
            for (int m = 0; m < 4; ++m)
#pragma unroll
                for (int n = 0; n < 2; ++n) acc[a][b][m][n] = (f32x4){0.f, 0.f, 0.f, 0.f};
    bf16x8 At[4][2], B0[2][2], B1[2][2];
    i32x8 At8[4], B08[2], B18[2];
    const int sc1 = 0x7f7f7f7f;
    (void)At; (void)B0; (void)B1; (void)At8; (void)B08; (void)B18; (void)sc1;
    const char* cA = cur.a; const char* cB = cur.b;
    if constexpr (GA) {
#pragma unroll
        for (int h = 0; h < 2; ++h)
#pragma unroll
            for (int i = 0; i < 2; ++i) { gC[h][i] = S.goff(cur, h * HALF + rowA[i]) + colA[i]; gN[h][i] = gC[h][i]; }
    }
    PG8_STAGE_B(PG8_SB(0, 0), cB); PG8_STAGE_B(PG8_SB(0, 1), cB + hstepB); PG8_STAGE_A(PG8_SA(0, 0), cA, 0, false); PG8_STAGE_A(PG8_SA(0, 1), cA, 1, false);
    if (wr == 1) PG8_BAR;
    PG8_WAIT_V(2); PG8_BAR;
    PG8_STAGE_B(PG8_SB(1, 0), cB + kstep); PG8_STAGE_A(PG8_SA(1, 0), cA + kstep, 0, false); PG8_STAGE_B(PG8_SB(1, 1), cB + hstepB + kstep);
    PG8_WAIT_V(6); PG8_BAR;
#pragma unroll 1
    for (;;) {
        const bool has_next = S.next(ui + 1, nxt);
        if constexpr (epi_pf<Epi>::value > 0) {
            if (epi_pf<Epi>::value == 8 || wid < 4) { unsigned m_ = ~0u; asm volatile("" : "+s"(m_)); const int l_ = (int)__builtin_amdgcn_mbcnt_hi(m_, __builtin_amdgcn_mbcnt_lo(m_, 0u));
                __builtin_amdgcn_global_load_lds((const unsigned*)((const char*)E.pf_src(cur) + (wid * 64 + l_) * 4), (LAS unsigned*)(lds + PF_SIDE_OFF + (ui & 1) * PF_SIDE_BYTES + wid * 256), 4, 0, 0); } }
        const char* nA = has_next ? nxt.a : cA; const char* nB = has_next ? nxt.b : cB;
        if constexpr (GA) { if (has_next) {
#pragma unroll
            for (int h = 0; h < 2; ++h)
#pragma unroll
                for (int i = 0; i < 2; ++i) gN[h][i] = S.goff(nxt, h * HALF + rowA[i]) + colA[i]; } }
#pragma unroll 1
        for (int t = 0; t < nt; t += 2) {
            const bool last = (t == nt - 2);
            const char* a1 = cA + (size_t)(t + 1) * kstep;
            const char* a2 = last ? nA : cA + (size_t)(t + 2) * kstep; const char* b2 = last ? nB : cB + (size_t)(t + 2) * kstep;
            const char* a3 = a2 + kstep; const char* b3 = b2 + kstep;
            PG8_LDB(B0, 0, 0); PG8_LDB(B1, 0, 1); PG8_SCHED; PG8_LDA(At, 0, 0); PG8_STAGE_A(PG8_SA(1, 1), a1, 1, false);
            PG8_WAIT_V(8); PG8_WAIT_L(0); PG8_BAR; PG8_MMA(0, 0, At, B0); PG8_MMA(0, 1, At, B1); PG8_BAR; PG8_SCHED;
            PG8_LDA(At, 0, 1); PG8_STAGE_B(PG8_SB(0, 0), b2); PG8_STAGE_B(PG8_SB(0, 1), b2 + hstepB); PG8_STAGE_A(PG8_SA(0, 0), a2, 0, last);
            PG8_WAIT_V(8); PG8_WAIT_L(0); PG8_BAR; PG8_MMA(1, 0, At, B0); PG8_MMA(1, 1, At, B1); PG8_BAR; PG8_SCHED;
            PG8_LDB(B0, 1, 0); PG8_LDB(B1, 1, 1); PG8_SCHED; PG8_LDA(At, 1, 0); PG8_STAGE_A(PG8_SA(0, 1), a2, 1, last);
            PG8_WAIT_V(8); PG8_WAIT_L(0); PG8_BAR; PG8_MMA(0, 0, At, B0); PG8_MMA(0, 1, At, B1); PG8_BAR; PG8_SCHED;
            PG8_LDA(At, 1, 1); PG8_STAGE_B(PG8_SB(1, 0), b3); PG8_STAGE_B(PG8_SB(1, 1), b3 + hstepB); PG8_STAGE_A(PG8_SA(1, 0), a3, 0, last);
            PG8_WAIT_V(8); PG8_WAIT_L(0); PG8_BAR; PG8_MMA(1, 0, At, B0); PG8_MMA(1, 1, At, B1); PG8_BAR; PG8_SCHED;
        }
        if constexpr (ALIGN_EPI) { if (wr == 0) PG8_BAR; }
        if constexpr (FP8) asm volatile("s_nop 15\n\ts_nop 15" ::: "memory");
        if constexpr (!Epi::AFTER_DRAIN) { if constexpr (epi_pf<Epi>::value > 0) E.with_pf(acc, cur, wr, wc, fr, fq, (const LAS unsigned char*)(lds + PF_SIDE_OFF + (ui & 1) * PF_SIDE_BYTES)); else E(acc, cur, wr, wc, fr, fq);
#if defined(MK_EPI_TWICE)
            if constexpr (Epi::PROBE_TWICE) { asm volatile("" ::: "memory"); E(acc, cur, wr, wc, fr, fq); }
#endif
        }
        if (!has_next) break;
#pragma unroll
        for (int a = 0; a < 2; ++a)
#pragma unroll
            for (int b = 0; b < 2; ++b)
#pragma unroll
                for (int m = 0; m < 4; ++m)
#pragma unroll
                    for (int n = 0; n < 2; ++n) acc[a][b][m][n] = (f32x4){0.f, 0.f, 0.f, 0.f};
        cur = nxt; cA = nA; cB = nB; ++ui;
        if constexpr (GA) {
#pragma unroll
            for (int h = 0; h < 2; ++h)
#pragma unroll
                for (int i = 0; i < 2; ++i) gC[h][i] = gN[h][i]; }
        if constexpr (ALIGN_EPI) { if (wr == 1) PG8_BAR; }
    }
    PG8_WAIT_V(0);
    if constexpr (!ALIGN_EPI) { if (wr == 0) PG8_BAR; }
    PG8_BAR;
    if constexpr (Epi::AFTER_DRAIN) { E.fused(acc, cur, wr, wc, fr, fq, lds, wid, lane); PG8_BAR; }
#undef PG8_SA
#undef PG8_SB
#undef PG8_GLDS
#undef PG8_STAGE_A
#undef PG8_STAGE_B
#undef PG8_LDA
#undef PG8_LDB
#undef PG8_MMA
#undef PG8_WAIT_V
#undef PG8_WAIT_L
#undef PG8_BAR
#undef PG8_SCHED
}

template <class Epi, class Sched, bool ALIGN_EPI = true, bool FP8 = false>
__device__ __forceinline__ void gemm_phase(LAS unsigned char* lds, const int K, const int lda, const int ldb, const Sched& S, const Epi& E) {
#if MK_FAST_GEMM
    gemm_phase_fast<Epi, Sched, ALIGN_EPI, FP8>(lds, K, lda, ldb, S, E);
#else
    gemm_phase_ref<Epi, Sched, ALIGN_EPI>(lds, K, lda, ldb, S, E);
#endif
}
}

constexpr int NWAVES = 8;
constexpr int DM = 2048, SEQ = 8192, MTOK = 16384;
constexpr int EIN = 5120, FFN = 5632, EXD = 2816, NEXP = 8, OIN = 6144;
constexpr int ECAP = 16384;
constexpr int MOE_ROWS = 2 * MTOK + NEXP * 256;
constexpr float RMS_EPS = 1e-6f, GN_EPS = 1e-5f;

constexpr size_t MiB = 1u << 20;
constexpr size_t WS_CTL = 0, CTL_ZERO_BYTES = 2 * MiB;
constexpr size_t WS_MISC = 2 * MiB;
constexpr size_t WS_EWIN = 8 * MiB;
constexpr size_t WS_EWP = WS_EWIN + 40 * MiB;
constexpr size_t WS_EWOUT = WS_EWP + 1 * MiB;
constexpr size_t WS_OWIN = WS_EWOUT + 16 * MiB;
constexpr size_t WS_OWOUT = WS_OWIN + 48 * MiB;
constexpr size_t WS_FGU = WS_OWOUT + 16 * MiB;
constexpr size_t WS_FDN = WS_FGU + 88 * MiB;
constexpr size_t WS_MGU = WS_FDN + 44 * MiB;
constexpr size_t WS_MDN = WS_MGU + 352 * MiB;
constexpr size_t WS_HB = WS_MDN + 176 * MiB;
constexpr size_t WS_U = WS_HB + 64 * MiB;
constexpr size_t WS_QP = WS_U + 32 * MiB;
constexpr size_t WS_KN = WS_QP + 64 * MiB;
constexpr size_t WS_SG = WS_KN + 32 * MiB;
constexpr size_t WS_KT = WS_SG + 32 * MiB;
constexpr size_t WS_VS = WS_KT + 32 * MiB;
constexpr size_t WS_LT = WS_VS + 64 * MiB;
constexpr size_t WS_PP = WS_LT + 64 * MiB;
constexpr size_t WS_YCAT = WS_PP + 32 * MiB;
constexpr size_t WS_ACT = WS_YCAT + 64 * MiB;
constexpr size_t WS_BG = WS_ACT + 176 * MiB;
constexpr size_t WS_Z = WS_BG + 64 * MiB;
constexpr size_t WS_ACTM = WS_Z + 64 * MiB;
constexpr size_t WS_YC = WS_ACTM + 188 * MiB;
constexpr size_t WS_HB8 = WS_YC + 136 * MiB;
constexpr size_t WS_Y8 = WS_HB8 + 32 * MiB;
constexpr size_t WS_END = WS_Y8 + 32 * MiB;
static_assert((size_t)MOE_ROWS * EXD * 2 <= 188 * MiB && (size_t)MOE_ROWS * DM * 2 <= 136 * MiB, "moe buffers");
constexpr size_t MS_TOKE = 0, MS_TOKP = 128 * 1024, MS_ROWTOK = 256 * 1024, MS_ER = 768 * 1024, MS_EW = 1280 * 1024;
constexpr int CW_TMO = 0, CW_CODE = 1;
constexpr int CW_BAR = 4096;
constexpr int CW_CNT = 8192;
constexpr int CW_CONVQ = 16384;
constexpr int CW_SSQ = 65536;
static_assert((CW_SSQ + 2 * 9 * MTOK) * 4 <= (int)CTL_ZERO_BYTES, "CTL words inside the memset region");
typedef unsigned long long ssq_t;
constexpr float SSQ_SCALE = 1048576.f, SSQ_INV = 1.f / 1048576.f;

constexpr int RING_OFF = 0, RING_BYTES = 131072;
constexpr int LDSX_OFF = RING_BYTES;
constexpr int LDSCTL_OFF = RING_BYTES + 8192, MISC_OFF = LDSCTL_OFF + 320;
constexpr int LDS_BYTES = 147456;
static_assert(MISC_OFF + 128 <= LDS_BYTES, "LDS map");
static_assert(pg8::PF_SIDE_OFF == LDSX_OFF + 4096 && pg8::PF_SIDE_OFF + 2 * pg8::PF_SIDE_BYTES <= LDSCTL_OFF, "epilogue prefetch side area");

#define RLX_AGENT __ATOMIC_RELAXED, __HIP_MEMORY_SCOPE_AGENT
#define LDS_WAIT() asm volatile("s_waitcnt lgkmcnt(0)" ::: "memory")
#define VM_WAIT() asm volatile("s_waitcnt vmcnt(0)" ::: "memory")

#define XB_TMO      128
#define XB_XCNT(j)  (256  + 64 * (j))
#define XB_XSUB(j)  (1280 + 64 * (j))
#define XB_XGEN(j)  (2304 + 64 * (j))
#define XB_TOP      3328
#define XB_TOPGEN   3392
#define XCD_BAR_WORDS 3456
#define XB_SPIN_CAP (1u << 22)

__device__ __forceinline__ unsigned xb_ld(unsigned* p)              { return __hip_atomic_load(p, __ATOMIC_RELAXED, __HIP_MEMORY_SCOPE_AGENT); }
__device__ __forceinline__ unsigned xb_add(unsigned* p, unsigned v) { return __hip_atomic_fetch_add(p, v, __ATOMIC_RELAXED, __HIP_MEMORY_SCOPE_AGENT); }
__device__ __forceinline__ unsigned xb_xcc_id() { return (unsigned)__builtin_amdgcn_s_getreg((3 << 11) | 20) & 0xFu; }
#define XB_SPIN(cond, bar) do { unsigned _sp = 0; while (cond) { __builtin_amdgcn_s_sleep(1); \
    if ((++_sp & 255u) == 0u) { if (xb_ld(&(bar)[XB_TMO])) break; if (_sp > XB_SPIN_CAP) { atomicAdd(&(bar)[XB_TMO], 1u); break; } } } } while (0)

struct XcdBarrier { unsigned* bar; unsigned x; volatile LAS unsigned* st; };

__device__ __forceinline__ XcdBarrier xcd_barrier_post(unsigned* bar, volatile LAS unsigned* st) {
    XcdBarrier b; b.bar = bar; b.x = xb_xcc_id(); b.st = st;
    if (threadIdx.x == 0) (void)xb_add(&bar[XB_XCNT(b.x)], 1u);
    return b;
}
__device__ __forceinline__ void xcd_barrier_complete(unsigned* bar, unsigned x, unsigned& nloc, unsigned& nx) {
    const unsigned G = gridDim.x * gridDim.y * gridDim.z;
    unsigned sum, cnt, mine, sp = 0u;
    for (;;) {
        sum = 0u; cnt = 0u; mine = 0u;
#pragma unroll
        for (unsigned j = 0; j < 16; ++j) { const unsigned c = xb_ld(&bar[XB_XCNT(j)]); sum += c; cnt += (c > 0u) ? 1u : 0u; mine = (j == x) ? c : mine; }
        if (sum == G) break;
        __builtin_amdgcn_s_sleep(1);
        if ((++sp & 255u) == 0u) { if (xb_ld(&bar[XB_TMO])) break; if (sp > XB_SPIN_CAP) { atomicAdd(&bar[XB_TMO], 1u); break; } }
    }
    nloc = mine > 0u ? mine : 1u; nx = cnt > 0u ? cnt : 1u;
}
__device__ __forceinline__ void xcd_barrier(const XcdBarrier& b) {
    asm volatile("s_waitcnt vmcnt(0)" ::: "memory");
    __syncthreads();
    if (threadIdx.x == 0) {
        unsigned* bar = b.bar;
        __builtin_amdgcn_s_waitcnt(0);
        unsigned nloc = b.st[0], nx = b.st[1];
        if (nloc == 0u) { xcd_barrier_complete(bar, b.x, nloc, nx); b.st[0] = nloc; b.st[1] = nx; }
        const unsigned old = xb_add(&bar[XB_XSUB(b.x)], 1u);
        const unsigned gen = old / nloc;
        if (old + 1u == (gen + 1u) * nloc) {
            __builtin_amdgcn_fence(__ATOMIC_RELEASE, "agent");
            asm volatile("s_waitcnt vmcnt(0)" ::: "memory");
            const unsigned og = xb_add(&bar[XB_TOP], 1u);
            const unsigned tg = og / nx;
            if (og + 1u == (tg + 1u) * nx) xb_add(&bar[XB_TOPGEN], 1u);
            else XB_SPIN(xb_ld(&bar[XB_TOPGEN]) == tg, bar);
            __builtin_amdgcn_fence(__ATOMIC_ACQUIRE, "agent");
            xb_add(&bar[XB_XGEN(b.x)], 1u);
            asm volatile("s_waitcnt vmcnt(0)" ::: "memory");
        } else {
            XB_SPIN(xb_ld(&bar[XB_XGEN(b.x)]) == gen, bar);
            __builtin_amdgcn_fence(__ATOMIC_ACQUIRE, "agent");
            asm volatile("s_waitcnt vmcnt(0)" ::: "memory");
        }
    }
    __syncthreads();
}

__device__ __forceinline__ float wave_sum(float v) {
#pragma unroll
    for (int o = 1; o < 64; o <<= 1) v += __shfl_xor(v, o);
    return v;
}
__device__ __forceinline__ float silu_f(float x) { return x * __builtin_amdgcn_rcpf(1.f + __builtin_amdgcn_exp2f(-1.44269504f * x)); }
__device__ __forceinline__ f32x2 swiglu_pk(f32x2 a0, f32x2 a1, float r, float r3) {
    const f32x2 t = a0 * (r * -1.44269504f); f32x2 e; e.x = __builtin_amdgcn_exp2f(t.x); e.y = __builtin_amdgcn_exp2f(t.y);
    const float is = __builtin_amdgcn_rcpf(r * r3);
    const f32x2 d = e * is + is; f32x2 rc; rc.x = __builtin_amdgcn_rcpf(d.x); rc.y = __builtin_amdgcn_rcpf(d.y);
    return (a0 * a1) * rc;
}
__device__ __forceinline__ ssq_t ssq_fix(float q) { return (ssq_t)__float2ull_rn(q * SSQ_SCALE); }
template <class T> __device__ __forceinline__ GAS T* at32(const void* base, unsigned byte_off) { return (GAS T*)((GAS unsigned char*)base + byte_off); }
__device__ __forceinline__ float rs_from(unsigned long long v) { const float f = (float)(unsigned)(v >> 32) * 4294967296.f + (float)(unsigned)v;
    return __builtin_amdgcn_rsqf(f * (SSQ_INV / (float)DM) + RMS_EPS); }
__device__ __forceinline__ float rs_of(const ssq_t* ssq, int m) { return rs_from(*at32<const unsigned long long>(ssq, (unsigned)m * 8u)); }
__device__ __forceinline__ float lg_gamma(int h) { return h == 0 ? -0.04580368961312479f : (h == 1 ? -0.02272007650008353f : (h == 2 ? -0.011315313227834146f : -0.005646563141142063f)); }
__device__ __forceinline__ unsigned pk2(float lo, float hi) { return pg8::cvt_pk_bf16(lo, hi); }
#ifndef MK_F8_MASK
#define MK_F8_MASK 0xcce
#endif
constexpr float W8_SCALE = 256.f, ACT8_SCALE = 8.f, GU8_UNSCALE = 1.f / 256.f, DN8_UNSCALE = 1.f / (256.f * 8.f);
__host__ __device__ constexpr bool f8_ffn(int lp) { return ((MK_F8_MASK) >> (2 * lp)) & 1; }
__host__ __device__ constexpr bool f8_moe(int lp) { return ((MK_F8_MASK) >> (2 * lp + 1)) & 1; }
__host__ __device__ constexpr bool f8_ein(int lp) { return ((MK_F8_MASK) >> (4 + 2 * lp)) & 1; }
__host__ __device__ constexpr bool f8_oin(int lp) { return ((MK_F8_MASK) >> (5 + 2 * lp)) & 1; }
__host__ __device__ constexpr bool f8_eout(int lp) { return ((MK_F8_MASK) >> (8 + 2 * lp)) & 1; }
__host__ __device__ constexpr bool f8_oout(int lp) { return ((MK_F8_MASK) >> (9 + 2 * lp)) & 1; }
__host__ __device__ constexpr bool f8_dn(int lp) { return f8_ffn(lp) || (((MK_F8_MASK) >> (12 + lp)) & 1); }
__device__ __forceinline__ float clamp8(float v) { return __builtin_amdgcn_fmed3f(v, -448.f, 448.f); }
__device__ __forceinline__ unsigned pk4_fp8(float a, float b, float c, float d) { int p = 0; p = __builtin_amdgcn_cvt_pk_fp8_f32(clamp8(a), clamp8(b), p, false); p = __builtin_amdgcn_cvt_pk_fp8_f32(clamp8(c), clamp8(d), p, true); return (unsigned)p; }
using pg8::bflo; using pg8::bfhi; using pg8::Unit;

struct EpiEvenIn {
    static constexpr bool PERM = true, AFTER_DRAIN = false, PROBE_TWICE = false;
    const ssq_t* ssq; bf16_t *U, *QP, *KN, *KT, *SG; float sc;
    static constexpr int PF_BYTES = 8;
    __device__ __forceinline__ const void* pf_src(const Unit& u) const { return ssq + u.pm * 256; }
    __device__ __forceinline__ void operator()(const f32x4 (&acc)[2][2][4][2], const Unit& u, int wr, int wc, int fr, int fq) const { run<false>(acc, u, wr, wc, fr, fq, nullptr); }
    __device__ __forceinline__ void with_pf(const f32x4 (&acc)[2][2][4][2], const Unit& u, int wr, int wc, int fr, int fq, const LAS unsigned char* sb) const { run<true>(acc, u, wr, wc, fr, fq, sb); }
    template <bool PFD> __device__ __forceinline__ void run(const f32x4 (&acc)[2][2][4][2], const Unit& u, int wr, int wc, int fr, int fq, const LAS unsigned char* sb) const {
        asm volatile("" : "+v"(fr), "+v"(fq));
        const int ct = u.pn, rl0 = wr * 64 + fr, row0 = u.pm * 256 + rl0, cl = wc * 32 + 8 * fq;
        if (ct < 4 || ct >= 16) {
            const bool isg = ct >= 16; bf16_t* O = isg ? SG : U; const int cb = (isg ? ct - 16 : ct) * 256;
#pragma unroll
            for (int ai = 0; ai < 2; ++ai)
#pragma unroll
                for (int m = 0; m < 4; ++m) { const int row = row0 + ai * 128 + m * 16; const float r = (PFD ? rs_from(*(const LAS unsigned long long*)(sb + (rl0 + ai * 128 + m * 16) * 8)) : rs_of(ssq, row)) * sc;
#pragma unroll
                    for (int bj = 0; bj < 2; ++bj) { f32x4 v0 = acc[ai][bj][m][0] * r, v1 = acc[ai][bj][m][1] * r;
                        if (isg) {
#pragma unroll
                            for (int j = 0; j < 4; ++j) { v0[j] = silu_f(v0[j]); v1[j] = silu_f(v1[j]); } }
                        u32x4 w; w.x = pk2(v0[0], v0[1]); w.y = pk2(v0[2], v0[3]); w.z = pk2(v1[0], v1[1]); w.w = pk2(v1[2], v1[3]);
                        *(GAS u32x4*)(O + (size_t)row * 1024 + cb + bj * 128 + cl) = w; } }
        } else {
            const bool isq = ct < 8; const int head = isq ? ct - 4 : ct - 8; const float lg = lg_gamma(head);
            float inv[2][4];
#pragma unroll
            for (int n = 0; n < 2; ++n)
#pragma unroll
                for (int j = 0; j < 4; ++j) inv[n][j] = __builtin_amdgcn_exp2f(-0.10381025296523007f * (float)(cl + 4 * n + j));
#pragma unroll
            for (int ai = 0; ai < 2; ++ai)
#pragma unroll
                for (int m = 0; m < 4; ++m) { const int rl = rl0 + ai * 128 + m * 16, row = u.pm * 256 + rl; const float r = (PFD ? rs_from(*(const LAS unsigned long long*)(sb + rl * 8)) : rs_of(ssq, row)) * (isq ? 0.0625f * sc : sc); const float pos = (float)(row & (SEQ - 1));
                    f32x4 o[2][2];
#pragma unroll
                    for (int n = 0; n < 2; ++n)
#pragma unroll
                        for (int j = 0; j < 4; ++j) { const float rev = pos * inv[n][j] * 0.15915494309189535f, fr_ = rev - __builtin_floorf(rev);
                            const float sn = __builtin_amdgcn_sinf(fr_), cs = __builtin_amdgcn_cosf(fr_); const float x1 = acc[ai][0][m][n][j] * r, x2 = acc[ai][1][m][n][j] * r;
                            o[0][n][j] = x1 * cs - x2 * sn; o[1][n][j] = x2 * cs + x1 * sn; }
#pragma unroll
                    for (int bj = 0; bj < 2; ++bj) { u32x4 w; w.x = pk2(o[bj][0][0], o[bj][0][1]); w.y = pk2(o[bj][0][2], o[bj][0][3]); w.z = pk2(o[bj][1][0], o[bj][1][1]); w.w = pk2(o[bj][1][2], o[bj][1][3]);
                        if (isq) *(GAS u32x4*)(QP + (size_t)row * 2048 + head * 512 + 256 + bj * 128 + cl) = w;
                        else *(GAS u32x4*)(KN + (size_t)row * 1024 + head * 256 + bj * 128 + cl) = w; }
                    if (!isq) {
                        const float kd = __builtin_amdgcn_exp2f(lg * (float)(255 - rl)); GAS bf16_t* kt = (GAS bf16_t*)KT + ((size_t)(u.pm * 4 + head) * 256) * 256 + rl;
#pragma unroll
                        for (int bj = 0; bj < 2; ++bj)
#pragma unroll
                            for (int n = 0; n < 2; ++n)
#pragma unroll
                                for (int j = 0; j < 4; ++j) kt[(size_t)(bj * 128 + cl + 4 * n + j) * 256] = (bf16_t)(pk2(o[bj][n][j] * kd, 0.f) & 0xffffu); }
                    __builtin_amdgcn_sched_barrier(0);
                }
        }
    }
};
struct EpiVt {
    static constexpr bool PERM = true, AFTER_DRAIN = false, PROBE_TWICE = false;
    const ssq_t* ssq; bf16_t* VS; float sc;
    static constexpr int PF_BYTES = 8;
    __device__ __forceinline__ const void* pf_src(const Unit& u) const { return ssq + u.pn * 256; }
    __device__ __forceinline__ void operator()(const f32x4 (&acc)[2][2][4][2], const Unit& u, int wr, int wc, int fr, int fq) const { run<false>(acc, u, wr, wc, fr, fq, nullptr); }
    __device__ __forceinline__ void with_pf(const f32x4 (&acc)[2][2][4][2], const Unit& u, int wr, int wc, int fr, int fq, const LAS unsigned char* sb) const { run<true>(acc, u, wr, wc, fr, fq, sb); }
    template <bool PFD> __device__ __forceinline__ void run(const f32x4 (&acc)[2][2][4][2], const Unit& u, int wr, int wc, int fr, int fq, const LAS unsigned char* sb) const {
        asm volatile("" : "+v"(fr), "+v"(fq));
        const int cl = wc * 32 + 8 * fq; bf16_t* base = VS + (size_t)(u.pn * 4 + u.pm) * 256 * 512;
        f32x4 rv[2][2];
#pragma unroll
        for (int bj = 0; bj < 2; ++bj)
#pragma unroll
            for (int n = 0; n < 2; ++n)
#pragma unroll
                for (int j = 0; j < 4; ++j) rv[bj][n][j] = (PFD ? rs_from(*(const LAS unsigned long long*)(sb + (bj * 128 + cl + 4 * n + j) * 8)) : rs_of(ssq, u.pn * 256 + bj * 128 + cl + 4 * n + j)) * sc;
#pragma unroll
        for (int ai = 0; ai < 2; ++ai)
#pragma unroll
            for (int m = 0; m < 4; ++m) { const int e = ai * 128 + wr * 64 + m * 16 + fr;
#pragma unroll
                for (int bj = 0; bj < 2; ++bj) { const f32x4 v0 = acc[ai][bj][m][0] * rv[bj][0], v1 = acc[ai][bj][m][1] * rv[bj][1];
                    u32x4 w; w.x = pk2(v0[0], v0[1]); w.y = pk2(v0[2], v0[3]); w.z = pk2(v1[0], v1[1]); w.w = pk2(v1[2], v1[3]);
                    *(GAS u32x4*)(base + (size_t)e * 512 + bj * 128 + cl) = w; } }
    }
};
struct EpiQK {
    static constexpr bool PERM = true, AFTER_DRAIN = false, PROBE_TWICE = false;
    bf16_t* QP;
    __device__ __forceinline__ void operator()(const f32x4 (&acc)[2][2][4][2], const Unit& u, int wr, int wc, int fr, int fq) const {
        asm volatile("" : "+v"(fr), "+v"(fq));
        const int cl = wc * 32 + 8 * fq; const float lg = lg_gamma(u.pn);
#pragma unroll
        for (int ai = 0; ai < 2; ++ai)
#pragma unroll
            for (int m = 0; m < 4; ++m) { const int i = ai * 128 + wr * 64 + m * 16 + fr, ci = i >> 6;
#pragma unroll
                for (int bj = 0; bj < 2; ++bj) { float o[2][4];
#pragma unroll
                    for (int n = 0; n < 2; ++n)
#pragma unroll
                        for (int j = 0; j < 4; ++j) { const int jc = bj * 128 + cl + 4 * n + j, cj = jc >> 6; const int ad = i > jc ? i - jc : jc - i;
                            const float ex = (cj == ci) ? (float)(ad - i - 1) : (float)(-jc - 1);
                            o[n][j] = (cj > ci) ? 0.f : acc[ai][bj][m][n][j] * __builtin_amdgcn_exp2f(lg * ex); }
                    u32x4 w; w.x = pk2(o[0][0], o[0][1]); w.y = pk2(o[0][2], o[0][3]); w.z = pk2(o[1][0], o[1][1]); w.w = pk2(o[1][2], o[1][3]);
                    *(GAS u32x4*)(QP + (size_t)(u.pm * 256 + i) * 2048 + u.pn * 512 + bj * 128 + cl) = w; __builtin_amdgcn_sched_barrier(0); } }
    }
};
struct EpiBf16Unit {
    static constexpr bool PERM = true, AFTER_DRAIN = false, PROBE_TWICE = false;
    bf16_t* C;
    __device__ __forceinline__ void operator()(const f32x4 (&acc)[2][2][4][2], const Unit& u, int wr, int wc, int fr, int fq) const {
        asm volatile("" : "+v"(fr), "+v"(fq));
        bf16_t* base = C + (size_t)(u.pm * 4 + u.pn) * 65536; const int cl = wc * 32 + 8 * fq;
#pragma unroll
        for (int ai = 0; ai < 2; ++ai)
#pragma unroll
            for (int m = 0; m < 4; ++m) { bf16_t* rowp = base + (size_t)(ai * 128 + wr * 64 + m * 16 + fr) * 256 + cl;
#pragma unroll
                for (int bj = 0; bj < 2; ++bj) { const f32x4 v0 = acc[ai][bj][m][0], v1 = acc[ai][bj][m][1];
                    u32x4 w; w.x = pk2(v0[0], v0[1]); w.y = pk2(v0[2], v0[3]); w.z = pk2(v1[0], v1[1]); w.w = pk2(v1[2], v1[3]);
                    *(GAS u32x4*)(rowp + bj * 128) = w; } }
    }
};
struct EpiBf16Plain {
    static constexpr bool PERM = true, AFTER_DRAIN = false, PROBE_TWICE = false;
    bf16_t* O; int ldc; unsigned char* O8;
    __device__ __forceinline__ void operator()(const f32x4 (&acc)[2][2][4][2], const Unit& u, int wr, int wc, int fr, int fq) const {
        asm volatile("" : "+v"(fr), "+v"(fq));
        const int cl = wc * 32 + 8 * fq;
#pragma unroll
        for (int ai = 0; ai < 2; ++ai)
#pragma unroll
            for (int m = 0; m < 4; ++m) { const size_t ro = (size_t)(u.pm * 256 + ai * 128 + wr * 64 + m * 16 + fr) * ldc + u.pn * 256 + cl; bf16_t* rowp = O + ro;
#pragma unroll
                for (int bj = 0; bj < 2; ++bj) { const f32x4 v0 = acc[ai][bj][m][0], v1 = acc[ai][bj][m][1];
                    u32x4 w; w.x = pk2(v0[0], v0[1]); w.y = pk2(v0[2], v0[3]); w.z = pk2(v1[0], v1[1]); w.w = pk2(v1[2], v1[3]);
                    if (!O8) *(GAS u32x4*)(rowp + bj * 128) = w;
                    if (O8) { u32x2 w8; w8.x = pk4_fp8(v0[0], v0[1], v0[2], v0[3]); w8.y = pk4_fp8(v1[0], v1[1], v1[2], v1[3]); *(GAS u32x2*)(O8 + ro + bj * 128) = w8; } } }
    }
};
struct EpiRetOut {
    static constexpr bool PERM = true, AFTER_DRAIN = true, PROBE_TWICE = false;
    const bf16_t* SG; bf16_t* YCAT; unsigned char* Y8;
    __device__ __forceinline__ void fused(f32x4 (&acc)[2][2][4][2], const Unit& u, int wr, int wc, int fr, int fq, LAS unsigned char* lds, int wid, int lane) const {
        asm volatile("" : "+v"(fr), "+v"(fq));
        LAS f32x2* P = (LAS f32x2*)lds;
        const int cl = wc * 32 + 8 * fq; const float lg = lg_gamma(u.pn);
        u32x4 gg[2][4][2];
#pragma unroll
        for (int ai = 0; ai < 2; ++ai)
#pragma unroll
            for (int m = 0; m < 4; ++m)
#pragma unroll
                for (int bj = 0; bj < 2; ++bj) gg[ai][m][bj] = *at32<const u32x4>(SG, ((unsigned)(u.pm * 256 + ai * 128 + wr * 64 + m * 16 + fr) * 1024u + (unsigned)(u.pn * 256 + bj * 128 + cl)) * 2u);
        __builtin_amdgcn_sched_barrier(0);
#pragma unroll
        for (int ai = 0; ai < 2; ++ai)
#pragma unroll
            for (int m = 0; m < 4; ++m) { const int i = ai * 128 + wr * 64 + m * 16 + fr; const float sc = __builtin_amdgcn_exp2f(lg * (float)(i + 1)); float s = 0.f, q = 0.f;
#pragma unroll
                for (int bj = 0; bj < 2; ++bj)
#pragma unroll
                    for (int n = 0; n < 2; ++n) { f32x4 x = acc[ai][bj][m][n] * sc; acc[ai][bj][m][n] = x; s += (x[0] + x[1]) + (x[2] + x[3]); q += (x[0] * x[0] + x[1] * x[1]) + (x[2] * x[2] + x[3] * x[3]); }
                s += __shfl_xor(s, 16); s += __shfl_xor(s, 32); q += __shfl_xor(q, 16); q += __shfl_xor(q, 32);
                if (fq == 0) P[i * 4 + wc] = (f32x2){s, q}; }
        asm volatile("s_waitcnt lgkmcnt(0)" ::: "memory"); __builtin_amdgcn_s_barrier(); asm volatile("" ::: "memory");
#pragma unroll
        for (int ai = 0; ai < 2; ++ai)
#pragma unroll
            for (int m = 0; m < 4; ++m) { const int i = ai * 128 + wr * 64 + m * 16 + fr, row = u.pm * 256 + i;
                const f32x2 p0 = P[i * 4 + 0], p1 = P[i * 4 + 1], p2 = P[i * 4 + 2], p3 = P[i * 4 + 3];
                const float mu = ((p0.x + p1.x) + (p2.x + p3.x)) * (1.f / 256.f); float var = ((p0.y + p1.y) + (p2.y + p3.y)) * (1.f / 256.f) - mu * mu; var = var > 0.f ? var : 0.f;
                const float rstd = __builtin_amdgcn_rsqf(var + GN_EPS);
#pragma unroll
                for (int bj = 0; bj < 2; ++bj) { const u32x4 g = gg[ai][m][bj];
                    const f32x4 x0 = (acc[ai][bj][m][0] - mu) * rstd, x1 = (acc[ai][bj][m][1] - mu) * rstd;
                    const float y0 = x0[0] * bflo(g.x), y1 = x0[1] * bfhi(g.x), y2 = x0[2] * bflo(g.y), y3 = x0[3] * bfhi(g.y), y4 = x1[0] * bflo(g.z), y5 = x1[1] * bfhi(g.z), y6 = x1[2] * bflo(g.w), y7 = x1[3] * bfhi(g.w);
                    u32x4 w; w.x = pk2(y0, y1); w.y = pk2(y2, y3); w.z = pk2(y4, y5); w.w = pk2(y6, y7);
                    if (!Y8) *(GAS u32x4*)(YCAT + (size_t)row * 2048 + 1024 + u.pn * 256 + bj * 128 + cl) = w;
                    if (Y8) { u32x2 w8; w8.x = pk4_fp8(y0, y1, y2, y3); w8.y = pk4_fp8(y4, y5, y6, y7); *(GAS u32x2*)(Y8 + (size_t)row * 2048 + 1024 + u.pn * 256 + bj * 128 + cl) = w8; } } __builtin_amdgcn_sched_barrier(0); }
    }
};
template <bool F8OUT> struct EpiResidual {
    static constexpr bool PERM = true, AFTER_DRAIN = false, PROBE_TWICE = false;
    const bf16_t* res_in; bf16_t* HB; ssq_t* ssq_out; float sc; unsigned char* HB8;
    __device__ __forceinline__ void operator()(const f32x4 (&acc)[2][2][4][2], const Unit& u, int wr, int wc, int fr, int fq) const {
        asm volatile("" : "+v"(fr), "+v"(fq));
        const int c0 = u.pn * 256 + wc * 32 + 8 * fq;
#pragma unroll
        for (int ai = 0; ai < 2; ++ai)
#pragma unroll
            for (int m = 0; m < 4; ++m) { const int row = u.pm * 256 + ai * 128 + wr * 64 + m * 16 + fr; const unsigned off = (unsigned)row * (unsigned)DM + (unsigned)c0; float q = 0.f;
#pragma unroll
                for (int bj = 0; bj < 2; ++bj) { const u32x4 h = *at32<const u32x4>(res_in, (off + bj * 128) * 2u); const f32x4 a0 = acc[ai][bj][m][0] * sc, a1 = acc[ai][bj][m][1] * sc;
                    const float x0 = bflo(h.x) + a0[0], x1 = bfhi(h.x) + a0[1], x2 = bflo(h.y) + a0[2], x3 = bfhi(h.y) + a0[3], x4 = bflo(h.z) + a1[0], x5 = bfhi(h.z) + a1[1], x6 = bflo(h.w) + a1[2], x7 = bfhi(h.w) + a1[3];
                    u32x4 w; w.x = pk2(x0, x1); w.y = pk2(x2, x3); w.z = pk2(x4, x5); w.w = pk2(x6, x7); *at32<u32x4>(HB, (off + bj * 128) * 2u) = w;
                    if constexpr (F8OUT) { u32x2 w8; w8.x = pk4_fp8(x0, x1, x2, x3); w8.y = pk4_fp8(x4, x5, x6, x7); *at32<u32x2>(HB8, off + bj * 128) = w8; }
                    q += ((x0 * x0 + x1 * x1) + (x2 * x2 + x3 * x3)) + ((x4 * x4 + x5 * x5) + (x6 * x6 + x7 * x7)); }
                q += __shfl_xor(q, 16); q += __shfl_xor(q, 32);
                if (fq == 0) __hip_atomic_fetch_add((GAS ssq_t*)ssq_out + row, ssq_fix(q), RLX_AGENT); }
    }
};
template <bool F8, bool F8OUT = F8> struct EpiSwiGLU {
    static constexpr bool PERM = true, AFTER_DRAIN = false, PROBE_TWICE = true;
    const ssq_t* ssq; void* ACT; int ldc;
    static constexpr int PF_BYTES = 8;
    __device__ __forceinline__ const void* pf_src(const Unit& u) const { return ssq + u.pm * 256; }
    __device__ __forceinline__ void operator()(const f32x4 (&acc)[2][2][4][2], const Unit& u, int wr, int wc, int fr, int fq) const { run<false>(acc, u, wr, wc, fr, fq, nullptr); }
    __device__ __forceinline__ void with_pf(const f32x4 (&acc)[2][2][4][2], const Unit& u, int wr, int wc, int fr, int fq, const LAS unsigned char* sb) const { run<true>(acc, u, wr, wc, fr, fq, sb); }
    template <bool PFD> __device__ __forceinline__ void run(const f32x4 (&acc)[2][2][4][2], const Unit& u, int wr, int wc, int fr, int fq, const LAS unsigned char* sb) const {
        asm volatile("" : "+v"(fr), "+v"(fq));
        const int cl = wc * 32 + 8 * fq;
#pragma unroll
        for (int ai = 0; ai < 2; ++ai)
#pragma unroll
            for (int m = 0; m < 4; ++m) { const int rl = ai * 128 + wr * 64 + m * 16 + fr, row = u.pm * 256 + rl; const float r = (PFD ? rs_from(*(const LAS unsigned long long*)(sb + rl * 8)) : rs_of(ssq, row)) * (F8 ? GU8_UNSCALE : 1.f); float o[2][4];
#pragma unroll
                for (int n = 0; n < 2; ++n)
#pragma unroll
                    for (int j = 0; j < 4; j += 2) { const f32x2 v = swiglu_pk((f32x2){acc[ai][0][m][n][j], acc[ai][0][m][n][j + 1]}, (f32x2){acc[ai][1][m][n][j], acc[ai][1][m][n][j + 1]}, r, F8OUT ? r * ACT8_SCALE : r); o[n][j] = v.x; o[n][j + 1] = v.y; }
                if constexpr (F8OUT) { u32x2 w; w.x = pk4_fp8(o[0][0], o[0][1], o[0][2], o[0][3]); w.y = pk4_fp8(o[1][0], o[1][1], o[1][2], o[1][3]); *at32<u32x2>(ACT, (unsigned)row * (unsigned)ldc + (unsigned)(u.pn * 128 + cl)) = w; }
                else { u32x4 w; w.x = pk2(o[0][0], o[0][1]); w.y = pk2(o[0][2], o[0][3]); w.z = pk2(o[1][0], o[1][1]); w.w = pk2(o[1][2], o[1][3]); *at32<u32x4>(ACT, ((unsigned)row * (unsigned)ldc + (unsigned)(u.pn * 128 + cl)) * 2u) = w; } }
    }
};
struct EpiOddIn {
    static constexpr bool PERM = true, AFTER_DRAIN = false, PROBE_TWICE = false;
    const ssq_t* ssq; bf16_t *BG, *Z; float sc;
    static constexpr int PF_BYTES = 8;
    __device__ __forceinline__ const void* pf_src(const Unit& u) const { return ssq + u.pm * 256; }
    __device__ __forceinline__ void operator()(const f32x4 (&acc)[2][2][4][2], const Unit& u, int wr, int wc, int fr, int fq) const { run<false>(acc, u, wr, wc, fr, fq, nullptr); }
    __device__ __forceinline__ void with_pf(const f32x4 (&acc)[2][2][4][2], const Unit& u, int wr, int wc, int fr, int fq, const LAS unsigned char* sb) const { run<true>(acc, u, wr, wc, fr, fq, sb); }
    template <bool PFD> __device__ __forceinline__ void run(const f32x4 (&acc)[2][2][4][2], const Unit& u, int wr, int wc, int fr, int fq, const LAS unsigned char* sb) const {
        asm volatile("" : "+v"(fr), "+v"(fq));
        const int cl = wc * 32 + 8 * fq;
#pragma unroll
        for (int ai = 0; ai < 2; ++ai)
#pragma unroll
            for (int m = 0; m < 4; ++m) { const int rl = ai * 128 + wr * 64 + m * 16 + fr, row = u.pm * 256 + rl; const float r = (PFD ? rs_from(*(const LAS unsigned long long*)(sb + rl * 8)) : rs_of(ssq, row)) * sc;
                if (u.pn < 8) {
#pragma unroll
                    for (int bj = 0; bj < 2; ++bj) { const f32x4 v0 = acc[ai][bj][m][0] * r, v1 = acc[ai][bj][m][1] * r;
                        u32x4 w; w.x = pk2(v0[0], v0[1]); w.y = pk2(v0[2], v0[3]); w.z = pk2(v1[0], v1[1]); w.w = pk2(v1[2], v1[3]);
                        *at32<u32x4>(BG, ((unsigned)row * (unsigned)DM + (unsigned)(u.pn * 256 + bj * 128 + cl)) * 2u) = w; }
                } else { const float r2 = r * r; const f32x4 v0 = acc[ai][0][m][0] * acc[ai][1][m][0] * r2, v1 = acc[ai][0][m][1] * acc[ai][1][m][1] * r2;
                    u32x4 w; w.x = pk2(v0[0], v0[1]); w.y = pk2(v0[2], v0[3]); w.z = pk2(v1[0], v1[1]); w.w = pk2(v1[2], v1[3]);
                    *at32<u32x4>(Z, ((unsigned)row * (unsigned)DM + (unsigned)((u.pn - 8) * 128 + cl)) * 2u) = w; } }
    }
};

template <bool GATHER_> struct MoeOrder {
    static constexpr bool GATHER = GATHER_;
    int tp[NEXP + 1], cnt[NEXP]; int nN, G, c; const char *A0, *B0; long a_rt, b_e, b_sn; const int* rowtok; unsigned row_bytes;
    __device__ __forceinline__ void init(const unsigned* cntw, int nN_, int G_, int c_) { nN = nN_; G = G_; c = c_; tp[0] = 0;
#pragma unroll
        for (int e = 0; e < NEXP; ++e) { int v = (int)__builtin_amdgcn_readfirstlane(__hip_atomic_load(cntw + 64 * e, RLX_AGENT)); v = v < 0 ? 0 : (v > ECAP ? ECAP : v); cnt[e] = v; tp[e + 1] = tp[e] + ((v + 255) >> 8); } }
    __device__ __forceinline__ bool next(int i, Unit& u) const {
        const long L = (long)i * G + c; const int nM = tp[NEXP]; if (L >= (long)nM * nN) return false;
        int rt, pn; pg8::tile_of((int)L, nM, nN, rt, pn); int e = 0;
#pragma unroll
        for (int k = 1; k < NEXP; ++k) e = (rt >= tp[k]) ? k : e;
        int ce = cnt[0], te = tp[0];
#pragma unroll
        for (int k = 1; k < NEXP; ++k) { ce = (e == k) ? cnt[k] : ce; te = (e == k) ? tp[k] : te; }
        u.pm = rt; u.pn = pn; u.x0 = e; u.x1 = (rt - te) * 256; u.x2 = ce;
        u.a = A0 + (GATHER_ ? 0 : (long)rt * a_rt); u.b = B0 + e * b_e + pn * b_sn; return true;
    }
    __device__ __forceinline__ unsigned goff(const Unit& u, int r) const {
        const int ep = u.x1 + r; const int tok = (ep < u.x2) ? ((const GAS int*)rowtok)[u.x0 * ECAP + ep] : 0; return (unsigned)tok * row_bytes;
    }
};
template <bool F8> struct EpiMoeGU {
    static constexpr bool PERM = true, AFTER_DRAIN = false, PROBE_TWICE = true;
    const float* er; void* ACTM;
    static constexpr int PF_BYTES = 4;
    __device__ __forceinline__ const void* pf_src(const Unit& u) const { return er + u.x0 * ECAP + u.x1; }
    __device__ __forceinline__ void operator()(const f32x4 (&acc)[2][2][4][2], const Unit& u, int wr, int wc, int fr, int fq) const { run<false>(acc, u, wr, wc, fr, fq, nullptr); }
    __device__ __forceinline__ void with_pf(const f32x4 (&acc)[2][2][4][2], const Unit& u, int wr, int wc, int fr, int fq, const LAS unsigned char* sb) const { run<true>(acc, u, wr, wc, fr, fq, sb); }
    template <bool PFD> __device__ __forceinline__ void run(const f32x4 (&acc)[2][2][4][2], const Unit& u, int wr, int wc, int fr, int fq, const LAS unsigned char* sb) const {
        asm volatile("" : "+v"(fr), "+v"(fq));
        const int cl = wc * 32 + 8 * fq;
#pragma unroll
        for (int ai = 0; ai < 2; ++ai)
#pragma unroll
            for (int m = 0; m < 4; ++m) { const int i = ai * 128 + wr * 64 + m * 16 + fr, ep = u.x1 + i; const float r = ((ep < u.x2) ? (PFD ? *(const LAS float*)(sb + i * 4) : ((const GAS float*)er)[u.x0 * ECAP + ep]) : 0.f) * (F8 ? GU8_UNSCALE : 1.f); float o[2][4];
#pragma unroll
                for (int n = 0; n < 2; ++n)
#pragma unroll
                    for (int j = 0; j < 4; j += 2) { const f32x2 v = swiglu_pk((f32x2){acc[ai][0][m][n][j], acc[ai][0][m][n][j + 1]}, (f32x2){acc[ai][1][m][n][j], acc[ai][1][m][n][j + 1]}, r, F8 ? r * ACT8_SCALE : r); o[n][j] = v.x; o[n][j + 1] = v.y; }
                if constexpr (F8) { u32x2 w; w.x = pk4_fp8(o[0][0], o[0][1], o[0][2], o[0][3]); w.y = pk4_fp8(o[1][0], o[1][1], o[1][2], o[1][3]); *at32<u32x2>(ACTM, (unsigned)(u.pm * 256 + i) * (unsigned)EXD + (unsigned)(u.pn * 128 + cl)) = w; }
                else { u32x4 w; w.x = pk2(o[0][0], o[0][1]); w.y = pk2(o[0][2], o[0][3]); w.z = pk2(o[1][0], o[1][1]); w.w = pk2(o[1][2], o[1][3]); *at32<u32x4>(ACTM, ((unsigned)(u.pm * 256 + i) * (unsigned)EXD + (unsigned)(u.pn * 128 + cl)) * 2u) = w; } }
    }
};
struct EpiMoeDown {
    static constexpr bool PERM = true, AFTER_DRAIN = false, PROBE_TWICE = false;
    const float* ew; bf16_t* YC; float sc;
    static constexpr int PF_BYTES = 4;
    __device__ __forceinline__ const void* pf_src(const Unit& u) const { return ew + u.x0 * ECAP + u.x1; }
    __device__ __forceinline__ void operator()(const f32x4 (&acc)[2][2][4][2], const Unit& u, int wr, int wc, int fr, int fq) const { run<false>(acc, u, wr, wc, fr, fq, nullptr); }
    __device__ __forceinline__ void with_pf(const f32x4 (&acc)[2][2][4][2], const Unit& u, int wr, int wc, int fr, int fq, const LAS unsigned char* sb) const { run<true>(acc, u, wr, wc, fr, fq, sb); }
    template <bool PFD> __device__ __forceinline__ void run(const f32x4 (&acc)[2][2][4][2], const Unit& u, int wr, int wc, int fr, int fq, const LAS unsigned char* sb) const {
        asm volatile("" : "+v"(fr), "+v"(fq));
        const int cl = wc * 32 + 8 * fq;
#pragma unroll
        for (int ai = 0; ai < 2; ++ai)
#pragma unroll
            for (int m = 0; m < 4; ++m) { const int i = ai * 128 + wr * 64 + m * 16 + fr, ep = u.x1 + i; const float wt = ((ep < u.x2) ? (PFD ? *(const LAS float*)(sb + i * 4) : ((const GAS float*)ew)[u.x0 * ECAP + ep]) : 0.f) * sc;
#pragma unroll
                for (int bj = 0; bj < 2; ++bj) { const f32x4 v0 = acc[ai][bj][m][0] * wt, v1 = acc[ai][bj][m][1] * wt;
                    u32x4 w; w.x = pk2(v0[0], v0[1]); w.y = pk2(v0[2], v0[3]); w.z = pk2(v1[0], v1[1]); w.w = pk2(v1[2], v1[3]);
                    *at32<u32x4>(YC, ((unsigned)(u.pm * 256 + i) * (unsigned)DM + (unsigned)(u.pn * 256 + bj * 128 + cl)) * 2u) = w; } }
    }
};

struct Frame {
    LAS unsigned char* lds;
    volatile LAS unsigned* MISC;
    gu32* ctl;
    int tid, lane, wave, G, bid;
    unsigned char* ws;
    const float* const* in;
};
template <class T> __device__ __forceinline__ T* wsp(const Frame& F, size_t off) { return (T*)(F.ws + off); }

__device__ __forceinline__ int conv_src_col(int mode, int N, int n) {
    if (mode == 0) return n;
    if (mode == 1) { const int t = n >> 8, w = n & 255; return (w < 128) ? t * 128 + w : (N >> 1) + t * 128 + (w - 128); }
    if (n < 2048) return n;
    const int np = n - 2048, t = np >> 8, w = np & 255; return 2048 + ((w < 128) ? t * 128 + w : 2048 + t * 128 + (w - 128));
}
struct ConvJob { const float* W; bf16_t* WT; const float* gain; const float* scale; int K, N, mode, start; };
constexpr int N_CONV_JOBS = 52;
#ifndef MK_CV_SH
#define MK_CV_SH 1
#endif
constexpr int CV_SH = MK_CV_SH;
#ifndef MK_STEAL_N
#define MK_STEAL_N 0
#endif
__device__ __forceinline__ ConvJob conv_job_desc(const Frame& F, int j, int& deadline) {
    const int i = j / 26, q = j % 26; const int pb = 1 + 14 * i;
    int r, d;
    if (q == 0) { r = 0; d = 0; } else if (q < 5) { r = q; d = 2; } else if (q == 5) { r = 5; d = 4; } else if (q == 6) { r = 8; d = 5; } else if (q == 7) { r = 9; d = 6; }
    else if (q == 8) { r = 6; d = 7; } else if (q == 9) { r = 7; d = 9; } else if (q < 18) { r = q; d = 11; } else { r = q; d = 12; }
    deadline = pb + d;
    ConvJob J; J.gain = nullptr; J.scale = nullptr; J.mode = 0; J.start = 0;
    if (r == 0) { J.W = F.in[4] + (size_t)i * DM * EIN; J.K = DM; J.N = EIN; J.WT = wsp<bf16_t>(F, WS_EWIN) + (size_t)i * EIN * DM; J.gain = F.in[1] + (2 * i) * DM; J.mode = f8_ein(i) ? 256 : 0; }
    else if (r < 5) { const int g = r - 1; J.W = F.in[5] + (size_t)(i * 4 + g) * 65536; J.K = 256; J.N = 256; J.WT = wsp<bf16_t>(F, WS_EWP) + (size_t)(i * 4 + g) * 65536; J.scale = F.in[6] + i * 1024 + g * 256; }
    else if (r == 5) { J.W = F.in[7] + (size_t)i * DM * DM; J.K = DM; J.N = DM; J.WT = wsp<bf16_t>(F, WS_EWOUT) + (size_t)i * DM * DM; J.mode = f8_eout(i) ? 256 : 0; }
    else if (r == 6) { J.W = F.in[8] + (size_t)i * DM * OIN; J.K = DM; J.N = OIN; J.WT = wsp<bf16_t>(F, WS_OWIN) + (size_t)i * OIN * DM; J.gain = F.in[1] + (2 * i + 1) * DM; J.mode = 2 | (f8_oin(i) ? 256 : 0); }
    else if (r == 7) { J.W = F.in[10] + (size_t)i * DM * DM; J.K = DM; J.N = DM; J.WT = wsp<bf16_t>(F, WS_OWOUT) + (size_t)i * DM * DM; J.mode = f8_oout(i) ? 256 : 0; }
    else if (r == 8) { J.W = F.in[11] + (size_t)i * DM * 2 * FFN; J.K = DM; J.N = 2 * FFN; J.WT = wsp<bf16_t>(F, WS_FGU) + (size_t)i * 2 * FFN * DM; J.gain = F.in[2] + (2 * i) * DM; J.mode = 1 | (f8_ffn(i) ? 256 : 0); }
    else if (r == 9) { J.W = F.in[12] + (size_t)i * FFN * DM; J.K = FFN; J.N = DM; J.WT = wsp<bf16_t>(F, WS_FDN) + (size_t)i * DM * FFN; J.mode = f8_dn(i) ? 256 : 0; }
    else if (r < 18) { const int e = r - 10; J.W = F.in[14] + (size_t)(i * NEXP + e) * DM * 2 * EXD; J.K = DM; J.N = 2 * EXD; J.WT = wsp<bf16_t>(F, WS_MGU) + (size_t)(i * NEXP + e) * 2 * EXD * DM; J.gain = F.in[2] + (2 * i + 1) * DM; J.mode = 1 | (f8_moe(i) ? 256 : 0); }
    else { const int e = r - 18; J.W = F.in[15] + (size_t)(i * NEXP + e) * EXD * DM; J.K = EXD; J.N = DM; J.WT = wsp<bf16_t>(F, WS_MDN) + (size_t)(i * NEXP + e) * DM * EXD; J.mode = f8_moe(i) ? 256 : 0; }
    return J;
}
constexpr int CV_JP = 0, CV_JI = 1664, CV_JD = 2496, CV_ST = 2704, CV_GT = 2816, CV_MAXG = 24;
#define CV_PTRS(F_) LAS unsigned long long* jp = (LAS unsigned long long*)((F_).lds + LDSX_OFF + CV_JP); LAS int* ji = (LAS int*)((F_).lds + LDSX_OFF + CV_JI); LAS int* jd = (LAS int*)((F_).lds + LDSX_OFF + CV_JD); LAS int* st = (LAS int*)((F_).lds + LDSX_OFF + CV_ST); \
    LAS int* gst = (LAS int*)((F_).lds + LDSX_OFF + CV_GT); LAS int* gdl = gst + CV_MAXG + 1; (void)jp; (void)ji; (void)jd; (void)st; (void)gst; (void)gdl
__device__ __forceinline__ void conv_init(const Frame& F) {
    CV_PTRS(F);
    if (F.tid < N_CONV_JOBS) { int dl; const ConvJob J = conv_job_desc(F, F.tid, dl); const int j = F.tid;
        jp[j * 4 + 0] = (unsigned long long)J.W; jp[j * 4 + 1] = (unsigned long long)J.WT; jp[j * 4 + 2] = (unsigned long long)J.gain; jp[j * 4 + 3] = (unsigned long long)J.scale;
        ji[j * 4 + 0] = J.K; ji[j * 4 + 1] = J.N; ji[j * 4 + 2] = J.mode; ji[j * 4 + 3] = 0; jd[j] = dl; }
    __syncthreads();
    if (F.tid == 0) { int acc = 0, ng = 0;
        for (int j = 0; j < N_CONV_JOBS; ++j) { if (j == 0 || jd[j] != jd[j - 1]) { gst[ng] = acc; gdl[ng] = jd[j]; ++ng; } ji[j * 4 + 3] = acc; acc += (ji[j * 4 + 0] >> 7) * (ji[j * 4 + 1] >> 7); }
        gst[ng] = acc; st[0] = acc; st[2] = 0; st[3] = 0; st[5] = (F.bid < gst[1]) ? F.bid : -1; st[6] = (F.bid < gst[1]) ? 0 : 1; st[7] = ng; st[8] = -1; st[9] = -1; }
    __syncthreads();
}
__device__ __forceinline__ unsigned* conv_qhead(const Frame& F, int gi) { return (unsigned*)(F.ctl + CW_CONVQ + (gi * 8 + (F.bid & (CV_SH - 1))) * 32); }
__device__ __forceinline__ int conv_claim_finish(const Frame& F, unsigned l) {
    CV_PTRS(F);
    int cg = st[6]; const int ng = st[7], sh = F.bid & (CV_SH - 1); int res = -1;
    while (cg < ng) {
        const int r = (int)((l + (cg == 0 ? (unsigned)(F.G / CV_SH) : 0u)) * (unsigned)CV_SH) + sh;
        if (r < gst[cg + 1] - gst[cg]) { res = gst[cg] + r; break; }
        if (++cg < ng) l = xb_add(conv_qhead(F, cg), 1u);
    }
    st[6] = cg; return res;
}
struct ConvRegs { f32x4 v[8]; f32x4 sn; float gk[8]; bf16_t* WT; int K, kb, n0, f8; };
__device__ __forceinline__ void conv_load(const Frame& F, int g, int j, ConvRegs& R) {
    CV_PTRS(F);
    const float* W = (const float*)jp[j * 4 + 0]; const float* gain = (const float*)jp[j * 4 + 2]; const float* scale = (const float*)jp[j * 4 + 3];
    const int N = ji[j * 4 + 1], mode = ji[j * 4 + 2], it = g - ji[j * 4 + 3], nblk = N >> 7;
    R.WT = (bf16_t*)jp[j * 4 + 1]; R.K = ji[j * 4 + 0]; R.kb = it / nblk; R.n0 = (it % nblk) << 7; R.f8 = (mode >> 8) & 1;
    const int sc = conv_src_col(mode & 255, N, R.n0 + 4 * (F.lane & 31)), k0 = R.kb * 128 + F.wave * 16 + 8 * (F.lane >> 5);
#pragma unroll
    for (int r = 0; r < 8; ++r) R.v[r] = *(const GAS f32x4*)(W + (size_t)(k0 + r) * N + sc);
    R.sn = scale ? *(const GAS f32x4*)(scale + sc) : (f32x4){1.f, 1.f, 1.f, 1.f};
#pragma unroll
    for (int r = 0; r < 8; ++r) R.gk[r] = gain ? ((const GAS float*)gain)[k0 + r] : 1.f;
}
__device__ __forceinline__ void conv_pack(const Frame& F, const ConvRegs& R, LAS unsigned* tile) {
    const int nl = 4 * (F.lane & 31), kl = F.wave * 16 + 8 * (F.lane >> 5);
    if (R.f8) {
#pragma unroll
        for (int hh = 0; hh < 2; ++hh)
#pragma unroll
            for (int q = 0; q < 4; ++q) { const float s_ = R.sn[q] * W8_SCALE;
                tile[(nl + q) * 33 + (kl >> 2) + hh] = pk4_fp8(R.v[4 * hh][q] * (R.gk[4 * hh] * s_), R.v[4 * hh + 1][q] * (R.gk[4 * hh + 1] * s_), R.v[4 * hh + 2][q] * (R.gk[4 * hh + 2] * s_), R.v[4 * hh + 3][q] * (R.gk[4 * hh + 3] * s_)); }
    } else {
#pragma unroll
        for (int rp = 0; rp < 4; ++rp)
#pragma unroll
            for (int q = 0; q < 4; ++q) tile[(nl + q) * 65 + (kl >> 1) + rp] = pk2(R.v[2 * rp][q] * (R.gk[2 * rp] * R.sn[q]), R.v[2 * rp + 1][q] * (R.gk[2 * rp + 1] * R.sn[q]));
    }
}
__device__ __forceinline__ void conv_store(const Frame& F, const LAS unsigned* tile, bf16_t* WT, int K, int kb, int n0, int f8) {
    if (f8) {
#pragma unroll
        for (int p = 0; p < 2; ++p) { const int row = p * 64 + (F.tid >> 3), c = F.tid & 7; const LAS unsigned* s = tile + row * 33 + 4 * c;
            u32x4 o; o.x = s[0]; o.y = s[1]; o.z = s[2]; o.w = s[3];
            *(GAS u32x4*)((unsigned char*)WT + (size_t)(n0 + row) * K + kb * 128 + 16 * c) = o; }
    } else {
#pragma unroll
        for (int p = 0; p < 4; ++p) { const int row = p * 32 + (F.tid >> 4), c = F.tid & 15; const LAS unsigned* s = tile + row * 65 + 4 * c;
            u32x4 o; o.x = s[0]; o.y = s[1]; o.z = s[2]; o.w = s[3];
            *(GAS u32x4*)(WT + (size_t)(n0 + row) * K + kb * 128 + 8 * c) = o; }
    }
}
__device__ __forceinline__ int conv_run(const Frame& F0, int max_phase, int extra) {
    Frame F = F0; { int t_ = threadIdx.x; asm volatile("" : "+v"(t_)); F.tid = t_; F.lane = t_ & 63; F.wave = __builtin_amdgcn_readfirstlane(t_ >> 6); }
    CV_PTRS(F);
    __syncthreads();
    int g = st[5], j = st[2], par = st[3], slot = 0, n = 0; const bool t0 = (F.tid == 0);
#define CV_ELIGIBLE(g_) ({ bool ok_ = false; if ((g_) >= 0) { while ((g_) >= ji[j * 4 + 3] + (ji[j * 4 + 0] >> 7) * (ji[j * 4 + 1] >> 7)) ++j; ok_ = jd[j] <= max_phase; if (!ok_ && extra > 0) { --extra; ok_ = true; } } ok_; })
    ConvRegs R; unsigned cl = 0u;
    bool have = CV_ELIGIBLE(g);
    if (have) { if (t0 && st[6] < st[7]) cl = xb_add(conv_qhead(F, st[6]), 1u); conv_load(F, g, j, R); if (t0) st[8] = conv_claim_finish(F, cl); }
    while (have) {
        LAS unsigned* tile = (LAS unsigned*)(F.lds + RING_OFF) + par * (128 * 65);
        conv_pack(F, R, tile);
        bf16_t* const WTc = R.WT; const int Kc = R.K, kbc = R.kb, n0c = R.n0, f8c = R.f8;
        ++n; par ^= 1;
        __syncthreads();
        g = st[8 + slot];
        have = CV_ELIGIBLE(g);
        if (have) { if (t0 && st[6] < st[7]) cl = xb_add(conv_qhead(F, st[6]), 1u); conv_load(F, g, j, R); }
        conv_store(F, tile, WTc, Kc, kbc, n0c, f8c);
        if (have && t0) st[8 + (slot ^ 1)] = conv_claim_finish(F, cl);
        slot ^= 1;
    }
#undef CV_ELIGIBLE
    __syncthreads();
    if (t0) { st[5] = g; st[2] = j; st[3] = par; }
    return n;
}
__device__ __forceinline__ void p_prologue(const Frame& F) {
    conv_init(F);
    const int gw = F.bid * NWAVES + F.wave, NGW = F.G * NWAVES; bf16_t* HB = wsp<bf16_t>(F, WS_HB); ssq_t* ssq0 = (ssq_t*)(F.ctl + CW_SSQ);
    for (int m0 = gw; m0 < MTOK; m0 += 2 * NGW) {
        f32x4 xv[2][8];
#pragma unroll
        for (int u = 0; u < 2; ++u) { const int m = (m0 + u * NGW < MTOK) ? m0 + u * NGW : m0; const GAS f32x4* xr = (const GAS f32x4*)(F.in[0] + (size_t)m * DM) + F.lane;
#pragma unroll
            for (int jj = 0; jj < 8; ++jj) xv[u][jj] = xr[64 * jj]; }
#pragma unroll
        for (int u = 0; u < 2; ++u) { const int m = m0 + u * NGW; if (m >= MTOK) continue; GAS u32x2* o = (GAS u32x2*)(HB + (size_t)m * DM) + F.lane; float q = 0.f;
#pragma unroll
            for (int jj = 0; jj < 8; ++jj) { const f32x4 vv = xv[u][jj]; q += (vv[0] * vv[0] + vv[1] * vv[1]) + (vv[2] * vv[2] + vv[3] * vv[3]); u32x2 w; w.x = pk2(vv[0], vv[1]); w.y = pk2(vv[2], vv[3]); o[64 * jj] = w;
                if (f8_ein(0)) ((GAS unsigned*)(wsp<unsigned char>(F, WS_HB8) + (size_t)m * DM))[64 * jj + F.lane] = pk4_fp8(vv[0], vv[1], vv[2], vv[3]); }
            q = wave_sum(q); if (F.lane == 0) ((GAS ssq_t*)ssq0)[m] = ssq_fix(q); } }
}
#define PP_ACC(s_, v_, op_) do { s_[0] op_ bflo(v_.x); s_[1] op_ bfhi(v_.x); s_[2] op_ bflo(v_.y); s_[3] op_ bfhi(v_.y); s_[4] op_ bflo(v_.z); s_[5] op_ bfhi(v_.z); s_[6] op_ bflo(v_.w); s_[7] op_ bfhi(v_.w); } while (0)
__device__ __forceinline__ void t_pool_p(const Frame& F, const bf16_t* U, bf16_t* PP) {
    const int gw = F.bid * NWAVES + F.wave, NGW = F.G * NWAVES; constexpr int RUN = 16;
    for (int it = gw; it < (MTOK / RUN) * 2; it += NGW) { const int row0 = (it >> 1) * RUN, c0 = (it & 1) * 512 + F.lane * 8, g = c0 >> 8, w = 2 << g, t0 = row0 & (SEQ - 1);
        const GAS u32x4* up = (const GAS u32x4*)(U + (size_t)row0 * 1024 + c0); GAS u32x4* pp = (GAS u32x4*)(PP + (size_t)row0 * 1024 + c0);
        float s[8];
#pragma unroll
        for (int j = 0; j < 8; ++j) s[j] = 0.f;
#pragma unroll
        for (int k = 1; k < 16; ++k) if (k < w && t0 > 0) { const u32x4 v = up[-128 * k]; PP_ACC(s, v, +=); }
#pragma unroll 8
        for (int i = 0; i < RUN; ++i) { const u32x4 v = up[128 * i]; PP_ACC(s, v, +=);
            const int t = t0 + i, cnt = (t + 1) < w ? (t + 1) : w; const float ic = 1.f / (float)cnt;
            u32x4 o; o.x = pk2(s[0] * ic - bflo(v.x), s[1] * ic - bfhi(v.x)); o.y = pk2(s[2] * ic - bflo(v.y), s[3] * ic - bfhi(v.y));
            o.z = pk2(s[4] * ic - bflo(v.z), s[5] * ic - bfhi(v.z)); o.w = pk2(s[6] * ic - bflo(v.w), s[7] * ic - bfhi(v.w));
            pp[128 * i] = o;
            if (t - w + 1 >= 0) { const u32x4 d = up[128 * (i - w + 1)]; PP_ACC(s, d, -=); } }
    }
}
#undef PP_ACC
__device__ __forceinline__ void t_scan(const Frame& F, const bf16_t* LT, bf16_t* VS) {
    for (int gid = F.bid * (NWAVES * 64) + F.tid; gid < 8 * 16384; gid += F.G * NWAVES * 64) {
        const int bh = gid >> 14, rem = gid & 16383, e = rem >> 6, d4 = (rem & 63) * 4, b = bh >> 2, h = bh & 3; const float cd = __builtin_amdgcn_exp2f(lg_gamma(h) * 256.f);
        f32x4 s = (f32x4){0.f, 0.f, 0.f, 0.f};
#pragma unroll
        for (int g = 0; g < 32; ++g) { const size_t unit = (size_t)((b * 32 + g) * 4 + h);
            u32x2 w; w.x = pk2(s[0], s[1]); w.y = pk2(s[2], s[3]); *(GAS u32x2*)(VS + (unit * 256 + e) * 512 + 256 + d4) = w;
            const u32x2 l = *(const GAS u32x2*)(LT + (unit * 256 + e) * 256 + d4); s = s * cd + (f32x4){bflo(l.x), bfhi(l.x), bflo(l.y), bfhi(l.y)}; }
    }
}
__device__ __forceinline__ void t_conv(const Frame& F, const bf16_t* BG, const bf16_t* Z, const float* cw, bf16_t* Y, unsigned char* Y8) {
    const int gw = F.bid * NWAVES + F.wave, NGW = F.G * NWAVES; constexpr int RUN = 32;
    for (int it = gw; it < (MTOK / RUN) * 4; it += NGW) { const int row0 = (it >> 2) * RUN, c0 = (it & 3) * 512 + F.lane * 8, t0 = row0 & (SEQ - 1);
        float w0[8], w1[8], w2[8];
#pragma unroll
        for (int h = 0; h < 2; ++h) { const f32x4 a = *(const GAS f32x4*)(cw + c0 + 4 * h), b = *(const GAS f32x4*)(cw + DM + c0 + 4 * h), c = *(const GAS f32x4*)(cw + 2 * DM + c0 + 4 * h);
#pragma unroll
            for (int j = 0; j < 4; ++j) { w0[4 * h + j] = a[j]; w1[4 * h + j] = b[j]; w2[4 * h + j] = c[j]; } }
        u32x4 z0 = (u32x4){0u, 0u, 0u, 0u}, z1 = z0;
        if (t0 >= 2) { z0 = *(const GAS u32x4*)(Z + (size_t)(row0 - 2) * DM + c0); z1 = *(const GAS u32x4*)(Z + (size_t)(row0 - 1) * DM + c0); }
#pragma unroll 8
        for (int i = 0; i < RUN; ++i) { const size_t off = (size_t)(row0 + i) * DM + c0;
            const u32x4 z2 = *(const GAS u32x4*)(Z + off), bg = *(const GAS u32x4*)(BG + off);
            float o[8];
            o[0] = bflo(bg.x) * (bflo(z0.x) * w0[0] + bflo(z1.x) * w1[0] + bflo(z2.x) * w2[0]); o[1] = bfhi(bg.x) * (bfhi(z0.x) * w0[1] + bfhi(z1.x) * w1[1] + bfhi(z2.x) * w2[1]);
            o[2] = bflo(bg.y) * (bflo(z0.y) * w0[2] + bflo(z1.y) * w1[2] + bflo(z2.y) * w2[2]); o[3] = bfhi(bg.y) * (bfhi(z0.y) * w0[3] + bfhi(z1.y) * w1[3] + bfhi(z2.y) * w2[3]);
            o[4] = bflo(bg.z) * (bflo(z0.z) * w0[4] + bflo(z1.z) * w1[4] + bflo(z2.z) * w2[4]); o[5] = bfhi(bg.z) * (bfhi(z0.z) * w0[5] + bfhi(z1.z) * w1[5] + bfhi(z2.z) * w2[5]);
            o[6] = bflo(bg.w) * (bflo(z0.w) * w0[6] + bflo(z1.w) * w1[6] + bflo(z2.w) * w2[6]); o[7] = bfhi(bg.w) * (bfhi(z0.w) * w0[7] + bfhi(z1.w) * w1[7] + bfhi(z2.w) * w2[7]);
            u32x4 w; w.x = pk2(o[0], o[1]); w.y = pk2(o[2], o[3]); w.z = pk2(o[4], o[5]); w.w = pk2(o[6], o[7]);
            if (!Y8) *(GAS u32x4*)(Y + off) = w;
            z0 = z1; z1 = z2;
            if (Y8) { u32x2 w8; w8.x = pk4_fp8(o[0], o[1], o[2], o[3]); w8.y = pk4_fp8(o[4], o[5], o[6], o[7]); *(GAS u32x2*)(Y8 + off) = w8; } }
    }
}
__device__ __forceinline__ void t_router(const Frame& F, const bf16_t* HB, const ssq_t* ssq, const float* gain, const float* R, unsigned* cntw, int* tok_e, int* tok_pos, int* rowtok, float* er, float* ew) {
    constexpr int RPITCH = 4096 + 16;
    LAS unsigned char* Rh = F.lds + RING_OFF; LAS unsigned char* Rlo = Rh + 8 * RPITCH;
#pragma unroll
    for (int m = 0; m < DM / (NWAVES * 64); ++m) { const int k = F.tid + m * (NWAVES * 64); const f32x4 r0 = *(const GAS f32x4*)(R + (size_t)k * NEXP), r1 = *(const GAS f32x4*)(R + (size_t)k * NEXP + 4); const float gk = ((const GAS float*)gain)[k];
#pragma unroll
        for (int e = 0; e < NEXP; ++e) { const float v = (e < 4 ? r0[e & 3] : r1[e & 3]) * gk;
            const unsigned hi = pk2(v, 0.f) & 0xffffu; const float rem = v - __uint_as_float(hi << 16);
            *(LAS bf16_t*)(Rh + e * RPITCH + k * 2) = (bf16_t)hi; *(LAS bf16_t*)(Rlo + e * RPITCH + k * 2) = (bf16_t)(pk2(rem, 0.f) & 0xffffu); } }
    if (F.tid < NEXP) ((LAS unsigned*)(F.lds + RING_OFF + 16 * RPITCH + 64 + 4096))[F.tid] = 0u;
    __syncthreads();
    const int gw = F.bid * NWAVES + F.wave, NGW = F.G * NWAVES, fr = F.lane & 15, fq = F.lane >> 4, kh = F.wave & 1;
    LAS f32x4* xch = (LAS f32x4*)(F.lds + RING_OFF + 16 * RPITCH + 64) + (F.wave >> 1) * 64 + F.lane;
    LAS unsigned* lcnt = (LAS unsigned*)(F.lds + RING_OFF + 16 * RPITCH + 64 + 4096);
    for (int grp0 = 0; grp0 < MTOK / 16; grp0 += NGW >> 1) { const int grp = grp0 + (gw >> 1); const bool live = grp < MTOK / 16; const int t = (live ? grp : 0) * 16 + fr;
        const GAS bf16x8* hrow = (const GAS bf16x8*)(HB + (size_t)t * DM) + fq + kh * (DM / 16);
        const LAS bf16x8* rh = (const LAS bf16x8*)(Rh + (fr & 7) * RPITCH) + fq + kh * (DM / 16); const LAS bf16x8* rl = (const LAS bf16x8*)(Rlo + (fr & 7) * RPITCH) + fq + kh * (DM / 16);
        f32x4 ah = (f32x4){0.f, 0.f, 0.f, 0.f}, al = ah;
#pragma unroll 16
        for (int s = 0; s < DM / 64; ++s) { const bf16x8 hv = hrow[4 * s];
            ah = __builtin_amdgcn_mfma_f32_16x16x32_bf16(rh[4 * s], hv, ah, 0, 0, 0); al = __builtin_amdgcn_mfma_f32_16x16x32_bf16(rl[4 * s], hv, al, 0, 0, 0); }
        ah = ah + al;
        if (kh) *xch = ah;
        __syncthreads();
        if (!kh) ah = ah + *xch;
        __syncthreads();
        const bool act = !kh && live;
        int e1 = 0, e2 = 1; float w1 = 0.f, w2 = 0.f, r = 0.f;
        if (act) {
            r = rs_of(ssq, t);
            float p[NEXP];
#pragma unroll
            for (int j = 0; j < 4; ++j) { const float mine = ah[j] * r, other = __shfl_xor(mine, 16); p[j] = (fq & 1) ? other : mine; p[4 + j] = (fq & 1) ? mine : other; }
            float v1 = p[0];
#pragma unroll
            for (int e = 1; e < NEXP; ++e) if (p[e] > v1) { v1 = p[e]; e1 = e; }
            e2 = -1; float v2 = -3.0e38f;
#pragma unroll
            for (int e = 0; e < NEXP; ++e) if (e != e1 && p[e] > v2) { v2 = p[e]; e2 = e; }
            const float ex = __builtin_amdgcn_exp2f((v2 - v1) * 1.44269504f); w1 = 1.f / (1.f + ex); w2 = ex * w1;
        }
        unsigned l1 = 0u, l2 = 0u;
        if (act && fq == 0) { l1 = __hip_atomic_fetch_add(lcnt + e1, 1u, __ATOMIC_RELAXED, __HIP_MEMORY_SCOPE_WORKGROUP); l2 = __hip_atomic_fetch_add(lcnt + e2, 1u, __ATOMIC_RELAXED, __HIP_MEMORY_SCOPE_WORKGROUP); }
        __syncthreads();
        if (F.tid < NEXP) { const unsigned c = lcnt[F.tid]; lcnt[NEXP + F.tid] = c ? __hip_atomic_fetch_add((GAS unsigned*)cntw + 64 * F.tid, c, RLX_AGENT) : 0u; lcnt[F.tid] = 0u; }
        __syncthreads();
        if (act && fq == 0) {
            const int p1 = (int)(lcnt[NEXP + e1] + l1), p2 = (int)(lcnt[NEXP + e2] + l2);
            GAS int* te_ = (GAS int*)tok_e; GAS int* tp_ = (GAS int*)tok_pos; GAS int* rt_ = (GAS int*)rowtok; GAS float* er_ = (GAS float*)er; GAS float* ew_ = (GAS float*)ew;
            te_[2 * t] = e1; te_[2 * t + 1] = e2; tp_[2 * t] = p1; tp_[2 * t + 1] = p2;
            if (p1 < ECAP) { rt_[e1 * ECAP + p1] = t; er_[e1 * ECAP + p1] = r; ew_[e1 * ECAP + p1] = w1; }
            if (p2 < ECAP) { rt_[e2 * ECAP + p2] = t; er_[e2 * ECAP + p2] = r; ew_[e2 * ECAP + p2] = w2; } }
    }
    __syncthreads();
}
__device__ __forceinline__ void t_combine(const Frame& F, const bf16_t* HB, bf16_t* HBout, const bf16_t* YC, const unsigned* cntw, const int* tok_e, const int* tok_pos, ssq_t* ssq_next, const float* gfin, float* out, bool final_, unsigned char* HB8) {
    int tp[NEXP + 1]; tp[0] = 0;
#pragma unroll
    for (int e = 0; e < NEXP; ++e) { int v = (int)__builtin_amdgcn_readfirstlane(__hip_atomic_load(cntw + 64 * e, RLX_AGENT)); v = v < 0 ? 0 : (v > ECAP ? ECAP : v); tp[e + 1] = tp[e] + ((v + 255) >> 8); }
    const int gw = F.bid * NWAVES + F.wave, NGW = F.G * NWAVES;
    for (int t0 = gw; t0 < MTOK; t0 += 2 * NGW) {
        u32x4 rh[2][4], ra[2][4], rb[2][4]; int tt[2]; bool ok[2];
#pragma unroll
        for (int u = 0; u < 2; ++u) { const int tq = t0 + u * NGW; ok[u] = tq < MTOK; const int t = ok[u] ? tq : t0; tt[u] = t;
            const int e1 = ((const GAS int*)tok_e)[2 * t], e2 = ((const GAS int*)tok_e)[2 * t + 1], p1 = ((const GAS int*)tok_pos)[2 * t], p2 = ((const GAS int*)tok_pos)[2 * t + 1]; int b1 = 0, b2 = 0;
#pragma unroll
            for (int k = 1; k < NEXP; ++k) { b1 = (e1 == k) ? tp[k] : b1; b2 = (e2 == k) ? tp[k] : b2; }
            const size_t s1 = (size_t)b1 * 256 + p1, s2 = (size_t)b2 * 256 + p2;
            const GAS u32x4* hr = (const GAS u32x4*)(HB + (size_t)t * DM) + F.lane; const GAS u32x4* y1 = (const GAS u32x4*)(YC + s1 * DM) + F.lane; const GAS u32x4* y2 = (const GAS u32x4*)(YC + s2 * DM) + F.lane;
#pragma unroll
            for (int j = 0; j < 4; ++j) { rh[u][j] = hr[64 * j]; ra[u][j] = y1[64 * j]; rb[u][j] = y2[64 * j]; } }
#pragma unroll
        for (int u = 0; u < 2; ++u) { if (!ok[u]) continue; const int t = tt[u];
            float v[4][8]; float q = 0.f;
#pragma unroll
            for (int j = 0; j < 4; ++j) { const u32x4 h = rh[u][j], a = ra[u][j], b = rb[u][j];
                v[j][0] = bflo(h.x) + (bflo(a.x) + bflo(b.x)); v[j][1] = bfhi(h.x) + (bfhi(a.x) + bfhi(b.x)); v[j][2] = bflo(h.y) + (bflo(a.y) + bflo(b.y)); v[j][3] = bfhi(h.y) + (bfhi(a.y) + bfhi(b.y));
                v[j][4] = bflo(h.z) + (bflo(a.z) + bflo(b.z)); v[j][5] = bfhi(h.z) + (bfhi(a.z) + bfhi(b.z)); v[j][6] = bflo(h.w) + (bflo(a.w) + bflo(b.w)); v[j][7] = bfhi(h.w) + (bfhi(a.w) + bfhi(b.w));
#pragma unroll
                for (int i = 0; i < 8; ++i) q += v[j][i] * v[j][i]; }
            q = wave_sum(q);
            if (!final_) { GAS u32x4* o = (GAS u32x4*)(HBout + (size_t)t * DM) + F.lane;
#pragma unroll
                for (int j = 0; j < 4; ++j) { u32x4 w; w.x = pk2(v[j][0], v[j][1]); w.y = pk2(v[j][2], v[j][3]); w.z = pk2(v[j][4], v[j][5]); w.w = pk2(v[j][6], v[j][7]); o[64 * j] = w;
                    if (HB8) { u32x2 w8; w8.x = pk4_fp8(v[j][0], v[j][1], v[j][2], v[j][3]); w8.y = pk4_fp8(v[j][4], v[j][5], v[j][6], v[j][7]); ((GAS u32x2*)(HB8 + (size_t)t * DM))[64 * j + F.lane] = w8; } }
                if (F.lane == 0) ((GAS ssq_t*)ssq_next)[t] = ssq_fix(q);
            } else { const float r = __builtin_amdgcn_rsqf(q * (1.f / (float)DM) + RMS_EPS); GAS f32x4* o = (GAS f32x4*)(out + (size_t)t * DM) + 2 * F.lane; const GAS f32x4* gg = (const GAS f32x4*)gfin + 2 * F.lane;
#pragma unroll
                for (int j = 0; j < 4; ++j) { const f32x4 g0 = gg[128 * j], g1 = gg[128 * j + 1];
                    o[128 * j] = (f32x4){v[j][0] * r * g0[0], v[j][1] * r * g0[1], v[j][2] * r * g0[2], v[j][3] * r * g0[3]}; o[128 * j + 1] = (f32x4){v[j][4] * r * g1[0], v[j][5] * r * g1[1], v[j][6] * r * g1[2], v[j][7] * r * g1[3]}; } } }
    }
}

constexpr int N_PHASES = 29;
struct Args { const float* in[16]; float* out; unsigned char* ws; int ph_lo, ph_hi; };
__global__ void __launch_bounds__(NWAVES * 64, 2) fwd_kernel(Args args) {
    extern __shared__ __attribute__((aligned(16))) unsigned char lds_raw[];
    Frame F;
    F.lds = (LAS unsigned char*)lds_raw;
    F.MISC = (volatile LAS unsigned*)(F.lds + MISC_OFF);
    F.tid = threadIdx.x; F.lane = F.tid & 63; F.wave = __builtin_amdgcn_readfirstlane(F.tid >> 6);
    F.G = gridDim.x; F.bid = blockIdx.x;
    F.ws = args.ws; F.ctl = (gu32*)(args.ws + WS_CTL); F.in = args.in;
    for (int u = F.tid; u < (LDS_BYTES - LDSCTL_OFF) / 4; u += NWAVES * 64) ((LAS unsigned*)(F.lds + LDSCTL_OFF))[u] = 0u;
    __syncthreads();
    XcdBarrier bar; bar.bar = (unsigned*)(F.ctl + CW_BAR); bar.x = 0; bar.st = nullptr;
#if MK_ONE_LAUNCH
    bar = xcd_barrier_post((unsigned*)(F.ctl + CW_BAR), F.MISC + 8);
#endif
    const int lo = args.ph_lo, hi = args.ph_hi;
#ifndef MK_KIND_MASK
#define MK_KIND_MASK 0x7fff
#endif
#define KON(kind) (((MK_KIND_MASK) >> (kind)) & 1)
#ifndef MK_DUP_MASK
#define MK_DUP_MASK 0
#endif
#define NREP(kind) ((((MK_DUP_MASK) >> (kind)) & 1) ? 2 : 1)
#ifndef MK_DUP_BAR
#define MK_DUP_BAR 0
#endif
#define DUMMY(kind) (NREP(kind) == 2 && rep_ == 0)
#define IN(k) (lo <= (k) && (k) < hi)
#if MK_ONE_LAUNCH
#ifndef MK_BAR_REP
#define MK_BAR_REP 1
#endif
#define SEAM(k) do { if (IN(k) && IN((k) + 1)) { (void)conv_run(F, (k) + 1, cv_extra); cv_extra = 0; xcd_barrier(bar); } } while (0)
#else
#define SEAM(k) do { } while (0)
#endif
    LAS unsigned char* ring = F.lds + RING_OFF;
    int cv_extra = 0;
#define PH_WS() unsigned char* ws_ = args.ws; asm volatile("" : "+s"(ws_)); Frame Fp = F; { int t_ = threadIdx.x; asm volatile("" : "+v"(t_)); Fp.tid = t_; Fp.lane = t_ & 63; Fp.wave = __builtin_amdgcn_readfirstlane(t_ >> 6); int g_ = gridDim.x, b_ = blockIdx.x; asm volatile("" : "+s"(g_), "+s"(b_)); Fp.G = g_; Fp.bid = b_; } Fp.ws = ws_; Fp.ctl = (gu32*)(ws_ + WS_CTL); ssq_t* ssq = (ssq_t*)(Fp.ctl + CW_SSQ); (void)ssq
#define WSP(T, off) ((T*)(ws_ + (off)))
#define F8_DISPATCH(flagfn, ...) do { if constexpr (flagfn(0) == flagfn(1)) { constexpr bool F8 = flagfn(0); __VA_ARGS__ } else { if (flagfn(lp)) { constexpr bool F8 = true; __VA_ARGS__ } else { constexpr bool F8 = false; __VA_ARGS__ } } } while (0)

    if (KON(0) && IN(0)) for (int rep_ = 0; rep_ < NREP(0); ++rep_) { if (MK_DUP_BAR && rep_ == 1) { asm volatile("" ::: "memory"); xcd_barrier(bar); asm volatile("" ::: "memory"); } PH_WS(); p_prologue(Fp); } SEAM(0);

    for (int lp = 0; lp < 2; ++lp) {
        const int pb = 1 + lp * 14, a0 = lp * 4;
        if (KON(1) && IN(pb + 0)) for (int rep_ = 0; rep_ < NREP(1); ++rep_) { if (MK_DUP_BAR && rep_ == 1) { asm volatile("" ::: "memory"); xcd_barrier(bar); asm volatile("" ::: "memory"); } PH_WS();
            F8_DISPATCH(f8_ein, { constexpr int ES = F8 ? 1 : 2; constexpr float SC = F8 ? GU8_UNSCALE : 1.f;
                const char* EWIN = WSP(char, WS_EWIN) + (size_t)lp * EIN * DM * 2; const char* HBA = F8 ? WSP(char, WS_HB8) : WSP(char, WS_HB);
                { const pg8::GridOrder S = pg8::grid_order(64, 16, Fp.G, Fp.bid, HBA, 256L * DM * ES, 0, EWIN, 0, 256L * DM * ES, 12, 4);
                  const EpiEvenIn E{ssq + (size_t)a0 * MTOK, WSP(bf16_t, WS_U), WSP(bf16_t, WS_QP), WSP(bf16_t, WS_KN), WSP(bf16_t, WS_KT), WSP(bf16_t, WS_SG), SC};
                  pg8::gemm_phase<EpiEvenIn, pg8::GridOrder, true, F8>(ring, DM, DM, DM, S, E); }
                { const pg8::GridOrder S = pg8::grid_order(4, 64, Fp.G, Fp.bid, EWIN + (size_t)3072 * DM * ES, 256L * DM * ES, 0, HBA, 0, 256L * DM * ES);
                  const EpiVt E{ssq + (size_t)a0 * MTOK, WSP(bf16_t, WS_VS), SC};
                  pg8::gemm_phase<EpiVt, pg8::GridOrder, true, F8>(ring, DM, DM, DM, S, E); } });
        } SEAM(pb + 0);
        if (KON(2) && IN(pb + 1)) for (int rep_ = 0; rep_ < NREP(2); ++rep_) { if (MK_DUP_BAR && rep_ == 1) { asm volatile("" ::: "memory"); xcd_barrier(bar); asm volatile("" ::: "memory"); } PH_WS();
            t_pool_p(Fp, WSP(bf16_t, WS_U), WSP(bf16_t, WS_PP));
            { const pg8::GridOrder S = pg8::grid_order(64, 4, Fp.G, Fp.bid, WSP(bf16_t, WS_VS), 4L * 256 * 512 * 2, 256L * 512 * 2, WSP(bf16_t, WS_KT), 4L * 65536 * 2, 65536L * 2);
              const EpiBf16Unit E{WSP(bf16_t, WS_LT)};
              pg8::gemm_phase(ring, 256, 512, 256, S, E); }
        } SEAM(pb + 1);
        if (KON(3) && IN(pb + 2)) for (int rep_ = 0; rep_ < NREP(3); ++rep_) { if (MK_DUP_BAR && rep_ == 1) { asm volatile("" ::: "memory"); xcd_barrier(bar); asm volatile("" ::: "memory"); } PH_WS();
            t_scan(Fp, WSP(bf16_t, WS_LT), WSP(bf16_t, WS_VS));
            { const pg8::GridOrder S = pg8::grid_order(64, 4, Fp.G, Fp.bid, WSP(bf16_t, WS_PP), 256L * 1024 * 2, 256 * 2, WSP(bf16_t, WS_EWP) + (size_t)lp * 4 * 65536, 0, 65536L * 2);
              const EpiBf16Plain E{WSP(bf16_t, WS_YCAT), 2048, f8_eout(lp) ? WSP(unsigned char, WS_Y8) : (unsigned char*)nullptr};
              pg8::gemm_phase(ring, 256, 1024, 256, S, E); }
            { bf16_t* QP = WSP(bf16_t, WS_QP);
              const pg8::GridOrder S = pg8::grid_order(64, 4, Fp.G, Fp.bid, QP + 256, 256L * 2048 * 2, 512 * 2, WSP(bf16_t, WS_KN), 256L * 1024 * 2, 256 * 2);
              const EpiQK E{QP};
              pg8::gemm_phase(ring, 256, 2048, 1024, S, E); }
        } SEAM(pb + 2);
        if (KON(4) && IN(pb + 3)) for (int rep_ = 0; rep_ < NREP(4); ++rep_) { if (MK_DUP_BAR && rep_ == 1) { asm volatile("" ::: "memory"); xcd_barrier(bar); asm volatile("" ::: "memory"); } PH_WS();
            const pg8::GridOrder S = pg8::grid_order(64, 4, Fp.G, Fp.bid, WSP(bf16_t, WS_QP), 256L * 2048 * 2, 512 * 2, WSP(bf16_t, WS_VS), 4L * 256 * 512 * 2, 256L * 512 * 2);
            const EpiRetOut E{WSP(bf16_t, WS_SG), WSP(bf16_t, WS_YCAT), f8_eout(lp) ? WSP(unsigned char, WS_Y8) : (unsigned char*)nullptr};
            pg8::gemm_phase(ring, 512, 2048, 512, S, E);
        } SEAM(pb + 3);
        if (KON(5) && IN(pb + 4)) for (int rep_ = 0; rep_ < NREP(5); ++rep_) { PH_WS();
            F8_DISPATCH(f8_eout, { constexpr int ES = F8 ? 1 : 2; constexpr bool F8W = F8;
                const pg8::GridOrder S = pg8::grid_order(64, 8, Fp.G, Fp.bid, F8W ? WSP(char, WS_Y8) : WSP(char, WS_YCAT), 256L * DM * ES, 0, WSP(char, WS_EWOUT) + (size_t)lp * DM * DM * 2, 0, 256L * DM * ES);
                if (f8_ffn(lp)) { const EpiResidual<true> E{WSP(bf16_t, WS_HB), DUMMY(5) ? WSP(bf16_t, WS_ACTM) : WSP(bf16_t, WS_HB), ssq + (size_t)(DUMMY(5) ? 8 : a0 + 1) * MTOK, F8W ? GU8_UNSCALE : 1.f, WSP(unsigned char, WS_HB8)};
                    pg8::gemm_phase<EpiResidual<true>, pg8::GridOrder, true, F8W>(ring, DM, DM, DM, S, E); }
                else { const EpiResidual<false> E{WSP(bf16_t, WS_HB), DUMMY(5) ? WSP(bf16_t, WS_ACTM) : WSP(bf16_t, WS_HB), ssq + (size_t)(DUMMY(5) ? 8 : a0 + 1) * MTOK, F8W ? GU8_UNSCALE : 1.f, nullptr};
                    pg8::gemm_phase<EpiResidual<false>, pg8::GridOrder, true, F8W>(ring, DM, DM, DM, S, E); } });
        } SEAM(pb + 4);
        if (KON(6) && IN(pb + 5)) for (int rep_ = 0; rep_ < NREP(6); ++rep_) { if (MK_DUP_BAR && rep_ == 1) { asm volatile("" ::: "memory"); xcd_barrier(bar); asm volatile("" ::: "memory"); } PH_WS();
            F8_DISPATCH(f8_ffn, { constexpr int ES = F8 ? 1 : 2;
                const pg8::GridOrder S = pg8::grid_order(64, 44, Fp.G, Fp.bid, F8 ? WSP(char, WS_HB8) : WSP(char, WS_HB), 256L * DM * ES, 0, WSP(char, WS_FGU) + (size_t)lp * 2 * FFN * DM * 2, 0, 256L * DM * ES);
                if (f8_dn(lp)) { const EpiSwiGLU<F8, true> E{ssq + (size_t)(a0 + 1) * MTOK, WSP(void, WS_ACT), FFN}; pg8::gemm_phase<EpiSwiGLU<F8, true>, pg8::GridOrder, true, F8>(ring, DM, DM, DM, S, E); }
                else { const EpiSwiGLU<F8, false> E{ssq + (size_t)(a0 + 1) * MTOK, WSP(void, WS_ACT), FFN}; pg8::gemm_phase<EpiSwiGLU<F8, false>, pg8::GridOrder, true, F8>(ring, DM, DM, DM, S, E); } });
        } SEAM(pb + 5);
        if (KON(7) && IN(pb + 6)) for (int rep_ = 0; rep_ < NREP(7); ++rep_) { if (MK_DUP_BAR && rep_ == 1) { asm volatile("" ::: "memory"); xcd_barrier(bar); asm volatile("" ::: "memory"); } PH_WS();
            F8_DISPATCH(f8_dn, { constexpr int ES = F8 ? 1 : 2; constexpr bool F8IN = F8;
                const pg8::GridOrder S = pg8::grid_order(64, 8, Fp.G, Fp.bid, WSP(char, WS_ACT), 256L * FFN * ES, 0, WSP(char, WS_FDN) + (size_t)lp * DM * FFN * 2, 0, 256L * FFN * ES);
                if (f8_oin(lp) && !DUMMY(7)) { const EpiResidual<true> E{WSP(bf16_t, WS_HB), WSP(bf16_t, WS_HB), ssq + (size_t)(a0 + 2) * MTOK, F8IN ? DN8_UNSCALE : 1.f, WSP(unsigned char, WS_HB8)};
                    pg8::gemm_phase<EpiResidual<true>, pg8::GridOrder, true, F8IN>(ring, FFN, FFN, FFN, S, E); }
                else { const EpiResidual<false> E{WSP(bf16_t, WS_HB), DUMMY(7) ? WSP(bf16_t, WS_ACTM) : WSP(bf16_t, WS_HB), ssq + (size_t)(DUMMY(7) ? 8 : a0 + 2) * MTOK, F8IN ? DN8_UNSCALE : 1.f, nullptr};
                    pg8::gemm_phase<EpiResidual<false>, pg8::GridOrder, true, F8IN>(ring, FFN, FFN, FFN, S, E); } });
        } SEAM(pb + 6);
        if (KON(8) && IN(pb + 7)) for (int rep_ = 0; rep_ < NREP(8); ++rep_) { if (MK_DUP_BAR && rep_ == 1) { asm volatile("" ::: "memory"); xcd_barrier(bar); asm volatile("" ::: "memory"); } PH_WS();
            F8_DISPATCH(f8_oin, { constexpr int ES = F8 ? 1 : 2;
                const pg8::GridOrder S = pg8::grid_order(64, 24, Fp.G, Fp.bid, F8 ? WSP(char, WS_HB8) : WSP(char, WS_HB), 256L * DM * ES, 0, WSP(char, WS_OWIN) + (size_t)lp * OIN * DM * 2, 0, 256L * DM * ES);
                const EpiOddIn E{ssq + (size_t)(a0 + 2) * MTOK, WSP(bf16_t, WS_BG), WSP(bf16_t, WS_Z), F8 ? GU8_UNSCALE : 1.f};
                pg8::gemm_phase<EpiOddIn, pg8::GridOrder, true, F8>(ring, DM, DM, DM, S, E); });
        } SEAM(pb + 7);
        if (KON(9) && IN(pb + 8)) for (int rep_ = 0; rep_ < NREP(9); ++rep_) { if (MK_DUP_BAR && rep_ == 1) { asm volatile("" ::: "memory"); xcd_barrier(bar); asm volatile("" ::: "memory"); } PH_WS(); t_conv(Fp, WSP(bf16_t, WS_BG), WSP(bf16_t, WS_Z), args.in[9] + (size_t)lp * 3 * DM, WSP(bf16_t, WS_YCAT), f8_oout(lp) ? WSP(unsigned char, WS_Y8) : (unsigned char*)nullptr); } SEAM(pb + 8);
        if (KON(10) && IN(pb + 9)) for (int rep_ = 0; rep_ < NREP(10); ++rep_) { PH_WS();
            F8_DISPATCH(f8_oout, { constexpr int ES = F8 ? 1 : 2; constexpr bool F8W = F8;
                const pg8::GridOrder S = pg8::grid_order(64, 8, Fp.G, Fp.bid, F8W ? WSP(char, WS_Y8) : WSP(char, WS_YCAT), 256L * DM * ES, 0, WSP(char, WS_OWOUT) + (size_t)lp * DM * DM * 2, 0, 256L * DM * ES);
                if (f8_moe(lp)) { const EpiResidual<true> E{WSP(bf16_t, WS_HB), DUMMY(10) ? WSP(bf16_t, WS_ACTM) : WSP(bf16_t, WS_HB), ssq + (size_t)(DUMMY(10) ? 8 : a0 + 3) * MTOK, F8W ? GU8_UNSCALE : 1.f, WSP(unsigned char, WS_HB8)};
                    pg8::gemm_phase<EpiResidual<true>, pg8::GridOrder, true, F8W>(ring, DM, DM, DM, S, E); }
                else { const EpiResidual<false> E{WSP(bf16_t, WS_HB), DUMMY(10) ? WSP(bf16_t, WS_ACTM) : WSP(bf16_t, WS_HB), ssq + (size_t)(DUMMY(10) ? 8 : a0 + 3) * MTOK, F8W ? GU8_UNSCALE : 1.f, nullptr};
                    pg8::gemm_phase<EpiResidual<false>, pg8::GridOrder, true, F8W>(ring, DM, DM, DM, S, E); } });
        } SEAM(pb + 9);
        if (KON(11) && IN(pb + 10)) for (int rep_ = 0; rep_ < NREP(11); ++rep_) { if (MK_DUP_BAR && rep_ == 1) { asm volatile("" ::: "memory"); xcd_barrier(bar); asm volatile("" ::: "memory"); } PH_WS(); const size_t dmy_ = DUMMY(11) ? 2 * MiB : 0;
            t_router(Fp, WSP(bf16_t, WS_HB), ssq + (size_t)(a0 + 3) * MTOK, args.in[2] + (2 * lp + 1) * DM, args.in[13] + (size_t)lp * DM * NEXP, (unsigned*)(Fp.ctl + CW_CNT + (DUMMY(11) ? 2 + lp : lp) * NEXP * 64),
                     WSP(int, WS_MISC + MS_TOKE + dmy_), WSP(int, WS_MISC + MS_TOKP + dmy_), WSP(int, WS_MISC + MS_ROWTOK + dmy_), WSP(float, WS_MISC + MS_ER + dmy_), WSP(float, WS_MISC + MS_EW + dmy_)); } SEAM(pb + 10);
        if (KON(12) && IN(pb + 11)) for (int rep_ = 0; rep_ < NREP(12); ++rep_) { if (MK_DUP_BAR && rep_ == 1) { asm volatile("" ::: "memory"); xcd_barrier(bar); asm volatile("" ::: "memory"); } PH_WS();
            F8_DISPATCH(f8_moe, { constexpr int ES = F8 ? 1 : 2;
                MoeOrder<true> S; S.init((unsigned*)(Fp.ctl + CW_CNT + lp * NEXP * 64), 22, Fp.G, Fp.bid); S.A0 = F8 ? WSP(char, WS_HB8) : WSP(char, WS_HB); S.B0 = WSP(char, WS_MGU) + (size_t)lp * NEXP * 2 * EXD * DM * 2;
                S.a_rt = 0; S.b_e = 2L * EXD * DM * 2; S.b_sn = 256L * DM * ES; S.rowtok = WSP(int, WS_MISC + MS_ROWTOK); S.row_bytes = DM * ES;
                const EpiMoeGU<F8> E{WSP(float, WS_MISC + MS_ER), WSP(void, WS_ACTM)};
                pg8::gemm_phase<EpiMoeGU<F8>, MoeOrder<true>, true, F8>(ring, DM, DM, DM, S, E); });
        } SEAM(pb + 11);
        if (KON(13) && IN(pb + 12)) for (int rep_ = 0; rep_ < NREP(13); ++rep_) { if (MK_DUP_BAR && rep_ == 1) { asm volatile("" ::: "memory"); xcd_barrier(bar); asm volatile("" ::: "memory"); } PH_WS();
            F8_DISPATCH(f8_moe, { constexpr int ES = F8 ? 1 : 2;
                MoeOrder<false> S; S.init((unsigned*)(Fp.ctl + CW_CNT + lp * NEXP * 64), 8, Fp.G, Fp.bid); S.A0 = WSP(char, WS_ACTM); S.B0 = WSP(char, WS_MDN) + (size_t)lp * NEXP * DM * EXD * 2;
                S.a_rt = 256L * EXD * ES; S.b_e = (long)DM * EXD * 2; S.b_sn = 256L * EXD * ES; S.rowtok = nullptr; S.row_bytes = 0;
                const EpiMoeDown E{WSP(float, WS_MISC + MS_EW), WSP(bf16_t, WS_YC), F8 ? DN8_UNSCALE : 1.f};
                pg8::gemm_phase<EpiMoeDown, MoeOrder<false>, true, F8>(ring, EXD, EXD, EXD, S, E);
                { const int total = S.tp[NEXP] * 8, maxr = (total + Fp.G - 1) / Fp.G; if ((long)(maxr - 1) * Fp.G + Fp.bid >= total) cv_extra = MK_STEAL_N; } });
        } SEAM(pb + 12);
        if (KON(14) && IN(pb + 13)) for (int rep_ = 0; rep_ < NREP(14); ++rep_) { if (MK_DUP_BAR && rep_ == 1) { asm volatile("" ::: "memory"); xcd_barrier(bar); asm volatile("" ::: "memory"); } PH_WS();
            t_combine(Fp, WSP(bf16_t, WS_HB), DUMMY(14) ? WSP(bf16_t, WS_ACTM) : WSP(bf16_t, WS_HB), WSP(bf16_t, WS_YC), (unsigned*)(Fp.ctl + CW_CNT + lp * NEXP * 64), WSP(int, WS_MISC + MS_TOKE), WSP(int, WS_MISC + MS_TOKP), ssq + (size_t)(DUMMY(14) ? 8 : a0 + 4) * MTOK, args.in[3], DUMMY(14) ? WSP(float, WS_BG) : args.out, lp == 1, (lp == 0 && f8_ein(1) && !DUMMY(14)) ? WSP(unsigned char, WS_HB8) : (unsigned char*)nullptr); } SEAM(pb + 13);
    }
#undef PH_WS
#undef WSP
#undef F8_DISPATCH
#undef IN
#undef SEAM
}

extern "C" void kernel_launch(void* const* d_in, const int* in_sizes, int n_in, void* d_out, int out_size, void* d_ws, size_t ws_size, hipStream_t stream) {
    static int grid = 0;
    if (grid == 0) {
        if (n_in != 16 || in_sizes[0] != MTOK * DM || out_size != MTOK * DM || ws_size < WS_END) { fprintf(stderr, "kernel_launch: unexpected shapes / workspace (n_in %d, in0 %d, out %d, ws %zu < %zu); nothing launched\n", n_in, n_in > 0 ? in_sizes[0] : -1, out_size, ws_size, (size_t)WS_END); grid = -1; return; }
        int dev = 0, cus = 0, per_cu = 0;
        if (hipGetDevice(&dev) != hipSuccess || hipDeviceGetAttribute(&cus, hipDeviceAttributeMultiprocessorCount, dev) != hipSuccess) { fprintf(stderr, "kernel_launch: device query failed\n"); grid = -1; return; }
        if (hipFuncSetAttribute((const void*)fwd_kernel, hipFuncAttributeMaxDynamicSharedMemorySize, LDS_BYTES) != hipSuccess) { fprintf(stderr, "kernel_launch: hipFuncSetAttribute failed\n"); grid = -1; return; }
        if (hipOccupancyMaxActiveBlocksPerMultiprocessor(&per_cu, (const void*)fwd_kernel, NWAVES * 64, LDS_BYTES) != hipSuccess || per_cu < 1) { fprintf(stderr, "kernel_launch: occupancy query reports %d blocks per CU; nothing launched\n", per_cu); (void)hipGetLastError(); grid = -1; return; }
        if (cus != 256) { fprintf(stderr, "kernel_launch: built for a 256-CU device, found %d CUs; nothing launched\n", cus); grid = -1; return; }
        grid = cus;
    }
    if (grid < 0) return;
    if (hipMemsetAsync((char*)d_ws + WS_CTL, 0, CTL_ZERO_BYTES, stream) != hipSuccess) { fprintf(stderr, "kernel_launch: memset failed\n"); return; }
    Args a{};
    for (int i = 0; i < 16; ++i) a.in[i] = (const float*)d_in[i];
    a.out = (float*)d_out; a.ws = (unsigned char*)d_ws;
#if MK_ONE_LAUNCH
    a.ph_lo = 0; a.ph_hi = N_PHASES;
    hipLaunchKernelGGL(fwd_kernel, dim3(grid), dim3(NWAVES * 64), LDS_BYTES, stream, a);
#else
    for (int p = 0; p < N_PHASES; ++p) { a.ph_lo = p; a.ph_hi = p + 1; hipLaunchKernelGGL(fwd_kernel, dim3(grid), dim3(NWAVES * 64), LDS_BYTES, stream, a); }
#endif
    const hipError_t le = hipPeekAtLastError();
    if (le != hipSuccess) fprintf(stderr, "kernel_launch: launch failed: %s\n", hipGetErrorName(le));
}
```

```cpp
#include <hip/hip_runtime.h>
#include <cstdio>
#include <cstdint>

#define LAS __attribute__((address_space(3)))
#define GAS __attribute__((address_space(1)))
typedef unsigned short bf16_t;
typedef short bf16x8 __attribute__((ext_vector_type(8)));
typedef float f32x4 __attribute__((ext_vector_type(4)));
typedef float f32x2 __attribute__((ext_vector_type(2)));
typedef unsigned u32x4 __attribute__((ext_vector_type(4)));
typedef unsigned u32x2 __attribute__((ext_vector_type(2)));
typedef GAS unsigned gu32;

#ifndef MK_FAST_GEMM
#define MK_FAST_GEMM 1
#endif
#ifndef MK_ONE_LAUNCH
#define MK_ONE_LAUNCH 1
#endif

namespace pg8 {
constexpr int BM = 256, BK = 64, HALF = 128, HTB = HALF * BK * 2  , STAGE_BYTES = 8 * HTB, NXCD = 8, WGM = 8;

__host__ __device__ __forceinline__ int lds_byte(int r, int c) { const int st = (r >> 4) * 2 + (c >> 5), rr = r & 15, cc = c & 31, ob = rr * 64 + cc * 2; return st * 1024 + (ob ^ (((ob >> 9) & 1) << 5)); }
__host__ __device__ __forceinline__ void stage_rc(int b, int& R, int& C) { const int st = b / 1024, sb = b % 1024, swz = sb ^ (((sb >> 9) & 1) << 5); R = (st >> 1) * 16 + swz / 64; C = (st & 1) * 32 + (swz % 64) / 2; }
__host__ __device__ __forceinline__ int perm32(int rho) { const int n = rho >> 4, i = rho & 15; return 8 * (i >> 2) + 4 * n + (i & 3); }

struct Unit { int pm, pn; const char* a; const char* b; int x0, x1, x2; };

__device__ __forceinline__ void tile_of(int L, int nM, int nN, int& pm, int& pn) {
    const int nwg = nM * nN; int wgid = L;
    { const int q = nwg / NXCD, r = nwg % NXCD, xcd = wgid % NXCD, off = wgid / NXCD; wgid = (xcd < r ? xcd * (q + 1) : r * (q + 1) + (xcd - r) * q) + off; }
    const int nig = WGM * nN, gid = wgid / nig, fm = gid * WGM, gsz = (nM - fm) < WGM ? (nM - fm) : WGM;
    pm = fm + ((wgid % nig) % gsz); pn = (wgid % nig) / gsz;
}

struct GridOrder {
    static constexpr bool GATHER = false;
    int nM, nN, G, c, skip_from, skip_by;
    const char *A0, *B0; long a_sm, a_sn, b_sm, b_sn;
    __device__ __forceinline__ bool next(int i, Unit& u) const {
        const long L = (long)i * G + c; if (L >= (long)nM * nN) return false;
        int pm, pn; tile_of((int)L, nM, nN, pm, pn); if (pn >= skip_from) pn += skip_by;
        u.pm = pm; u.pn = pn; u.a = A0 + pm * a_sm + pn * a_sn; u.b = B0 + pm * b_sm + pn * b_sn; u.x0 = u.x1 = u.x2 = 0; return true;
    }
    __device__ __forceinline__ unsigned goff(const Unit&, int) const { return 0u; }
};
__device__ __forceinline__ GridOrder grid_order(int nM, int nN, int G, int c, const void* A0, long a_sm, long a_sn, const void* B0, long b_sm, long b_sn, int skip_from = 1 << 30, int skip_by = 0) {
    GridOrder S; S.nM = nM; S.nN = nN; S.G = G; S.c = c; S.skip_from = skip_from; S.skip_by = skip_by; S.A0 = (const char*)A0; S.B0 = (const char*)B0; S.a_sm = a_sm; S.a_sn = a_sn; S.b_sm = b_sm; S.b_sn = b_sn; return S;
}

__device__ __forceinline__ unsigned cvt_pk_bf16(float lo, float hi) { unsigned r; asm volatile("v_cvt_pk_bf16_f32 %0, %1, %2" : "=v"(r) : "v"(lo), "v"(hi)); return r; }
__device__ __forceinline__ float bf2f(unsigned short b) { return __uint_as_float(((unsigned)b) << 16); }
__device__ __forceinline__ float bflo(unsigned w) { return __uint_as_float(w << 16); }
__device__ __forceinline__ float bfhi(unsigned w) { return __uint_as_float(w & 0xffff0000u); }

typedef int i32x8 __attribute__((ext_vector_type(8)));
typedef int i32x4 __attribute__((ext_vector_type(4)));
typedef float f32x8 __attribute__((ext_vector_type(8)));
__device__ __forceinline__ i32x8 frag8(bf16x8 lo, bf16x8 hi) { const i32x4 a = __builtin_bit_cast(i32x4, lo), b = __builtin_bit_cast(i32x4, hi); return (i32x8){a[0], a[1], a[2], a[3], b[0], b[1], b[2], b[3]}; }

constexpr int PF_SIDE_OFF = 131072 + 4096, PF_SIDE_BYTES = 2048;
template <class E, class = void> struct epi_pf { static constexpr int value = 0; };
template <class E> struct epi_pf<E, decltype((void)E::PF_BYTES)> { static constexpr int value = E::PF_BYTES; };
template <class Epi, class Sched, bool ALIGN_EPI = true>
__device__ __forceinline__ void gemm_phase_ref(LAS unsigned char* lds, const int K, const int lda, const int ldb, const Sched& S, const Epi& E) {
    const int tid = threadIdx.x, wid = __builtin_amdgcn_readfirstlane(tid >> 6), lane = tid & 63, wr = wid >> 2, wc = wid & 3, fr = lane & 15, fq = lane >> 4;
    constexpr int KT = 32, LDR = KT + 8;
    LAS bf16_t* As = (LAS bf16_t*)lds; LAS bf16_t* Bs = As + 256 * LDR;
    for (int ui = 0;; ++ui) {
        Unit u; if (!S.next(ui, u)) break;
        f32x4 acc[2][2][4][2];
#pragma unroll
        for (int a = 0; a < 2; ++a)
#pragma unroll
            for (int b = 0; b < 2; ++b)
#pragma unroll
                for (int m = 0; m < 4; ++m)
#pragma unroll
                    for (int n = 0; n < 2; ++n) acc[a][b][m][n] = (f32x4){0.f, 0.f, 0.f, 0.f};
        for (int k0 = 0; k0 < K; k0 += KT) {
            __syncthreads();
            for (int c = tid; c < 1024; c += 512) { const int row = c >> 2, ch = c & 3;
                const char* ap = Sched::GATHER ? (u.a + S.goff(u, row)) : (u.a + (size_t)row * lda * 2);
                const u32x4 va = *(const GAS u32x4*)(ap + (size_t)k0 * 2 + ch * 16); *(LAS u32x4*)(As + row * LDR + ch * 8) = va;
                const u32x4 vb = *(const GAS u32x4*)(u.b + (size_t)row * ldb * 2 + (size_t)k0 * 2 + ch * 16); *(LAS u32x4*)(Bs + row * LDR + ch * 8) = vb; }
            __syncthreads();
            for (int kk = 0; kk < KT; ++kk) {
                float av[2][4], bv[2][2][4];
#pragma unroll
                for (int ai = 0; ai < 2; ++ai)
#pragma unroll
                    for (int m = 0; m < 4; ++m) av[ai][m] = bf2f(As[(ai * 128 + wr * 64 + m * 16 + fr) * LDR + kk]);
#pragma unroll
                for (int bj = 0; bj < 2; ++bj)
#pragma unroll
                    for (int n = 0; n < 2; ++n)
#pragma unroll
                        for (int j = 0; j < 4; ++j) { const int col = Epi::PERM ? (bj * 128 + wc * 32 + 8 * fq + 4 * n + j) : (bj * 128 + wc * 32 + 16 * n + 4 * fq + j); bv[bj][n][j] = bf2f(Bs[col * LDR + kk]); }
#pragma unroll
                for (int ai = 0; ai < 2; ++ai)
#pragma unroll
                    for (int bj = 0; bj < 2; ++bj)
#pragma unroll
                        for (int m = 0; m < 4; ++m)
#pragma unroll
                            for (int n = 0; n < 2; ++n)
#pragma unroll
                                for (int j = 0; j < 4; ++j) acc[ai][bj][m][n][j] += av[ai][m] * bv[bj][n][j];
            }
        }
        if constexpr (Epi::AFTER_DRAIN) { __syncthreads(); E.fused(acc, u, wr, wc, fr, fq, lds, wid, lane); __syncthreads(); }
        else E(acc, u, wr, wc, fr, fq);
    }
    __syncthreads();
}

template <class Epi, class Sched, bool ALIGN_EPI = true, bool FP8 = false>
__device__ __forceinline__ void gemm_phase_fast(LAS unsigned char* lds, const int K, const int lda, const int ldb, const Sched& S, const Epi& E) {
    int tid_ = threadIdx.x; asm volatile("" : "+v"(tid_));
    const int tid = tid_, wid = __builtin_amdgcn_readfirstlane(tid >> 6), lane = tid & 63, wr = wid >> 2, wc = wid & 3, fr = lane & 15, fq = lane >> 4;
    constexpr int ESZ = FP8 ? 1 : 2;
    const int nt = K * ESZ / (BK * 2);
    constexpr bool GA = Sched::GATHER;
    unsigned voffA[2], voffB[2], colA[2]; int rowA[2];
#pragma unroll
    for (int i = 0; i < 2; ++i) { int R, C; stage_rc(tid * 16 + i * 8192, R, C); const int Rb = Epi::PERM ? ((R & ~31) + perm32(R & 31)) : R;
        voffA[i] = (unsigned)(R * lda * ESZ + C * 2); voffB[i] = (unsigned)(Rb * ldb * ESZ + C * 2); colA[i] = (unsigned)C * 2u; rowA[i] = R; }
    const size_t kstep = (size_t)(BK * 2);
    const size_t hstepA = GA ? (size_t)0 : (size_t)HALF * lda * ESZ, hstepB = (size_t)HALF * ldb * ESZ;
    const unsigned ldsw = (unsigned)wid * 1024u;
    const int aoff = FP8 ? lds_byte(wr * 64 + fr, fq * 16) : lds_byte(wr * 64 + fr, fq * 8), boff = FP8 ? lds_byte(wc * 32 + fr, fq * 16) : lds_byte(wc * 32 + fr, fq * 8);
    unsigned gC[2][2], gN[2][2];
#define PG8_SA(b, h) (((b) * 2 + (h)) * HTB)
#define PG8_SB(b, h) ((4 + (b) * 2 + (h)) * HTB)
#define PG8_GLDS(gp, bufoff, _i) __builtin_amdgcn_global_load_lds((const unsigned*)(gp), (LAS unsigned*)(lds + (bufoff) + ldsw + (_i) * 8192), 16, 0, 0)
#define PG8_STAGE_B(bufoff, gbase) do { _Pragma("unroll") for (int _i = 0; _i < 2; ++_i) PG8_GLDS((const char*)(gbase) + voffB[_i], bufoff, _i); } while (0)
#define PG8_STAGE_A(bufoff, gbase, h, nx) do { _Pragma("unroll") for (int _i = 0; _i < 2; ++_i) { \
        if constexpr (GA) PG8_GLDS((const char*)(gbase) + ((nx) ? gN[h][_i] : gC[h][_i]), bufoff, _i); \
        else PG8_GLDS((const char*)(gbase) + (h) * hstepA + voffA[_i], bufoff, _i); } } while (0)
#define PG8_LDA(dst, b, h) do { if constexpr (FP8) { _Pragma("unroll") for (int m = 0; m < 4; ++m) { dst##8[m].lo = *(const LAS i32x4*)(lds + PG8_SA(b, h) + aoff + m * 2048); dst##8[m].hi = *(const LAS i32x4*)(lds + PG8_SA(b, h) + aoff + m * 2048 + 16); } } \
        else { _Pragma("unroll") for (int m = 0; m < 4; ++m) _Pragma("unroll") for (int k = 0; k < 2; ++k) dst[m][k] = *(const LAS bf16x8*)(lds + PG8_SA(b, h) + aoff + m * 2048 + k * 1024); } } while (0)
#define PG8_LDB(dst, b, h) do { if constexpr (FP8) { _Pragma("unroll") for (int n = 0; n < 2; ++n) { dst##8[n].lo = *(const LAS i32x4*)(lds + PG8_SB(b, h) + boff + n * 2048); dst##8[n].hi = *(const LAS i32x4*)(lds + PG8_SB(b, h) + boff + n * 2048 + 16); } } \
        else { _Pragma("unroll") for (int n = 0; n < 2; ++n) _Pragma("unroll") for (int k = 0; k < 2; ++k) dst[n][k] = *(const LAS bf16x8*)(lds + PG8_SB(b, h) + boff + n * 2048 + k * 1024); } } while (0)
#define PG8_MMA(ai, bj, At, Bt) do { __builtin_amdgcn_s_setprio(1); _Pragma("unroll") for (int m = 0; m < 4; ++m) _Pragma("unroll") for (int n = 0; n < 2; ++n) { \
        if constexpr (FP8) asm volatile("v_mfma_scale_f32_16x16x128_f8f6f4 %0, %1, %2, %0, %3, %3 op_sel_hi:[0,0,0]" : "+v"(acc[ai][bj][m][n]) : "v"(Bt##8[n]), "v"(At##8[m]), "v"(sc1)); \
        else { _Pragma("unroll") for (int k = 0; k < 2; ++k) acc[ai][bj][m][n] = __builtin_amdgcn_mfma_f32_16x16x32_bf16(Bt[n][k], At[m][k], acc[ai][bj][m][n], 0, 0, 0); } } __builtin_amdgcn_s_setprio(0); } while (0)
#define PG8_WAIT_V(n) asm volatile("s_waitcnt vmcnt(" #n ")" ::: "memory")
#define PG8_WAIT_L(n) asm volatile("s_waitcnt lgkmcnt(" #n ")" ::: "memory")
#define PG8_BAR __builtin_amdgcn_s_barrier()
#define PG8_SCHED __builtin_amdgcn_sched_barrier(0)
    Unit cur, nxt; int ui = 0;
    if (!S.next(0, cur)) return;
    f32x4 acc[2][2][4][2];
#pragma unroll
    for (int a = 0; a < 2; ++a)
#pragma unroll
        for (int b = 0; b < 2; ++b)
#pragma unroll
            for (int m = 0; m < 4; ++m)
#pragma unroll
                for (int n = 0; n < 2; ++n) acc[a][b][m][n] = (f32x4){0.f, 0.f, 0.f, 0.f};
    bf16x8 At[4][2], B0[2][2], B1[2][2];
    i32x8 At8[4], B08[2], B18[2];
    const int sc1 = 0x7f7f7f7f;
    (void)At; (void)B0; (void)B1; (void)At8; (void)B08; (void)B18; (void)sc1;
    const char* cA = cur.a; const char* cB = cur.b;
    if constexpr (GA) {
#pragma unroll
        for (int h = 0; h < 2; ++h)
#pragma unroll
            for (int i = 0; i < 2; ++i) { gC[h][i] = S.goff(cur, h * HALF + rowA[i]) + colA[i]; gN[h][i] = gC[h][i]; }
    }
    PG8_STAGE_B(PG8_SB(0, 0), cB); PG8_STAGE_B(PG8_SB(0, 1), cB + hstepB); PG8_STAGE_A(PG8_SA(0, 0), cA, 0, false); PG8_STAGE_A(PG8_SA(0, 1), cA, 1, false);
    if (wr == 1) PG8_BAR;
    PG8_WAIT_V(2); PG8_BAR;
    PG8_STAGE_B(PG8_SB(1, 0), cB + kstep); PG8_STAGE_A(PG8_SA(1, 0), cA + kstep, 0, false); PG8_STAGE_B(PG8_SB(1, 1), cB + hstepB + kstep);
    PG8_WAIT_V(6); PG8_BAR;
#pragma unroll 1
    for (;;) {
        const bool has_next = S.next(ui + 1, nxt);
        if constexpr (epi_pf<Epi>::value > 0) {
            if (epi_pf<Epi>::value == 8 || wid < 4) { unsigned m_ = ~0u; asm volatile("" : "+s"(m_)); const int l_ = (int)__builtin_amdgcn_mbcnt_hi(m_, __builtin_amdgcn_mbcnt_lo(m_, 0u));
                __builtin_amdgcn_global_load_lds((const unsigned*)((const char*)E.pf_src(cur) + (wid * 64 + l_) * 4), (LAS unsigned*)(lds + PF_SIDE_OFF + (ui & 1) * PF_SIDE_BYTES + wid * 256), 4, 0, 0); } }
        const char* nA = has_next ? nxt.a : cA; const char* nB = has_next ? nxt.b : cB;
        if constexpr (GA) { if (has_next) {
#pragma unroll
            for (int h = 0; h < 2; ++h)
#pragma unroll
                for (int i = 0; i < 2; ++i) gN[h][i] = S.goff(nxt, h * HALF + rowA[i]) + colA[i]; } }
#pragma unroll 1
        for (int t = 0; t < nt; t += 2) {
            const bool last = (t == nt - 2);
            const char* a1 = cA + (size_t)(t + 1) * kstep;
            const char* a2 = last ? nA : cA + (size_t)(t + 2) * kstep; const char* b2 = last ? nB : cB + (size_t)(t + 2) * kstep;
            const char* a3 = a2 + kstep; const char* b3 = b2 + kstep;
            PG8_LDB(B0, 0, 0); PG8_LDB(B1, 0, 1); PG8_SCHED; PG8_LDA(At, 0, 0); PG8_STAGE_A(PG8_SA(1, 1), a1, 1, false);
            PG8_WAIT_V(8); PG8_WAIT_L(0); PG8_BAR; PG8_MMA(0, 0, At, B0); PG8_MMA(0, 1, At, B1); PG8_BAR; PG8_SCHED;
            PG8_LDA(At, 0, 1); PG8_STAGE_B(PG8_SB(0, 0), b2); PG8_STAGE_B(PG8_SB(0, 1), b2 + hstepB); PG8_STAGE_A(PG8_SA(0, 0), a2, 0, last);
            PG8_WAIT_V(8); PG8_WAIT_L(0); PG8_BAR; PG8_MMA(1, 0, At, B0); PG8_MMA(1, 1, At, B1); PG8_BAR; PG8_SCHED;
            PG8_LDB(B0, 1, 0); PG8_LDB(B1, 1, 1); PG8_SCHED; PG8_LDA(At, 1, 0); PG8_STAGE_A(PG8_SA(0, 1), a2, 1, last);
            PG8_WAIT_V(8); PG8_WAIT_L(0); PG8_BAR; PG8_MMA(0, 0, At, B0); PG8_MMA(0, 1, At, B1); PG8_BAR; PG8_SCHED;
            PG8_LDA(At, 1, 1); PG8_STAGE_B(PG8_SB(1, 0), b3); PG8_STAGE_B(PG8_SB(1, 1), b3 + hstepB); PG8_STAGE_A(PG8_SA(1, 0), a3, 0, last);
            PG8_WAIT_V(8); PG8_WAIT_L(0); PG8_BAR; PG8_MMA(1, 0, At, B0); PG8_MMA(1, 1, At, B1); PG8_BAR; PG8_SCHED;
        }
        if constexpr (ALIGN_EPI) { if (wr == 0) PG8_BAR; }
        if constexpr (FP8) asm volatile("s_nop 15\n\ts_nop 15" ::: "memory");
        if constexpr (!Epi::AFTER_DRAIN) { if constexpr (epi_pf<Epi>::value > 0) E.with_pf(acc, cur, wr, wc, fr, fq, (const LAS unsigned char*)(lds + PF_SIDE_OFF + (ui & 1) * PF_SIDE_BYTES)); else E(acc, cur, wr, wc, fr, fq);
#if defined(MK_EPI_TWICE)
            if constexpr (Epi::PROBE_TWICE) { asm volatile("" ::: "memory"); E(acc, cur, wr, wc, fr, fq); }
#endif
        }
        if (!has_next) break;
#pragma unroll
        for (int a = 0; a < 2; ++a)
#pragma unroll
            for (int b = 0; b < 2; ++b)
#pragma unroll
                for (int m = 0; m < 4; ++m)
#pragma unroll
                    for (int n = 0; n < 2; ++n) acc[a][b][m][n] = (f32x4){0.f, 0.f, 0.f, 0.f};
        cur = nxt; cA = nA; cB = nB; ++ui;
        if constexpr (GA) {
#pragma unroll
            for (int h = 0; h < 2; ++h)
#pragma unroll
                for (int i = 0; i < 2; ++i) gC[h][i] = gN[h][i]; }
        if constexpr (ALIGN_EPI) { if (wr == 1) PG8_BAR; }
    }
    PG8_WAIT_V(0);
    if constexpr (!ALIGN_EPI) { if (wr == 0) PG8_BAR; }
    PG8_BAR;
    if constexpr (Epi::AFTER_DRAIN) { E.fused(acc, cur, wr, wc, fr, fq, lds, wid, lane); PG8_BAR; }
#undef PG8_SA
#undef PG8_SB
#undef PG8_GLDS
#undef PG8_STAGE_A
#undef PG8_STAGE_B
#undef PG8_LDA
#undef PG8_LDB
#undef PG8_MMA
#undef PG8_WAIT_V
#undef PG8_WAIT_L
#undef PG8_BAR
#undef PG8_SCHED
}

template <class Epi, class Sched, bool ALIGN_EPI = true, bool FP8 = false>
__device__ __forceinline__ void gemm_phase(LAS unsigned char* lds, const int K, const int lda, const int ldb, const Sched& S, const Epi& E) {
#if MK_FAST_GEMM
    gemm_phase_fast<Epi, Sched, ALIGN_EPI, FP8>(lds, K, lda, ldb, S, E);
#else
    gemm_phase_ref<Epi, Sched, ALIGN_EPI>(lds, K, lda, ldb, S, E);
#endif
}
}

constexpr int NWAVES = 8;
constexpr int DM = 2048, SEQ = 8192, MTOK = 16384;
constexpr int EIN = 5120, FFN = 5632, EXD = 2816, NEXP = 8, OIN = 6144;
constexpr int ECAP = 16384;
constexpr int MOE_ROWS = 2 * MTOK + NEXP * 256;
constexpr float RMS_EPS = 1e-6f, GN_EPS = 1e-5f;

constexpr size_t MiB = 1u << 20;
constexpr size_t WS_CTL = 0, CTL_ZERO_BYTES = 2 * MiB;
constexpr size_t WS_MISC = 2 * MiB;
constexpr size_t WS_EWIN = 8 * MiB;
constexpr size_t WS_EWP = WS_EWIN + 40 * MiB;
constexpr size_t WS_EWOUT = WS_EWP + 1 * MiB;
constexpr size_t WS_OWIN = WS_EWOUT + 16 * MiB;
constexpr size_t WS_OWOUT = WS_OWIN + 48 * MiB;
constexpr size_t WS_FGU = WS_OWOUT + 16 * MiB;
constexpr size_t WS_FDN = WS_FGU + 88 * MiB;
constexpr size_t WS_MGU = WS_FDN + 44 * MiB;
constexpr size_t WS_MDN = WS_MGU + 352 * MiB;
constexpr size_t WS_HB = WS_MDN + 176 * MiB;
constexpr size_t WS_U = WS_HB + 64 * MiB;
constexpr size_t WS_QP = WS_U + 32 * MiB;
constexpr size_t WS_KN = WS_QP + 64 * MiB;
constexpr size_t WS_SG = WS_KN + 32 * MiB;
constexpr size_t WS_KT = WS_SG + 32 * MiB;
constexpr size_t WS_VS = WS_KT + 32 * MiB;
constexpr size_t WS_LT = WS_VS + 64 * MiB;
constexpr size_t WS_PP = WS_LT + 64 * MiB;
constexpr size_t WS_YCAT = WS_PP + 32 * MiB;
constexpr size_t WS_ACT = WS_YCAT + 64 * MiB;
constexpr size_t WS_BG = WS_ACT + 176 * MiB;
constexpr size_t WS_Z = WS_BG + 64 * MiB;
constexpr size_t WS_ACTM = WS_Z + 64 * MiB;
constexpr size_t WS_YC = WS_ACTM + 188 * MiB;
constexpr size_t WS_HB8 = WS_YC + 136 * MiB;
constexpr size_t WS_Y8 = WS_HB8 + 32 * MiB;
constexpr size_t WS_END = WS_Y8 + 32 * MiB;
static_assert((size_t)MOE_ROWS * EXD * 2 <= 188 * MiB && (size_t)MOE_ROWS * DM * 2 <= 136 * MiB, "moe buffers");
constexpr size_t MS_TOKE = 0, MS_TOKP = 128 * 1024, MS_ROWTOK = 256 * 1024, MS_ER = 768 * 1024, MS_EW = 1280 * 1024;
constexpr int CW_TMO = 0, CW_CODE = 1;
constexpr int CW_BAR = 4096;
constexpr int CW_CNT = 8192;
constexpr int CW_CONVQ = 16384;
constexpr int CW_SSQ = 65536;
static_assert((CW_SSQ + 2 * 9 * MTOK) * 4 <= (int)CTL_ZERO_BYTES, "CTL words inside the memset region");
typedef unsigned long long ssq_t;
constexpr float SSQ_SCALE = 1048576.f, SSQ_INV = 1.f / 1048576.f;

constexpr int RING_OFF = 0, RING_BYTES = 131072;
constexpr int LDSX_OFF = RING_BYTES;
constexpr int LDSCTL_OFF = RING_BYTES + 8192, MISC_OFF = LDSCTL_OFF + 320;
constexpr int LDS_BYTES = 147456;
static_assert(MISC_OFF + 128 <= LDS_BYTES, "LDS map");
static_assert(pg8::PF_SIDE_OFF == LDSX_OFF + 4096 && pg8::PF_SIDE_OFF + 2 * pg8::PF_SIDE_BYTES <= LDSCTL_OFF, "epilogue prefetch side area");

#define RLX_AGENT __ATOMIC_RELAXED, __HIP_MEMORY_SCOPE_AGENT
#define LDS_WAIT() asm volatile("s_waitcnt lgkmcnt(0)" ::: "memory")
#define VM_WAIT() asm volatile("s_waitcnt vmcnt(0)" ::: "memory")

#define XB_TMO      128
#define XB_XCNT(j)  (256  + 64 * (j))
#define XB_XSUB(j)  (1280 + 64 * (j))
#define XB_XGEN(j)  (2304 + 64 * (j))
#define XB_TOP      3328
#define XB_TOPGEN   3392
#define XCD_BAR_WORDS 3456
#define XB_SPIN_CAP (1u << 22)

__device__ __forceinline__ unsigned xb_ld(unsigned* p)              { return __hip_atomic_load(p, __ATOMIC_RELAXED, __HIP_MEMORY_SCOPE_AGENT); }
__device__ __forceinline__ unsigned xb_add(unsigned* p, unsigned v) { return __hip_atomic_fetch_add(p, v, __ATOMIC_RELAXED, __HIP_MEMORY_SCOPE_AGENT); }
__device__ __forceinline__ unsigned xb_xcc_id() { return (unsigned)__builtin_amdgcn_s_getreg((3 << 11) | 20) & 0xFu; }
#define XB_SPIN(cond, bar) do { unsigned _sp = 0; while (cond) { __builtin_amdgcn_s_sleep(1); \
    if ((++_sp & 255u) == 0u) { if (xb_ld(&(bar)[XB_TMO])) break; if (_sp > XB_SPIN_CAP) { atomicAdd(&(bar)[XB_TMO], 1u); break; } } } } while (0)

struct XcdBarrier { unsigned* bar; unsigned x; volatile LAS unsigned* st; };

__device__ __forceinline__ XcdBarrier xcd_barrier_post(unsigned* bar, volatile LAS unsigned* st) {
    XcdBarrier b; b.bar = bar; b.x = xb_xcc_id(); b.st = st;
    if (threadIdx.x == 0) (void)xb_add(&bar[XB_XCNT(b.x)], 1u);
    return b;
}
__device__ __forceinline__ void xcd_barrier_complete(unsigned* bar, unsigned x, unsigned& nloc, unsigned& nx) {
    const unsigned G = gridDim.x * gridDim.y * gridDim.z;
    unsigned sum, cnt, mine, sp = 0u;
    for (;;) {
        sum = 0u; cnt = 0u; mine = 0u;
#pragma unroll
        for (unsigned j = 0; j < 16; ++j) { const unsigned c = xb_ld(&bar[XB_XCNT(j)]); sum += c; cnt += (c > 0u) ? 1u : 0u; mine = (j == x) ? c : mine; }
        if (sum == G) break;
        __builtin_amdgcn_s_sleep(1);
        if ((++sp & 255u) == 0u) { if (xb_ld(&bar[XB_TMO])) break; if (sp > XB_SPIN_CAP) { atomicAdd(&bar[XB_TMO], 1u); break; } }
    }
    nloc = mine > 0u ? mine : 1u; nx = cnt > 0u ? cnt : 1u;
}
__device__ __forceinline__ void xcd_barrier(const XcdBarrier& b) {
    asm volatile("s_waitcnt vmcnt(0)" ::: "memory");
    __syncthreads();
    if (threadIdx.x == 0) {
        unsigned* bar = b.bar;
        __builtin_amdgcn_s_waitcnt(0);
        unsigned nloc = b.st[0], nx = b.st[1];
        if (nloc == 0u) { xcd_barrier_complete(bar, b.x, nloc, nx); b.st[0] = nloc; b.st[1] = nx; }
        const unsigned old = xb_add(&bar[XB_XSUB(b.x)], 1u);
        const unsigned gen = old / nloc;
        if (old + 1u == (gen + 1u) * nloc) {
            __builtin_amdgcn_fence(__ATOMIC_RELEASE, "agent");
            asm volatile("s_waitcnt vmcnt(0)" ::: "memory");
            const unsigned og = xb_add(&bar[XB_TOP], 1u);
            const unsigned tg = og / nx;
            if (og + 1u == (tg + 1u) * nx) xb_add(&bar[XB_TOPGEN], 1u);
            else XB_SPIN(xb_ld(&bar[XB_TOPGEN]) == tg, bar);
            __builtin_amdgcn_fence(__ATOMIC_ACQUIRE, "agent");
            xb_add(&bar[XB_XGEN(b.x)], 1u);
            asm volatile("s_waitcnt vmcnt(0)" ::: "memory");
        } else {
            XB_SPIN(xb_ld(&bar[XB_XGEN(b.x)]) == gen, bar);
            __builtin_amdgcn_fence(__ATOMIC_ACQUIRE, "agent");
            asm volatile("s_waitcnt vmcnt(0)" ::: "memory");
        }
    }
    __syncthreads();
}

__device__ __forceinline__ float wave_sum(float v) {
#pragma unroll
    for (int o = 1; o < 64; o <<= 1) v += __shfl_xor(v, o);
    return v;
}
__device__ __forceinline__ float silu_f(float x) { return x * __builtin_amdgcn_rcpf(1.f + __builtin_amdgcn_exp2f(-1.44269504f * x)); }
__device__ __forceinline__ f32x2 swiglu_pk(f32x2 a0, f32x2 a1, float r, float r3) {
    const f32x2 t = a0 * (r * -1.44269504f); f32x2 e; e.x = __builtin_amdgcn_exp2f(t.x); e.y = __builtin_amdgcn_exp2f(t.y);
    const float is = __builtin_amdgcn_rcpf(r * r3);
    const f32x2 d = e * is + is; f32x2 rc; rc.x = __builtin_amdgcn_rcpf(d.x); rc.y = __builtin_amdgcn_rcpf(d.y);
    return (a0 * a1) * rc;
}
__device__ __forceinline__ ssq_t ssq_fix(float q) { return (ssq_t)__float2ull_rn(q * SSQ_SCALE); }
template <class T> __device__ __forceinline__ GAS T* at32(const void* base, unsigned byte_off) { return (GAS T*)((GAS unsigned char*)base + byte_off); }
__device__ __forceinline__ float rs_from(unsigned long long v) { const float f = (float)(unsigned)(v >> 32) * 4294967296.f + (float)(unsigned)v;
    return __builtin_amdgcn_rsqf(f * (SSQ_INV / (float)DM) + RMS_EPS); }
__device__ __forceinline__ float rs_of(const ssq_t* ssq, int m) { return rs_from(*at32<const unsigned long long>(ssq, (unsigned)m * 8u)); }
__device__ __forceinline__ float lg_gamma(int h) { return h == 0 ? -0.04580368961312479f : (h == 1 ? -0.02272007650008353f : (h == 2 ? -0.011315313227834146f : -0.005646563141142063f)); }
__device__ __forceinline__ unsigned pk2(float lo, float hi) { return pg8::cvt_pk_bf16(lo, hi); }
#ifndef MK_F8_MASK
#define MK_F8_MASK 0xcce
#endif
constexpr float W8_SCALE = 256.f, ACT8_SCALE = 8.f, GU8_UNSCALE = 1.f / 256.f, DN8_UNSCALE = 1.f / (256.f * 8.f);
__host__ __device__ constexpr bool f8_ffn(int lp) { return ((MK_F8_MASK) >> (2 * lp)) & 1; }
__host__ __device__ constexpr bool f8_moe(int lp) { return ((MK_F8_MASK) >> (2 * lp + 1)) & 1; }
__host__ __device__ constexpr bool f8_ein(int lp) { return ((MK_F8_MASK) >> (4 + 2 * lp)) & 1; }
__host__ __device__ constexpr bool f8_oin(int lp) { return ((MK_F8_MASK) >> (5 + 2 * lp)) & 1; }
__host__ __device__ constexpr bool f8_eout(int lp) { return ((MK_F8_MASK) >> (8 + 2 * lp)) & 1; }
__host__ __device__ constexpr bool f8_oout(int lp) { return ((MK_F8_MASK) >> (9 + 2 * lp)) & 1; }
__host__ __device__ constexpr bool f8_dn(int lp) { return f8_ffn(lp) || (((MK_F8_MASK) >> (12 + lp)) & 1); }
__device__ __forceinline__ float clamp8(float v) { return __builtin_amdgcn_fmed3f(v, -448.f, 448.f); }
__device__ __forceinline__ unsigned pk4_fp8(float a, float b, float c, float d) { int p = 0; p = __builtin_amdgcn_cvt_pk_fp8_f32(clamp8(a), clamp8(b), p, false); p = __builtin_amdgcn_cvt_pk_fp8_f32(clamp8(c), clamp8(d), p, true); return (unsigned)p; }
using pg8::bflo; using pg8::bfhi; using pg8::Unit;

struct EpiEvenIn {
    static constexpr bool PERM = true, AFTER_DRAIN = false, PROBE_TWICE = false;
    const ssq_t* ssq; bf16_t *U, *QP, *KN, *KT, *SG; float sc;
    static constexpr int PF_BYTES = 8;
    __device__ __forceinline__ const void* pf_src(const Unit& u) const { return ssq + u.pm * 256; }
    __device__ __forceinline__ void operator()(const f32x4 (&acc)[2][2][4][2], const Unit& u, int wr, int wc, int fr, int fq) const { run<false>(acc, u, wr, wc, fr, fq, nullptr); }
    __device__ __forceinline__ void with_pf(const f32x4 (&acc)[2][2][4][2], const Unit& u, int wr, int wc, int fr, int fq, const LAS unsigned char* sb) const { run<true>(acc, u, wr, wc, fr, fq, sb); }
    template <bool PFD> __device__ __forceinline__ void run(const f32x4 (&acc)[2][2][4][2], const Unit& u, int wr, int wc, int fr, int fq, const LAS unsigned char* sb) const {
        asm volatile("" : "+v"(fr), "+v"(fq));
        const int ct = u.pn, rl0 = wr * 64 + fr, row0 = u.pm * 256 + rl0, cl = wc * 32 + 8 * fq;
        if (ct < 4 || ct >= 16) {
            const bool isg = ct >= 16; bf16_t* O = isg ? SG : U; const int cb = (isg ? ct - 16 : ct) * 256;
#pragma unroll
            for (int ai = 0; ai < 2; ++ai)
#pragma unroll
                for (int m = 0; m < 4; ++m) { const int row = row0 + ai * 128 + m * 16; const float r = (PFD ? rs_from(*(const LAS unsigned long long*)(sb + (rl0 + ai * 128 + m * 16) * 8)) : rs_of(ssq, row)) * sc;
#pragma unroll
                    for (int bj = 0; bj < 2; ++bj) { f32x4 v0 = acc[ai][bj][m][0] * r, v1 = acc[ai][bj][m][1] * r;
                        if (isg) {
#pragma unroll
                            for (int j = 0; j < 4; ++j) { v0[j] = silu_f(v0[j]); v1[j] = silu_f(v1[j]); } }
                        u32x4 w; w.x = pk2(v0[0], v0[1]); w.y = pk2(v0[2], v0[3]); w.z = pk2(v1[0], v1[1]); w.w = pk2(v1[2], v1[3]);
                        *(GAS u32x4*)(O + (size_t)row * 1024 + cb + bj * 128 + cl) = w; } }
        } else {
            const bool isq = ct < 8; const int head = isq ? ct - 4 : ct - 8; const float lg = lg_gamma(head);
            float inv[2][4];
#pragma unroll
            for (int n = 0; n < 2; ++n)
#pragma unroll
                for (int j = 0; j < 4; ++j) inv[n][j] = __builtin_amdgcn_exp2f(-0.10381025296523007f * (float)(cl + 4 * n + j));
#pragma unroll
            for (int ai = 0; ai < 2; ++ai)
#pragma unroll
                for (int m = 0; m < 4; ++m) { const int rl = rl0 + ai * 128 + m * 16, row = u.pm * 256 + rl; const float r = (PFD ? rs_from(*(const LAS unsigned long long*)(sb + rl * 8)) : rs_of(ssq, row)) * (isq ? 0.0625f * sc : sc); const float pos = (float)(row & (SEQ - 1));
                    f32x4 o[2][2];
#pragma unroll
                    for (int n = 0; n < 2; ++n)
#pragma unroll
                        for (int j = 0; j < 4; ++j) { const float rev = pos * inv[n][j] * 0.15915494309189535f, fr_ = rev - __builtin_floorf(rev);
                            const float sn = __builtin_amdgcn_sinf(fr_), cs = __builtin_amdgcn_cosf(fr_); const float x1 = acc[ai][0][m][n][j] * r, x2 = acc[ai][1][m][n][j] * r;
                            o[0][n][j] = x1 * cs - x2 * sn; o[1][n][j] = x2 * cs + x1 * sn; }
#pragma unroll
                    for (int bj = 0; bj < 2; ++bj) { u32x4 w; w.x = pk2(o[bj][0][0], o[bj][0][1]); w.y = pk2(o[bj][0][2], o[bj][0][3]); w.z = pk2(o[bj][1][0], o[bj][1][1]); w.w = pk2(o[bj][1][2], o[bj][1][3]);
                        if (isq) *(GAS u32x4*)(QP + (size_t)row * 2048 + head * 512 + 256 + bj * 128 + cl) = w;
                        else *(GAS u32x4*)(KN + (size_t)row * 1024 + head * 256 + bj * 128 + cl) = w; }
                    if (!isq) {
                        const float kd = __builtin_amdgcn_exp2f(lg * (float)(255 - rl)); GAS bf16_t* kt = (GAS bf16_t*)KT + ((size_t)(u.pm * 4 + head) * 256) * 256 + rl;
#pragma unroll
                        for (int bj = 0; bj < 2; ++bj)
#pragma unroll
                            for (int n = 0; n < 2; ++n)
#pragma unroll
                                for (int j = 0; j < 4; ++j) kt[(size_t)(bj * 128 + cl + 4 * n + j) * 256] = (bf16_t)(pk2(o[bj][n][j] * kd, 0.f) & 0xffffu); }
                    __builtin_amdgcn_sched_barrier(0);
                }
        }
    }
};
struct EpiVt {
    static constexpr bool PERM = true, AFTER_DRAIN = false, PROBE_TWICE = false;
    const ssq_t* ssq; bf16_t* VS; float sc;
    static constexpr int PF_BYTES = 8;
    __device__ __forceinline__ const void* pf_src(const Unit& u) const { return ssq + u.pn * 256; }
    __device__ __forceinline__ void operator()(const f32x4 (&acc)[2][2][4][2], const Unit& u, int wr, int wc, int fr, int fq) const { run<false>(acc, u, wr, wc, fr, fq, nullptr); }
    __device__ __forceinline__ void with_pf(const f32x4 (&acc)[2][2][4][2], const Unit& u, int wr, int wc, int fr, int fq, const LAS unsigned char* sb) const { run<true>(acc, u, wr, wc, fr, fq, sb); }
    template <bool PFD> __device__ __forceinline__ void run(const f32x4 (&acc)[2][2][4][2], const Unit& u, int wr, int wc, int fr, int fq, const LAS unsigned char* sb) const {
        asm volatile("" : "+v"(fr), "+v"(fq));
        const int cl = wc * 32 + 8 * fq; bf16_t* base = VS + (size_t)(u.pn * 4 + u.pm) * 256 * 512;
        f32x4 rv[2][2];
#pragma unroll
        for (int bj = 0; bj < 2; ++bj)
#pragma unroll
            for (int n = 0; n < 2; ++n)
#pragma unroll
                for (int j = 0; j < 4; ++j) rv[bj][n][j] = (PFD ? rs_from(*(const LAS unsigned long long*)(sb + (bj * 128 + cl + 4 * n + j) * 8)) : rs_of(ssq, u.pn * 256 + bj * 128 + cl + 4 * n + j)) * sc;
#pragma unroll
        for (int ai = 0; ai < 2; ++ai)
#pragma unroll
            for (int m = 0; m < 4; ++m) { const int e = ai * 128 + wr * 64 + m * 16 + fr;
#pragma unroll
                for (int bj = 0; bj < 2; ++bj) { const f32x4 v0 = acc[ai][bj][m][0] * rv[bj][0], v1 = acc[ai][bj][m][1] * rv[bj][1];
                    u32x4 w; w.x = pk2(v0[0], v0[1]); w.y = pk2(v0[2], v0[3]); w.z = pk2(v1[0], v1[1]); w.w = pk2(v1[2], v1[3]);
                    *(GAS u32x4*)(base + (size_t)e * 512 + bj * 128 + cl) = w; } }
    }
};
struct EpiQK {
    static constexpr bool PERM = true, AFTER_DRAIN = false, PROBE_TWICE = false;
    bf16_t* QP;
    __device__ __forceinline__ void operator()(const f32x4 (&acc)[2][2][4][2], const Unit& u, int wr, int wc, int fr, int fq) const {
        asm volatile("" : "+v"(fr), "+v"(fq));
        const int cl = wc * 32 + 8 * fq; const float lg = lg_gamma(u.pn);
#pragma unroll
        for (int ai = 0; ai < 2; ++ai)
#pragma unroll
            for (int m = 0; m < 4; ++m) { const int i = ai * 128 + wr * 64 + m * 16 + fr, ci = i >> 6;
#pragma unroll
                for (int bj = 0; bj < 2; ++bj) { float o[2][4];
#pragma unroll
                    for (int n = 0; n < 2; ++n)
#pragma unroll
                        for (int j = 0; j < 4; ++j) { const int jc = bj * 128 + cl + 4 * n + j, cj = jc >> 6; const int ad = i > jc ? i - jc : jc - i;
                            const float ex = (cj == ci) ? (float)(ad - i - 1) : (float)(-jc - 1);
                            o[n][j] = (cj > ci) ? 0.f : acc[ai][bj][m][n][j] * __builtin_amdgcn_exp2f(lg * ex); }
                    u32x4 w; w.x = pk2(o[0][0], o[0][1]); w.y = pk2(o[0][2], o[0][3]); w.z = pk2(o[1][0], o[1][1]); w.w = pk2(o[1][2], o[1][3]);
                    *(GAS u32x4*)(QP + (size_t)(u.pm * 256 + i) * 2048 + u.pn * 512 + bj * 128 + cl) = w; __builtin_amdgcn_sched_barrier(0); } }
    }
};
struct EpiBf16Unit {
    static constexpr bool PERM = true, AFTER_DRAIN = false, PROBE_TWICE = false;
    bf16_t* C;
    __device__ __forceinline__ void operator()(const f32x4 (&acc)[2][2][4][2], const Unit& u, int wr, int wc, int fr, int fq) const {
        asm volatile("" : "+v"(fr), "+v"(fq));
        bf16_t* base = C + (size_t)(u.pm * 4 + u.pn) * 65536; const int cl = wc * 32 + 8 * fq;
#pragma unroll
        for (int ai = 0; ai < 2; ++ai)
#pragma unroll
            for (int m = 0; m < 4; ++m) { bf16_t* rowp = base + (size_t)(ai * 128 + wr * 64 + m * 16 + fr) * 256 + cl;
#pragma unroll
                for (int bj = 0; bj < 2; ++bj) { const f32x4 v0 = acc[ai][bj][m][0], v1 = acc[ai][bj][m][1];
                    u32x4 w; w.x = pk2(v0[0], v0[1]); w.y = pk2(v0[2], v0[3]); w.z = pk2(v1[0], v1[1]); w.w = pk2(v1[2], v1[3]);
                    *(GAS u32x4*)(rowp + bj * 128) = w; } }
    }
};
struct EpiBf16Plain {
    static constexpr bool PERM = true, AFTER_DRAIN = false, PROBE_TWICE = false;
    bf16_t* O; int ldc; unsigned char* O8;
    __device__ __forceinline__ void operator()(const f32x4 (&acc)[2][2][4][2], const Unit& u, int wr, int wc, int fr, int fq) const {
        asm volatile("" : "+v"(fr), "+v"(fq));
        const int cl = wc * 32 + 8 * fq;
#pragma unroll
        for (int ai = 0; ai < 2; ++ai)
#pragma unroll
            for (int m = 0; m < 4; ++m) { const size_t ro = (size_t)(u.pm * 256 + ai * 128 + wr * 64 + m * 16 + fr) * ldc + u.pn * 256 + cl; bf16_t* rowp = O + ro;
#pragma unroll
                for (int bj = 0; bj < 2; ++bj) { const f32x4 v0 = acc[ai][bj][m][0], v1 = acc[ai][bj][m][1];
                    u32x4 w; w.x = pk2(v0[0], v0[1]); w.y = pk2(v0[2], v0[3]); w.z = pk2(v1[0], v1[1]); w.w = pk2(v1[2], v1[3]);
                    if (!O8) *(GAS u32x4*)(rowp + bj * 128) = w;
                    if (O8) { u32x2 w8; w8.x = pk4_fp8(v0[0], v0[1], v0[2], v0[3]); w8.y = pk4_fp8(v1[0], v1[1], v1[2], v1[3]); *(GAS u32x2*)(O8 + ro + bj * 128) = w8; } } }
    }
};
struct EpiRetOut {
    static constexpr bool PERM = true, AFTER_DRAIN = true, PROBE_TWICE = false;
    const bf16_t* SG; bf16_t* YCAT; unsigned char* Y8;
    __device__ __forceinline__ void fused(f32x4 (&acc)[2][2][4][2], const Unit& u, int wr, int wc, int fr, int fq, LAS unsigned char* lds, int wid, int lane) const {
        asm volatile("" : "+v"(fr), "+v"(fq));
        LAS f32x2* P = (LAS f32x2*)lds;
        const int cl = wc * 32 + 8 * fq; const float lg = lg_gamma(u.pn);
#pragma unroll
        for (int ai = 0; ai < 2; ++ai)
#pragma unroll
            for (int m = 0; m < 4; ++m) { const int i = ai * 128 + wr * 64 + m * 16 + fr; const float sc = __builtin_amdgcn_exp2f(lg * (float)(i + 1)); float s = 0.f, q = 0.f;
#pragma unroll
                for (int bj = 0; bj < 2; ++bj)
#pragma unroll
                    for (int n = 0; n < 2; ++n) { f32x4 x = acc[ai][bj][m][n] * sc; acc[ai][bj][m][n] = x; s += (x[0] + x[1]) + (x[2] + x[3]); q += (x[0] * x[0] + x[1] * x[1]) + (x[2] * x[2] + x[3] * x[3]); }
                s += __shfl_xor(s, 16); s += __shfl_xor(s, 32); q += __shfl_xor(q, 16); q += __shfl_xor(q, 32);
                if (fq == 0) P[i * 4 + wc] = (f32x2){s, q}; }
        asm volatile("s_waitcnt lgkmcnt(0)" ::: "memory"); __builtin_amdgcn_s_barrier(); asm volatile("" ::: "memory");
#pragma unroll
        for (int ai = 0; ai < 2; ++ai)
#pragma unroll
            for (int m = 0; m < 4; ++m) { const int i = ai * 128 + wr * 64 + m * 16 + fr, row = u.pm * 256 + i;
                const f32x2 p0 = P[i * 4 + 0], p1 = P[i * 4 + 1], p2 = P[i * 4 + 2], p3 = P[i * 4 + 3];
                const float mu = ((p0.x + p1.x) + (p2.x + p3.x)) * (1.f / 256.f); float var = ((p0.y + p1.y) + (p2.y + p3.y)) * (1.f / 256.f) - mu * mu; var = var > 0.f ? var : 0.f;
                const float rstd = __builtin_amdgcn_rsqf(var + GN_EPS);
#pragma unroll
                for (int bj = 0; bj < 2; ++bj) { const u32x4 g = *(const GAS u32x4*)(SG + (size_t)row * 1024 + u.pn * 256 + bj * 128 + cl);
                    const f32x4 x0 = (acc[ai][bj][m][0] - mu) * rstd, x1 = (acc[ai][bj][m][1] - mu) * rstd;
                    const float y0 = x0[0] * bflo(g.x), y1 = x0[1] * bfhi(g.x), y2 = x0[2] * bflo(g.y), y3 = x0[3] * bfhi(g.y), y4 = x1[0] * bflo(g.z), y5 = x1[1] * bfhi(g.z), y6 = x1[2] * bflo(g.w), y7 = x1[3] * bfhi(g.w);
                    u32x4 w; w.x = pk2(y0, y1); w.y = pk2(y2, y3); w.z = pk2(y4, y5); w.w = pk2(y6, y7);
                    if (!Y8) *(GAS u32x4*)(YCAT + (size_t)row * 2048 + 1024 + u.pn * 256 + bj * 128 + cl) = w;
                    if (Y8) { u32x2 w8; w8.x = pk4_fp8(y0, y1, y2, y3); w8.y = pk4_fp8(y4, y5, y6, y7); *(GAS u32x2*)(Y8 + (size_t)row * 2048 + 1024 + u.pn * 256 + bj * 128 + cl) = w8; } } __builtin_amdgcn_sched_barrier(0); }
    }
};
template <bool F8OUT> struct EpiResidual {
    static constexpr bool PERM = true, AFTER_DRAIN = false, PROBE_TWICE = false;
    const bf16_t* res_in; bf16_t* HB; ssq_t* ssq_out; float sc; unsigned char* HB8;
    __device__ __forceinline__ void operator()(const f32x4 (&acc)[2][2][4][2], const Unit& u, int wr, int wc, int fr, int fq) const {
        asm volatile("" : "+v"(fr), "+v"(fq));
        const int c0 = u.pn * 256 + wc * 32 + 8 * fq;
#pragma unroll
        for (int ai = 0; ai < 2; ++ai)
#pragma unroll
            for (int m = 0; m < 4; ++m) { const int row = u.pm * 256 + ai * 128 + wr * 64 + m * 16 + fr; const unsigned off = (unsigned)row * (unsigned)DM + (unsigned)c0; float q = 0.f;
#pragma unroll
                for (int bj = 0; bj < 2; ++bj) { const u32x4 h = *at32<const u32x4>(res_in, (off + bj * 128) * 2u); const f32x4 a0 = acc[ai][bj][m][0] * sc, a1 = acc[ai][bj][m][1] * sc;
                    const float x0 = bflo(h.x) + a0[0], x1 = bfhi(h.x) + a0[1], x2 = bflo(h.y) + a0[2], x3 = bfhi(h.y) + a0[3], x4 = bflo(h.z) + a1[0], x5 = bfhi(h.z) + a1[1], x6 = bflo(h.w) + a1[2], x7 = bfhi(h.w) + a1[3];
                    u32x4 w; w.x = pk2(x0, x1); w.y = pk2(x2, x3); w.z = pk2(x4, x5); w.w = pk2(x6, x7); *at32<u32x4>(HB, (off + bj * 128) * 2u) = w;
                    if constexpr (F8OUT) { u32x2 w8; w8.x = pk4_fp8(x0, x1, x2, x3); w8.y = pk4_fp8(x4, x5, x6, x7); *at32<u32x2>(HB8, off + bj * 128) = w8; }
                    q += ((x0 * x0 + x1 * x1) + (x2 * x2 + x3 * x3)) + ((x4 * x4 + x5 * x5) + (x6 * x6 + x7 * x7)); }
                q += __shfl_xor(q, 16); q += __shfl_xor(q, 32);
                if (fq == 0) __hip_atomic_fetch_add((GAS ssq_t*)ssq_out + row, ssq_fix(q), RLX_AGENT); }
    }
};
template <bool F8, bool F8OUT = F8> struct EpiSwiGLU {
    static constexpr bool PERM = true, AFTER_DRAIN = false, PROBE_TWICE = true;
    const ssq_t* ssq; void* ACT; int ldc;
    static constexpr int PF_BYTES = 8;
    __device__ __forceinline__ const void* pf_src(const Unit& u) const { return ssq + u.pm * 256; }
    __device__ __forceinline__ void operator()(const f32x4 (&acc)[2][2][4][2], const Unit& u, int wr, int wc, int fr, int fq) const { run<false>(acc, u, wr, wc, fr, fq, nullptr); }
    __device__ __forceinline__ void with_pf(const f32x4 (&acc)[2][2][4][2], const Unit& u, int wr, int wc, int fr, int fq, const LAS unsigned char* sb) const { run<true>(acc, u, wr, wc, fr, fq, sb); }
    template <bool PFD> __device__ __forceinline__ void run(const f32x4 (&acc)[2][2][4][2], const Unit& u, int wr, int wc, int fr, int fq, const LAS unsigned char* sb) const {
        asm volatile("" : "+v"(fr), "+v"(fq));
        const int cl = wc * 32 + 8 * fq;
#pragma unroll
        for (int ai = 0; ai < 2; ++ai)
#pragma unroll
            for (int m = 0; m < 4; ++m) { const int rl = ai * 128 + wr * 64 + m * 16 + fr, row = u.pm * 256 + rl; const float r = (PFD ? rs_from(*(const LAS unsigned long long*)(sb + rl * 8)) : rs_of(ssq, row)) * (F8 ? GU8_UNSCALE : 1.f); float o[2][4];
#pragma unroll
                for (int n = 0; n < 2; ++n)
#pragma unroll
                    for (int j = 0; j < 4; j += 2) { const f32x2 v = swiglu_pk((f32x2){acc[ai][0][m][n][j], acc[ai][0][m][n][j + 1]}, (f32x2){acc[ai][1][m][n][j], acc[ai][1][m][n][j + 1]}, r, F8OUT ? r * ACT8_SCALE : r); o[n][j] = v.x; o[n][j + 1] = v.y; }
                if constexpr (F8OUT) { u32x2 w; w.x = pk4_fp8(o[0][0], o[0][1], o[0][2], o[0][3]); w.y = pk4_fp8(o[1][0], o[1][1], o[1][2], o[1][3]); *at32<u32x2>(ACT, (unsigned)row * (unsigned)ldc + (unsigned)(u.pn * 128 + cl)) = w; }
                else { u32x4 w; w.x = pk2(o[0][0], o[0][1]); w.y = pk2(o[0][2], o[0][3]); w.z = pk2(o[1][0], o[1][1]); w.w = pk2(o[1][2], o[1][3]); *at32<u32x4>(ACT, ((unsigned)row * (unsigned)ldc + (unsigned)(u.pn * 128 + cl)) * 2u) = w; } }
    }
};
struct EpiOddIn {
    static constexpr bool PERM = true, AFTER_DRAIN = false, PROBE_TWICE = false;
    const ssq_t* ssq; bf16_t *BG, *Z; float sc;
    static constexpr int PF_BYTES = 8;
    __device__ __forceinline__ const void* pf_src(const Unit& u) const { return ssq + u.pm * 256; }
    __device__ __forceinline__ void operator()(const f32x4 (&acc)[2][2][4][2], const Unit& u, int wr, int wc, int fr, int fq) const { run<false>(acc, u, wr, wc, fr, fq, nullptr); }
    __device__ __forceinline__ void with_pf(const f32x4 (&acc)[2][2][4][2], const Unit& u, int wr, int wc, int fr, int fq, const LAS unsigned char* sb) const { run<true>(acc, u, wr, wc, fr, fq, sb); }
    template <bool PFD> __device__ __forceinline__ void run(const f32x4 (&acc)[2][2][4][2], const Unit& u, int wr, int wc, int fr, int fq, const LAS unsigned char* sb) const {
        asm volatile("" : "+v"(fr), "+v"(fq));
        const int cl = wc * 32 + 8 * fq;
#pragma unroll
        for (int ai = 0; ai < 2; ++ai)
#pragma unroll
            for (int m = 0; m < 4; ++m) { const int rl = ai * 128 + wr * 64 + m * 16 + fr, row = u.pm * 256 + rl; const float r = (PFD ? rs_from(*(const LAS unsigned long long*)(sb + rl * 8)) : rs_of(ssq, row)) * sc;
                if (u.pn < 8) {
#pragma unroll
                    for (int bj = 0; bj < 2; ++bj) { const f32x4 v0 = acc[ai][bj][m][0] * r, v1 = acc[ai][bj][m][1] * r;
                        u32x4 w; w.x = pk2(v0[0], v0[1]); w.y = pk2(v0[2], v0[3]); w.z = pk2(v1[0], v1[1]); w.w = pk2(v1[2], v1[3]);
                        *at32<u32x4>(BG, ((unsigned)row * (unsigned)DM + (unsigned)(u.pn * 256 + bj * 128 + cl)) * 2u) = w; }
                } else { const float r2 = r * r; const f32x4 v0 = acc[ai][0][m][0] * acc[ai][1][m][0] * r2, v1 = acc[ai][0][m][1] * acc[ai][1][m][1] * r2;
                    u32x4 w; w.x = pk2(v0[0], v0[1]); w.y = pk2(v0[2], v0[3]); w.z = pk2(v1[0], v1[1]); w.w = pk2(v1[2], v1[3]);
                    *at32<u32x4>(Z, ((unsigned)row * (unsigned)DM + (unsigned)((u.pn - 8) * 128 + cl)) * 2u) = w; } }
    }
};

__device__ __forceinline__ unsigned load_counts8(const unsigned* cntw) {
    const int l = (int)__builtin_amdgcn_mbcnt_hi(~0u, __builtin_amdgcn_mbcnt_lo(~0u, 0u)); unsigned v = 0u;
    if (l < NEXP) v = __hip_atomic_load(cntw + 64 * l, RLX_AGENT);
    return v;
}
template <bool GATHER_> struct MoeOrder {
    static constexpr bool GATHER = GATHER_;
    int tp[NEXP + 1], cnt[NEXP]; int nN, G, c; const char *A0, *B0; long a_rt, b_e, b_sn; const int* rowtok; unsigned row_bytes;
    __device__ __forceinline__ void init(const unsigned* cntw, int nN_, int G_, int c_) { nN = nN_; G = G_; c = c_; tp[0] = 0;
        const unsigned cv = load_counts8(cntw);
#pragma unroll
        for (int e = 0; e < NEXP; ++e) { int v = (int)__builtin_amdgcn_readlane(cv, e); v = v < 0 ? 0 : (v > ECAP ? ECAP : v); cnt[e] = v; tp[e + 1] = tp[e] + ((v + 255) >> 8); } }
    __device__ __forceinline__ bool next(int i, Unit& u) const {
        const long L = (long)i * G + c; const int nM = tp[NEXP]; if (L >= (long)nM * nN) return false;
        int rt, pn; pg8::tile_of((int)L, nM, nN, rt, pn); int e = 0;
#pragma unroll
        for (int k = 1; k < NEXP; ++k) e = (rt >= tp[k]) ? k : e;
        int ce = cnt[0], te = tp[0];
#pragma unroll
        for (int k = 1; k < NEXP; ++k) { ce = (e == k) ? cnt[k] : ce; te = (e == k) ? tp[k] : te; }
        u.pm = rt; u.pn = pn; u.x0 = e; u.x1 = (rt - te) * 256; u.x2 = ce;
        u.a = A0 + (GATHER_ ? 0 : (long)rt * a_rt); u.b = B0 + e * b_e + pn * b_sn; return true;
    }
    __device__ __forceinline__ unsigned goff(const Unit& u, int r) const {
        const int ep = u.x1 + r; const int tok = (ep < u.x2) ? ((const GAS int*)rowtok)[u.x0 * ECAP + ep] : 0; return (unsigned)tok * row_bytes;
    }
};
template <bool F8> struct EpiMoeGU {
    static constexpr bool PERM = true, AFTER_DRAIN = false, PROBE_TWICE = true;
    const float* er; void* ACTM;
    static constexpr int PF_BYTES = 4;
    __device__ __forceinline__ const void* pf_src(const Unit& u) const { return er + u.x0 * ECAP + u.x1; }
    __device__ __forceinline__ void operator()(const f32x4 (&acc)[2][2][4][2], const Unit& u, int wr, int wc, int fr, int fq) const { run<false>(acc, u, wr, wc, fr, fq, nullptr); }
    __device__ __forceinline__ void with_pf(const f32x4 (&acc)[2][2][4][2], const Unit& u, int wr, int wc, int fr, int fq, const LAS unsigned char* sb) const { run<true>(acc, u, wr, wc, fr, fq, sb); }
    template <bool PFD> __device__ __forceinline__ void run(const f32x4 (&acc)[2][2][4][2], const Unit& u, int wr, int wc, int fr, int fq, const LAS unsigned char* sb) const {
        asm volatile("" : "+v"(fr), "+v"(fq));
        const int cl = wc * 32 + 8 * fq;
#pragma unroll
        for (int ai = 0; ai < 2; ++ai)
#pragma unroll
            for (int m = 0; m < 4; ++m) { const int i = ai * 128 + wr * 64 + m * 16 + fr, ep = u.x1 + i; const float r = ((ep < u.x2) ? (PFD ? *(const LAS float*)(sb + i * 4) : ((const GAS float*)er)[u.x0 * ECAP + ep]) : 0.f) * (F8 ? GU8_UNSCALE : 1.f); float o[2][4];
#pragma unroll
                for (int n = 0; n < 2; ++n)
#pragma unroll
                    for (int j = 0; j < 4; j += 2) { const f32x2 v = swiglu_pk((f32x2){acc[ai][0][m][n][j], acc[ai][0][m][n][j + 1]}, (f32x2){acc[ai][1][m][n][j], acc[ai][1][m][n][j + 1]}, r, F8 ? r * ACT8_SCALE : r); o[n][j] = v.x; o[n][j + 1] = v.y; }
                if constexpr (F8) { u32x2 w; w.x = pk4_fp8(o[0][0], o[0][1], o[0][2], o[0][3]); w.y = pk4_fp8(o[1][0], o[1][1], o[1][2], o[1][3]); *at32<u32x2>(ACTM, (unsigned)(u.pm * 256 + i) * (unsigned)EXD + (unsigned)(u.pn * 128 + cl)) = w; }
                else { u32x4 w; w.x = pk2(o[0][0], o[0][1]); w.y = pk2(o[0][2], o[0][3]); w.z = pk2(o[1][0], o[1][1]); w.w = pk2(o[1][2], o[1][3]); *at32<u32x4>(ACTM, ((unsigned)(u.pm * 256 + i) * (unsigned)EXD + (unsigned)(u.pn * 128 + cl)) * 2u) = w; } }
    }
};
struct EpiMoeDown {
    static constexpr bool PERM = true, AFTER_DRAIN = false, PROBE_TWICE = false;
    const float* ew; bf16_t* YC; float sc;
    static constexpr int PF_BYTES = 4;
    __device__ __forceinline__ const void* pf_src(const Unit& u) const { return ew + u.x0 * ECAP + u.x1; }
    __device__ __forceinline__ void operator()(const f32x4 (&acc)[2][2][4][2], const Unit& u, int wr, int wc, int fr, int fq) const { run<false>(acc, u, wr, wc, fr, fq, nullptr); }
    __device__ __forceinline__ void with_pf(const f32x4 (&acc)[2][2][4][2], const Unit& u, int wr, int wc, int fr, int fq, const LAS unsigned char* sb) const { run<true>(acc, u, wr, wc, fr, fq, sb); }
    template <bool PFD> __device__ __forceinline__ void run(const f32x4 (&acc)[2][2][4][2], const Unit& u, int wr, int wc, int fr, int fq, const LAS unsigned char* sb) const {
        asm volatile("" : "+v"(fr), "+v"(fq));
        const int cl = wc * 32 + 8 * fq;
#pragma unroll
        for (int ai = 0; ai < 2; ++ai)
#pragma unroll
            for (int m = 0; m < 4; ++m) { const int i = ai * 128 + wr * 64 + m * 16 + fr, ep = u.x1 + i; const float wt = ((ep < u.x2) ? (PFD ? *(const LAS float*)(sb + i * 4) : ((const GAS float*)ew)[u.x0 * ECAP + ep]) : 0.f) * sc;
#pragma unroll
                for (int bj = 0; bj < 2; ++bj) { const f32x4 v0 = acc[ai][bj][m][0] * wt, v1 = acc[ai][bj][m][1] * wt;
                    u32x4 w; w.x = pk2(v0[0], v0[1]); w.y = pk2(v0[2], v0[3]); w.z = pk2(v1[0], v1[1]); w.w = pk2(v1[2], v1[3]);
                    *at32<u32x4>(YC, ((unsigned)(u.pm * 256 + i) * (unsigned)DM + (unsigned)(u.pn * 256 + bj * 128 + cl)) * 2u) = w; } }
    }
};

struct Frame {
    LAS unsigned char* lds;
    volatile LAS unsigned* MISC;
    gu32* ctl;
    int tid, lane, wave, G, bid;
    unsigned char* ws;
    const float* const* in;
};
template <class T> __device__ __forceinline__ T* wsp(const Frame& F, size_t off) { return (T*)(F.ws + off); }

__device__ __forceinline__ int conv_src_col(int mode, int N, int n) {
    if (mode == 0) return n;
    if (mode == 1) { const int t = n >> 8, w = n & 255; return (w < 128) ? t * 128 + w : (N >> 1) + t * 128 + (w - 128); }
    if (n < 2048) return n;
    const int np = n - 2048, t = np >> 8, w = np & 255; return 2048 + ((w < 128) ? t * 128 + w : 2048 + t * 128 + (w - 128));
}
struct ConvJob { const float* W; bf16_t* WT; const float* gain; const float* scale; int K, N, mode, start; };
constexpr int N_CONV_JOBS = 52;
#ifndef MK_CV_SH
#define MK_CV_SH 1
#endif
constexpr int CV_SH = MK_CV_SH;
#ifndef MK_STEAL_N
#define MK_STEAL_N 0
#endif
__device__ __forceinline__ ConvJob conv_job_desc(const Frame& F, int j, int& deadline) {
    const int i = j / 26, q = j % 26; const int pb = 1 + 14 * i;
    int r, d;
    if (q == 0) { r = 0; d = 0; } else if (q < 5) { r = q; d = 2; } else if (q == 5) { r = 5; d = 4; } else if (q == 6) { r = 8; d = 5; } else if (q == 7) { r = 9; d = 6; }
    else if (q == 8) { r = 6; d = 7; } else if (q == 9) { r = 7; d = 9; } else if (q < 18) { r = q; d = 11; } else { r = q; d = 12; }
    deadline = pb + d;
    ConvJob J; J.gain = nullptr; J.scale = nullptr; J.mode = 0; J.start = 0;
    if (r == 0) { J.W = F.in[4] + (size_t)i * DM * EIN; J.K = DM; J.N = EIN; J.WT = wsp<bf16_t>(F, WS_EWIN) + (size_t)i * EIN * DM; J.gain = F.in[1] + (2 * i) * DM; J.mode = f8_ein(i) ? 256 : 0; }
    else if (r < 5) { const int g = r - 1; J.W = F.in[5] + (size_t)(i * 4 + g) * 65536; J.K = 256; J.N = 256; J.WT = wsp<bf16_t>(F, WS_EWP) + (size_t)(i * 4 + g) * 65536; J.scale = F.in[6] + i * 1024 + g * 256; }
    else if (r == 5) { J.W = F.in[7] + (size_t)i * DM * DM; J.K = DM; J.N = DM; J.WT = wsp<bf16_t>(F, WS_EWOUT) + (size_t)i * DM * DM; J.mode = f8_eout(i) ? 256 : 0; }
    else if (r == 6) { J.W = F.in[8] + (size_t)i * DM * OIN; J.K = DM; J.N = OIN; J.WT = wsp<bf16_t>(F, WS_OWIN) + (size_t)i * OIN * DM; J.gain = F.in[1] + (2 * i + 1) * DM; J.mode = 2 | (f8_oin(i) ? 256 : 0); }
    else if (r == 7) { J.W = F.in[10] + (size_t)i * DM * DM; J.K = DM; J.N = DM; J.WT = wsp<bf16_t>(F, WS_OWOUT) + (size_t)i * DM * DM; J.mode = f8_oout(i) ? 256 : 0; }
    else if (r == 8) { J.W = F.in[11] + (size_t)i * DM * 2 * FFN; J.K = DM; J.N = 2 * FFN; J.WT = wsp<bf16_t>(F, WS_FGU) + (size_t)i * 2 * FFN * DM; J.gain = F.in[2] + (2 * i) * DM; J.mode = 1 | (f8_ffn(i) ? 256 : 0); }
    else if (r == 9) { J.W = F.in[12] + (size_t)i * FFN * DM; J.K = FFN; J.N = DM; J.WT = wsp<bf16_t>(F, WS_FDN) + (size_t)i * DM * FFN; J.mode = f8_dn(i) ? 256 : 0; }
    else if (r < 18) { const int e = r - 10; J.W = F.in[14] + (size_t)(i * NEXP + e) * DM * 2 * EXD; J.K = DM; J.N = 2 * EXD; J.WT = wsp<bf16_t>(F, WS_MGU) + (size_t)(i * NEXP + e) * 2 * EXD * DM; J.gain = F.in[2] + (2 * i + 1) * DM; J.mode = 1 | (f8_moe(i) ? 256 : 0); }
    else { const int e = r - 18; J.W = F.in[15] + (size_t)(i * NEXP + e) * EXD * DM; J.K = EXD; J.N = DM; J.WT = wsp<bf16_t>(F, WS_MDN) + (size_t)(i * NEXP + e) * DM * EXD; J.mode = f8_moe(i) ? 256 : 0; }
    return J;
}
constexpr int CV_JP = 0, CV_JI = 1664, CV_JD = 2496, CV_ST = 2704, CV_GT = 2816, CV_MAXG = 24;
#define CV_PTRS(F_) LAS unsigned long long* jp = (LAS unsigned long long*)((F_).lds + LDSX_OFF + CV_JP); LAS int* ji = (LAS int*)((F_).lds + LDSX_OFF + CV_JI); LAS int* jd = (LAS int*)((F_).lds + LDSX_OFF + CV_JD); LAS int* st = (LAS int*)((F_).lds + LDSX_OFF + CV_ST); \
    LAS int* gst = (LAS int*)((F_).lds + LDSX_OFF + CV_GT); LAS int* gdl = gst + CV_MAXG + 1; (void)jp; (void)ji; (void)jd; (void)st; (void)gst; (void)gdl
__device__ __forceinline__ void conv_init(const Frame& F) {
    CV_PTRS(F);
    if (F.tid < N_CONV_JOBS) { int dl; const ConvJob J = conv_job_desc(F, F.tid, dl); const int j = F.tid;
        jp[j * 4 + 0] = (unsigned long long)J.W; jp[j * 4 + 1] = (unsigned long long)J.WT; jp[j * 4 + 2] = (unsigned long long)J.gain; jp[j * 4 + 3] = (unsigned long long)J.scale;
        ji[j * 4 + 0] = J.K; ji[j * 4 + 1] = J.N; ji[j * 4 + 2] = J.mode; ji[j * 4 + 3] = 0; jd[j] = dl; }
    __syncthreads();
    if (F.tid == 0) { int acc = 0, ng = 0;
        for (int j = 0; j < N_CONV_JOBS; ++j) { if (j == 0 || jd[j] != jd[j - 1]) { gst[ng] = acc; gdl[ng] = jd[j]; ++ng; } ji[j * 4 + 3] = acc; acc += (ji[j * 4 + 0] >> 7) * (ji[j * 4 + 1] >> 7); }
        gst[ng] = acc; st[0] = acc; st[2] = 0; st[3] = 0; st[5] = (F.bid < gst[1]) ? F.bid : -1; st[6] = (F.bid < gst[1]) ? 0 : 1; st[7] = ng; st[8] = -1; st[9] = -1; }
    __syncthreads();
}
__device__ __forceinline__ unsigned* conv_qhead(const Frame& F, int gi) { return (unsigned*)(F.ctl + CW_CONVQ + (gi * 8 + (F.bid & (CV_SH - 1))) * 32); }
__device__ __forceinline__ int conv_claim_finish(const Frame& F, unsigned l) {
    CV_PTRS(F);
    int cg = st[6]; const int ng = st[7], sh = F.bid & (CV_SH - 1); int res = -1;
    while (cg < ng) {
        const int r = (int)((l + (cg == 0 ? (unsigned)(F.G / CV_SH) : 0u)) * (unsigned)CV_SH) + sh;
        if (r < gst[cg + 1] - gst[cg]) { res = gst[cg] + r; break; }
        if (++cg < ng) l = xb_add(conv_qhead(F, cg), 1u);
    }
    st[6] = cg; return res;
}
struct ConvRegs { f32x4 v[8]; f32x4 sn; float gk[8]; bf16_t* WT; int K, kb, n0, f8; };
__device__ __forceinline__ void conv_load(const Frame& F, int g, int j, ConvRegs& R) {
    CV_PTRS(F);
    const float* W = (const float*)jp[j * 4 + 0]; const float* gain = (const float*)jp[j * 4 + 2]; const float* scale = (const float*)jp[j * 4 + 3];
    const int N = ji[j * 4 + 1], mode = ji[j * 4 + 2], it = g - ji[j * 4 + 3], nblk = N >> 7;
    R.WT = (bf16_t*)jp[j * 4 + 1]; R.K = ji[j * 4 + 0]; R.kb = it / nblk; R.n0 = (it % nblk) << 7; R.f8 = (mode >> 8) & 1;
    const int sc = conv_src_col(mode & 255, N, R.n0 + 4 * (F.lane & 31)), k0 = R.kb * 128 + F.wave * 16 + 8 * (F.lane >> 5);
#pragma unroll
    for (int r = 0; r < 8; ++r) R.v[r] = *(const GAS f32x4*)(W + (size_t)(k0 + r) * N + sc);
    R.sn = scale ? *(const GAS f32x4*)(scale + sc) : (f32x4){1.f, 1.f, 1.f, 1.f};
#pragma unroll
    for (int r = 0; r < 8; ++r) R.gk[r] = gain ? ((const GAS float*)gain)[k0 + r] : 1.f;
}
__device__ __forceinline__ void conv_pack(const Frame& F, const ConvRegs& R, LAS unsigned* tile) {
    const int nl = 4 * (F.lane & 31), kl = F.wave * 16 + 8 * (F.lane >> 5);
    if (R.f8) {
#pragma unroll
        for (int hh = 0; hh < 2; ++hh)
#pragma unroll
            for (int q = 0; q < 4; ++q) { const float s_ = R.sn[q] * W8_SCALE;
                tile[(nl + q) * 33 + (kl >> 2) + hh] = pk4_fp8(R.v[4 * hh][q] * (R.gk[4 * hh] * s_), R.v[4 * hh + 1][q] * (R.gk[4 * hh + 1] * s_), R.v[4 * hh + 2][q] * (R.gk[4 * hh + 2] * s_), R.v[4 * hh + 3][q] * (R.gk[4 * hh + 3] * s_)); }
    } else {
#pragma unroll
        for (int rp = 0; rp < 4; ++rp)
#pragma unroll
            for (int q = 0; q < 4; ++q) tile[(nl + q) * 65 + (kl >> 1) + rp] = pk2(R.v[2 * rp][q] * (R.gk[2 * rp] * R.sn[q]), R.v[2 * rp + 1][q] * (R.gk[2 * rp + 1] * R.sn[q]));
    }
}
__device__ __forceinline__ void conv_store(const Frame& F, const LAS unsigned* tile, bf16_t* WT, int K, int kb, int n0, int f8) {
    if (f8) {
#pragma unroll
        for (int p = 0; p < 2; ++p) { const int row = p * 64 + (F.tid >> 3), c = F.tid & 7; const LAS unsigned* s = tile + row * 33 + 4 * c;
            u32x4 o; o.x = s[0]; o.y = s[1]; o.z = s[2]; o.w = s[3];
            *(GAS u32x4*)((unsigned char*)WT + (size_t)(n0 + row) * K + kb * 128 + 16 * c) = o; }
    } else {
#pragma unroll
        for (int p = 0; p < 4; ++p) { const int row = p * 32 + (F.tid >> 4), c = F.tid & 15; const LAS unsigned* s = tile + row * 65 + 4 * c;
            u32x4 o; o.x = s[0]; o.y = s[1]; o.z = s[2]; o.w = s[3];
            *(GAS u32x4*)(WT + (size_t)(n0 + row) * K + kb * 128 + 8 * c) = o; }
    }
}
__device__ __forceinline__ int conv_run(const Frame& F0, int max_phase, int extra) {
    Frame F = F0; { int t_ = threadIdx.x; asm volatile("" : "+v"(t_)); F.tid = t_; F.lane = t_ & 63; F.wave = __builtin_amdgcn_readfirstlane(t_ >> 6); }
    CV_PTRS(F);
    __syncthreads();
    int g = st[5], j = st[2], par = st[3], slot = 0, n = 0; const bool t0 = (F.tid == 0);
#define CV_ELIGIBLE(g_) ({ bool ok_ = false; if ((g_) >= 0) { while ((g_) >= ji[j * 4 + 3] + (ji[j * 4 + 0] >> 7) * (ji[j * 4 + 1] >> 7)) ++j; ok_ = jd[j] <= max_phase; if (!ok_ && extra > 0) { --extra; ok_ = true; } } ok_; })
    ConvRegs R; unsigned cl = 0u;
    bool have = CV_ELIGIBLE(g);
    if (have) { if (t0 && st[6] < st[7]) cl = xb_add(conv_qhead(F, st[6]), 1u); conv_load(F, g, j, R); if (t0) st[8] = conv_claim_finish(F, cl); }
    while (have) {
        LAS unsigned* tile = (LAS unsigned*)(F.lds + RING_OFF) + par * (128 * 65);
        conv_pack(F, R, tile);
        bf16_t* const WTc = R.WT; const int Kc = R.K, kbc = R.kb, n0c = R.n0, f8c = R.f8;
        ++n; par ^= 1;
        __syncthreads();
        g = st[8 + slot];
        have = CV_ELIGIBLE(g);
        if (have) { if (t0 && st[6] < st[7]) cl = xb_add(conv_qhead(F, st[6]), 1u); conv_load(F, g, j, R); }
        conv_store(F, tile, WTc, Kc, kbc, n0c, f8c);
        if (have && t0) st[8 + (slot ^ 1)] = conv_claim_finish(F, cl);
        slot ^= 1;
    }
#undef CV_ELIGIBLE
    __syncthreads();
    if (t0) { st[5] = g; st[2] = j; st[3] = par; }
    return n;
}
__device__ __forceinline__ void p_prologue(const Frame& F) {
    conv_init(F);
    const int gw = F.bid * NWAVES + F.wave, NGW = F.G * NWAVES; bf16_t* HB = wsp<bf16_t>(F, WS_HB); ssq_t* ssq0 = (ssq_t*)(F.ctl + CW_SSQ);
    for (int m0 = gw; m0 < MTOK; m0 += 2 * NGW) {
        f32x4 xv[2][8];
#pragma unroll
        for (int u = 0; u < 2; ++u) { const int m = (m0 + u * NGW < MTOK) ? m0 + u * NGW : m0; const GAS f32x4* xr = (const GAS f32x4*)(F.in[0] + (size_t)m * DM) + F.lane;
#pragma unroll
            for (int jj = 0; jj < 8; ++jj) xv[u][jj] = xr[64 * jj]; }
#pragma unroll
        for (int u = 0; u < 2; ++u) { const int m = m0 + u * NGW; if (m >= MTOK) continue; GAS u32x2* o = (GAS u32x2*)(HB + (size_t)m * DM) + F.lane; float q = 0.f;
#pragma unroll
            for (int jj = 0; jj < 8; ++jj) { const f32x4 vv = xv[u][jj]; q += (vv[0] * vv[0] + vv[1] * vv[1]) + (vv[2] * vv[2] + vv[3] * vv[3]); u32x2 w; w.x = pk2(vv[0], vv[1]); w.y = pk2(vv[2], vv[3]); o[64 * jj] = w;
                if (f8_ein(0)) ((GAS unsigned*)(wsp<unsigned char>(F, WS_HB8) + (size_t)m * DM))[64 * jj + F.lane] = pk4_fp8(vv[0], vv[1], vv[2], vv[3]); }
            q = wave_sum(q); if (F.lane == 0) ((GAS ssq_t*)ssq0)[m] = ssq_fix(q); } }
}
#define PP_ACC(s_, v_, op_) do { s_[0] op_ bflo(v_.x); s_[1] op_ bfhi(v_.x); s_[2] op_ bflo(v_.y); s_[3] op_ bfhi(v_.y); s_[4] op_ bflo(v_.z); s_[5] op_ bfhi(v_.z); s_[6] op_ bflo(v_.w); s_[7] op_ bfhi(v_.w); } while (0)
__device__ __forceinline__ void t_pool_p(const Frame& F, const bf16_t* U, bf16_t* PP) {
    const int gw = F.bid * NWAVES + F.wave, NGW = F.G * NWAVES; constexpr int RUN = 16;
    for (int it = gw; it < (MTOK / RUN) * 2; it += NGW) { const int row0 = (it >> 1) * RUN, c0 = (it & 1) * 512 + F.lane * 8, g = c0 >> 8, w = 2 << g, t0 = row0 & (SEQ - 1);
        const GAS u32x4* up = (const GAS u32x4*)(U + (size_t)row0 * 1024 + c0); GAS u32x4* pp = (GAS u32x4*)(PP + (size_t)row0 * 1024 + c0);
        float s[8];
#pragma unroll
        for (int j = 0; j < 8; ++j) s[j] = 0.f;
#pragma unroll
        for (int k = 1; k < 16; ++k) if (k < w && t0 > 0) { const u32x4 v = up[-128 * k]; PP_ACC(s, v, +=); }
#pragma unroll 8
        for (int i = 0; i < RUN; ++i) { const u32x4 v = up[128 * i]; PP_ACC(s, v, +=);
            const int t = t0 + i, cnt = (t + 1) < w ? (t + 1) : w; const float ic = 1.f / (float)cnt;
            u32x4 o; o.x = pk2(s[0] * ic - bflo(v.x), s[1] * ic - bfhi(v.x)); o.y = pk2(s[2] * ic - bflo(v.y), s[3] * ic - bfhi(v.y));
            o.z = pk2(s[4] * ic - bflo(v.z), s[5] * ic - bfhi(v.z)); o.w = pk2(s[6] * ic - bflo(v.w), s[7] * ic - bfhi(v.w));
            pp[128 * i] = o;
            if (t - w + 1 >= 0) { const u32x4 d = up[128 * (i - w + 1)]; PP_ACC(s, d, -=); } }
    }
}
#undef PP_ACC
__device__ __forceinline__ void t_scan(const Frame& F, const bf16_t* LT, bf16_t* VS) {
    for (int gid = F.bid * (NWAVES * 64) + F.tid; gid < 8 * 16384; gid += F.G * NWAVES * 64) {
        const int bh = gid >> 14, rem = gid & 16383, e = rem >> 6, d4 = (rem & 63) * 4, b = bh >> 2, h = bh & 3; const float cd = __builtin_amdgcn_exp2f(lg_gamma(h) * 256.f);
        f32x4 s = (f32x4){0.f, 0.f, 0.f, 0.f};
#pragma unroll
        for (int g = 0; g < 32; ++g) { const size_t unit = (size_t)((b * 32 + g) * 4 + h);
            u32x2 w; w.x = pk2(s[0], s[1]); w.y = pk2(s[2], s[3]); *(GAS u32x2*)(VS + (unit * 256 + e) * 512 + 256 + d4) = w;
            const u32x2 l = *(const GAS u32x2*)(LT + (unit * 256 + e) * 256 + d4); s = s * cd + (f32x4){bflo(l.x), bfhi(l.x), bflo(l.y), bfhi(l.y)}; }
    }
}
__device__ __forceinline__ void t_conv(const Frame& F, const bf16_t* BG, const bf16_t* Z, const float* cw, bf16_t* Y, unsigned char* Y8) {
    const int gw = F.bid * NWAVES + F.wave, NGW = F.G * NWAVES; constexpr int RUN = 32;
    for (int it = gw; it < (MTOK / RUN) * 4; it += NGW) { const int row0 = (it >> 2) * RUN, c0 = (it & 3) * 512 + F.lane * 8, t0 = row0 & (SEQ - 1);
        float w0[8], w1[8], w2[8];
#pragma unroll
        for (int h = 0; h < 2; ++h) { const f32x4 a = *(const GAS f32x4*)(cw + c0 + 4 * h), b = *(const GAS f32x4*)(cw + DM + c0 + 4 * h), c = *(const GAS f32x4*)(cw + 2 * DM + c0 + 4 * h);
#pragma unroll
            for (int j = 0; j < 4; ++j) { w0[4 * h + j] = a[j]; w1[4 * h + j] = b[j]; w2[4 * h + j] = c[j]; } }
        u32x4 z0 = (u32x4){0u, 0u, 0u, 0u}, z1 = z0;
        if (t0 >= 2) { z0 = *(const GAS u32x4*)(Z + (size_t)(row0 - 2) * DM + c0); z1 = *(const GAS u32x4*)(Z + (size_t)(row0 - 1) * DM + c0); }
#pragma unroll 8
        for (int i = 0; i < RUN; ++i) { const size_t off = (size_t)(row0 + i) * DM + c0;
            const u32x4 z2 = *(const GAS u32x4*)(Z + off), bg = *(const GAS u32x4*)(BG + off);
            float o[8];
            o[0] = bflo(bg.x) * (bflo(z0.x) * w0[0] + bflo(z1.x) * w1[0] + bflo(z2.x) * w2[0]); o[1] = bfhi(bg.x) * (bfhi(z0.x) * w0[1] + bfhi(z1.x) * w1[1] + bfhi(z2.x) * w2[1]);
            o[2] = bflo(bg.y) * (bflo(z0.y) * w0[2] + bflo(z1.y) * w1[2] + bflo(z2.y) * w2[2]); o[3] = bfhi(bg.y) * (bfhi(z0.y) * w0[3] + bfhi(z1.y) * w1[3] + bfhi(z2.y) * w2[3]);
            o[4] = bflo(bg.z) * (bflo(z0.z) * w0[4] + bflo(z1.z) * w1[4] + bflo(z2.z) * w2[4]); o[5] = bfhi(bg.z) * (bfhi(z0.z) * w0[5] + bfhi(z1.z) * w1[5] + bfhi(z2.z) * w2[5]);
            o[6] = bflo(bg.w) * (bflo(z0.w) * w0[6] + bflo(z1.w) * w1[6] + bflo(z2.w) * w2[6]); o[7] = bfhi(bg.w) * (bfhi(z0.w) * w0[7] + bfhi(z1.w) * w1[7] + bfhi(z2.w) * w2[7]);
            u32x4 w; w.x = pk2(o[0], o[1]); w.y = pk2(o[2], o[3]); w.z = pk2(o[4], o[5]); w.w = pk2(o[6], o[7]);
            if (!Y8) *(GAS u32x4*)(Y + off) = w;
            z0 = z1; z1 = z2;
            if (Y8) { u32x2 w8; w8.x = pk4_fp8(o[0], o[1], o[2], o[3]); w8.y = pk4_fp8(o[4], o[5], o[6], o[7]); *(GAS u32x2*)(Y8 + off) = w8; } }
    }
}
__device__ __forceinline__ void t_router(const Frame& F, const bf16_t* HB, const ssq_t* ssq, const float* gain, const float* R, unsigned* cntw, int* tok_e, int* tok_pos, int* rowtok, float* er, float* ew) {
    constexpr int RPITCH = 4096 + 16;
    LAS unsigned char* Rh = F.lds + RING_OFF; LAS unsigned char* Rlo = Rh + 8 * RPITCH;
#pragma unroll
    for (int m = 0; m < DM / (NWAVES * 64); ++m) { const int k = F.tid + m * (NWAVES * 64); const f32x4 r0 = *(const GAS f32x4*)(R + (size_t)k * NEXP), r1 = *(const GAS f32x4*)(R + (size_t)k * NEXP + 4); const float gk = ((const GAS float*)gain)[k];
#pragma unroll
        for (int e = 0; e < NEXP; ++e) { const float v = (e < 4 ? r0[e & 3] : r1[e & 3]) * gk;
            const unsigned hi = pk2(v, 0.f) & 0xffffu; const float rem = v - __uint_as_float(hi << 16);
            *(LAS bf16_t*)(Rh + e * RPITCH + k * 2) = (bf16_t)hi; *(LAS bf16_t*)(Rlo + e * RPITCH + k * 2) = (bf16_t)(pk2(rem, 0.f) & 0xffffu); } }
    if (F.tid < NEXP) ((LAS unsigned*)(F.lds + RING_OFF + 16 * RPITCH + 64 + 4096))[F.tid] = 0u;
    __syncthreads();
    const int gw = F.bid * NWAVES + F.wave, NGW = F.G * NWAVES, fr = F.lane & 15, fq = F.lane >> 4, kh = F.wave & 1;
    LAS f32x4* xch = (LAS f32x4*)(F.lds + RING_OFF + 16 * RPITCH + 64) + (F.wave >> 1) * 64 + F.lane;
    LAS unsigned* lcnt = (LAS unsigned*)(F.lds + RING_OFF + 16 * RPITCH + 64 + 4096);
    for (int grp0 = 0; grp0 < MTOK / 16; grp0 += NGW >> 1) { const int grp = grp0 + (gw >> 1); const bool live = grp < MTOK / 16; const int t = (live ? grp : 0) * 16 + fr;
        const GAS bf16x8* hrow = (const GAS bf16x8*)(HB + (size_t)t * DM) + fq + kh * (DM / 16);
        const LAS bf16x8* rh = (const LAS bf16x8*)(Rh + (fr & 7) * RPITCH) + fq + kh * (DM / 16); const LAS bf16x8* rl = (const LAS bf16x8*)(Rlo + (fr & 7) * RPITCH) + fq + kh * (DM / 16);
        f32x4 ah = (f32x4){0.f, 0.f, 0.f, 0.f}, al = ah;
#pragma unroll 16
        for (int s = 0; s < DM / 64; ++s) { const bf16x8 hv = hrow[4 * s];
            ah = __builtin_amdgcn_mfma_f32_16x16x32_bf16(rh[4 * s], hv, ah, 0, 0, 0); al = __builtin_amdgcn_mfma_f32_16x16x32_bf16(rl[4 * s], hv, al, 0, 0, 0); }
        ah = ah + al;
        if (kh) *xch = ah;
        __syncthreads();
        if (!kh) ah = ah + *xch;
        __syncthreads();
        const bool act = !kh && live;
        int e1 = 0, e2 = 1; float w1 = 0.f, w2 = 0.f, r = 0.f;
        if (act) {
            r = rs_of(ssq, t);
            float p[NEXP];
#pragma unroll
            for (int j = 0; j < 4; ++j) { const float mine = ah[j] * r, other = __shfl_xor(mine, 16); p[j] = (fq & 1) ? other : mine; p[4 + j] = (fq & 1) ? mine : other; }
            float v1 = p[0];
#pragma unroll
            for (int e = 1; e < NEXP; ++e) if (p[e] > v1) { v1 = p[e]; e1 = e; }
            e2 = -1; float v2 = -3.0e38f;
#pragma unroll
            for (int e = 0; e < NEXP; ++e) if (e != e1 && p[e] > v2) { v2 = p[e]; e2 = e; }
            const float ex = __builtin_amdgcn_exp2f((v2 - v1) * 1.44269504f); w1 = 1.f / (1.f + ex); w2 = ex * w1;
        }
        unsigned l1 = 0u, l2 = 0u;
        if (act && fq == 0) { l1 = __hip_atomic_fetch_add(lcnt + e1, 1u, __ATOMIC_RELAXED, __HIP_MEMORY_SCOPE_WORKGROUP); l2 = __hip_atomic_fetch_add(lcnt + e2, 1u, __ATOMIC_RELAXED, __HIP_MEMORY_SCOPE_WORKGROUP); }
        __syncthreads();
        if (F.tid < NEXP) { const unsigned c = lcnt[F.tid]; lcnt[NEXP + F.tid] = c ? __hip_atomic_fetch_add((GAS unsigned*)cntw + 64 * F.tid, c, RLX_AGENT) : 0u; lcnt[F.tid] = 0u; }
        __syncthreads();
        if (act && fq == 0) {
            const int p1 = (int)(lcnt[NEXP + e1] + l1), p2 = (int)(lcnt[NEXP + e2] + l2);
            GAS int* te_ = (GAS int*)tok_e; GAS int* tp_ = (GAS int*)tok_pos; GAS int* rt_ = (GAS int*)rowtok; GAS float* er_ = (GAS float*)er; GAS float* ew_ = (GAS float*)ew;
            te_[2 * t] = e1; te_[2 * t + 1] = e2; tp_[2 * t] = p1; tp_[2 * t + 1] = p2;
            if (p1 < ECAP) { rt_[e1 * ECAP + p1] = t; er_[e1 * ECAP + p1] = r; ew_[e1 * ECAP + p1] = w1; }
            if (p2 < ECAP) { rt_[e2 * ECAP + p2] = t; er_[e2 * ECAP + p2] = r; ew_[e2 * ECAP + p2] = w2; } }
    }
    __syncthreads();
}
__device__ __forceinline__ void t_combine(const Frame& F, const bf16_t* HB, bf16_t* HBout, const bf16_t* YC, const unsigned* cntw, const int* tok_e, const int* tok_pos, ssq_t* ssq_next, const float* gfin, float* out, bool final_, unsigned char* HB8) {
    int tp[NEXP + 1]; tp[0] = 0;
    const unsigned cv = load_counts8(cntw);
#pragma unroll
    for (int e = 0; e < NEXP; ++e) { int v = (int)__builtin_amdgcn_readlane(cv, e); v = v < 0 ? 0 : (v > ECAP ? ECAP : v); tp[e + 1] = tp[e] + ((v + 255) >> 8); }
    const int gw = F.bid * NWAVES + F.wave, NGW = F.G * NWAVES;
    for (int t0 = gw; t0 < MTOK; t0 += 2 * NGW) {
        u32x4 rh[2][4], ra[2][4], rb[2][4]; int tt[2]; bool ok[2];
#pragma unroll
        for (int u = 0; u < 2; ++u) { const int tq = t0 + u * NGW; ok[u] = tq < MTOK; const int t = ok[u] ? tq : t0; tt[u] = t;
            const int e1 = ((const GAS int*)tok_e)[2 * t], e2 = ((const GAS int*)tok_e)[2 * t + 1], p1 = ((const GAS int*)tok_pos)[2 * t], p2 = ((const GAS int*)tok_pos)[2 * t + 1]; int b1 = 0, b2 = 0;
#pragma unroll
            for (int k = 1; k < NEXP; ++k) { b1 = (e1 == k) ? tp[k] : b1; b2 = (e2 == k) ? tp[k] : b2; }
            const size_t s1 = (size_t)b1 * 256 + p1, s2 = (size_t)b2 * 256 + p2;
            const GAS u32x4* hr = (const GAS u32x4*)(HB + (size_t)t * DM) + F.lane; const GAS u32x4* y1 = (const GAS u32x4*)(YC + s1 * DM) + F.lane; const GAS u32x4* y2 = (const GAS u32x4*)(YC + s2 * DM) + F.lane;
#pragma unroll
            for (int j = 0; j < 4; ++j) { rh[u][j] = hr[64 * j]; ra[u][j] = y1[64 * j]; rb[u][j] = y2[64 * j]; } }
#pragma unroll
        for (int u = 0; u < 2; ++u) { if (!ok[u]) continue; const int t = tt[u];
            float v[4][8]; float q = 0.f;
#pragma unroll
            for (int j = 0; j < 4; ++j) { const u32x4 h = rh[u][j], a = ra[u][j], b = rb[u][j];
                v[j][0] = bflo(h.x) + (bflo(a.x) + bflo(b.x)); v[j][1] = bfhi(h.x) + (bfhi(a.x) + bfhi(b.x)); v[j][2] = bflo(h.y) + (bflo(a.y) + bflo(b.y)); v[j][3] = bfhi(h.y) + (bfhi(a.y) + bfhi(b.y));
                v[j][4] = bflo(h.z) + (bflo(a.z) + bflo(b.z)); v[j][5] = bfhi(h.z) + (bfhi(a.z) + bfhi(b.z)); v[j][6] = bflo(h.w) + (bflo(a.w) + bflo(b.w)); v[j][7] = bfhi(h.w) + (bfhi(a.w) + bfhi(b.w));
#pragma unroll
                for (int i = 0; i < 8; ++i) q += v[j][i] * v[j][i]; }
            q = wave_sum(q);
            if (!final_) { GAS u32x4* o = (GAS u32x4*)(HBout + (size_t)t * DM) + F.lane;
#pragma unroll
                for (int j = 0; j < 4; ++j) { u32x4 w; w.x = pk2(v[j][0], v[j][1]); w.y = pk2(v[j][2], v[j][3]); w.z = pk2(v[j][4], v[j][5]); w.w = pk2(v[j][6], v[j][7]); o[64 * j] = w;
                    if (HB8) { u32x2 w8; w8.x = pk4_fp8(v[j][0], v[j][1], v[j][2], v[j][3]); w8.y = pk4_fp8(v[j][4], v[j][5], v[j][6], v[j][7]); ((GAS u32x2*)(HB8 + (size_t)t * DM))[64 * j + F.lane] = w8; } }
                if (F.lane == 0) ((GAS ssq_t*)ssq_next)[t] = ssq_fix(q);
            } else { const float r = __builtin_amdgcn_rsqf(q * (1.f / (float)DM) + RMS_EPS); GAS f32x4* o = (GAS f32x4*)(out + (size_t)t * DM) + 2 * F.lane; const GAS f32x4* gg = (const GAS f32x4*)gfin + 2 * F.lane;
#pragma unroll
                for (int j = 0; j < 4; ++j) { const f32x4 g0 = gg[128 * j], g1 = gg[128 * j + 1];
                    o[128 * j] = (f32x4){v[j][0] * r * g0[0], v[j][1] * r * g0[1], v[j][2] * r * g0[2], v[j][3] * r * g0[3]}; o[128 * j + 1] = (f32x4){v[j][4] * r * g1[0], v[j][5] * r * g1[1], v[j][6] * r * g1[2], v[j][7] * r * g1[3]}; } } }
    }
}

constexpr int N_PHASES = 29;
struct Args { const float* in[16]; float* out; unsigned char* ws; int ph_lo, ph_hi; };
__global__ void __launch_bounds__(NWAVES * 64, 2) fwd_kernel(Args args) {
    extern __shared__ __attribute__((aligned(16))) unsigned char lds_raw[];
    Frame F;
    F.lds = (LAS unsigned char*)lds_raw;
    F.MISC = (volatile LAS unsigned*)(F.lds + MISC_OFF);
    F.tid = threadIdx.x; F.lane = F.tid & 63; F.wave = __builtin_amdgcn_readfirstlane(F.tid >> 6);
    F.G = gridDim.x; F.bid = blockIdx.x;
    F.ws = args.ws; F.ctl = (gu32*)(args.ws + WS_CTL); F.in = args.in;
    for (int u = F.tid; u < (LDS_BYTES - LDSCTL_OFF) / 4; u += NWAVES * 64) ((LAS unsigned*)(F.lds + LDSCTL_OFF))[u] = 0u;
    __syncthreads();
    XcdBarrier bar; bar.bar = (unsigned*)(F.ctl + CW_BAR); bar.x = 0; bar.st = nullptr;
#if MK_ONE_LAUNCH
    bar = xcd_barrier_post((unsigned*)(F.ctl + CW_BAR), F.MISC + 8);
#endif
    const int lo = args.ph_lo, hi = args.ph_hi;
#ifndef MK_KIND_MASK
#define MK_KIND_MASK 0x7fff
#endif
#define KON(kind) (((MK_KIND_MASK) >> (kind)) & 1)
#ifndef MK_DUP_MASK
#define MK_DUP_MASK 0
#endif
#define NREP(kind) ((((MK_DUP_MASK) >> (kind)) & 1) ? 2 : 1)
#ifndef MK_DUP_BAR
#define MK_DUP_BAR 0
#endif
#define DUMMY(kind) (NREP(kind) == 2 && rep_ == 0)
#define IN(k) (lo <= (k) && (k) < hi)
#if MK_ONE_LAUNCH
#ifndef MK_BAR_REP
#define MK_BAR_REP 1
#endif
#define SEAM(k) do { if (IN(k) && IN((k) + 1)) { (void)conv_run(F, (k) + 1, cv_extra); cv_extra = 0; xcd_barrier(bar); } } while (0)
#else
#define SEAM(k) do { } while (0)
#endif
    LAS unsigned char* ring = F.lds + RING_OFF;
    int cv_extra = 0;
#define PH_WS() unsigned char* ws_ = args.ws; asm volatile("" : "+s"(ws_)); Frame Fp = F; { int t_ = threadIdx.x; asm volatile("" : "+v"(t_)); Fp.tid = t_; Fp.lane = t_ & 63; Fp.wave = __builtin_amdgcn_readfirstlane(t_ >> 6); int g_ = gridDim.x, b_ = blockIdx.x; asm volatile("" : "+s"(g_), "+s"(b_)); Fp.G = g_; Fp.bid = b_; } Fp.ws = ws_; Fp.ctl = (gu32*)(ws_ + WS_CTL); ssq_t* ssq = (ssq_t*)(Fp.ctl + CW_SSQ); (void)ssq
#define WSP(T, off) ((T*)(ws_ + (off)))
#define F8_DISPATCH(flagfn, ...) do { if constexpr (flagfn(0) == flagfn(1)) { constexpr bool F8 = flagfn(0); __VA_ARGS__ } else { if (flagfn(lp)) { constexpr bool F8 = true; __VA_ARGS__ } else { constexpr bool F8 = false; __VA_ARGS__ } } } while (0)

    if (KON(0) && IN(0)) for (int rep_ = 0; rep_ < NREP(0); ++rep_) { if (MK_DUP_BAR && rep_ == 1) { asm volatile("" ::: "memory"); xcd_barrier(bar); asm volatile("" ::: "memory"); } PH_WS(); p_prologue(Fp); } SEAM(0);

    for (int lp = 0; lp < 2; ++lp) {
        const int pb = 1 + lp * 14, a0 = lp * 4;
        if (KON(1) && IN(pb + 0)) for (int rep_ = 0; rep_ < NREP(1); ++rep_) { if (MK_DUP_BAR && rep_ == 1) { asm volatile("" ::: "memory"); xcd_barrier(bar); asm volatile("" ::: "memory"); } PH_WS();
            F8_DISPATCH(f8_ein, { constexpr int ES = F8 ? 1 : 2; constexpr float SC = F8 ? GU8_UNSCALE : 1.f;
                const char* EWIN = WSP(char, WS_EWIN) + (size_t)lp * EIN * DM * 2; const char* HBA = F8 ? WSP(char, WS_HB8) : WSP(char, WS_HB);
                { const pg8::GridOrder S = pg8::grid_order(64, 16, Fp.G, Fp.bid, HBA, 256L * DM * ES, 0, EWIN, 0, 256L * DM * ES, 12, 4);
                  const EpiEvenIn E{ssq + (size_t)a0 * MTOK, WSP(bf16_t, WS_U), WSP(bf16_t, WS_QP), WSP(bf16_t, WS_KN), WSP(bf16_t, WS_KT), WSP(bf16_t, WS_SG), SC};
                  pg8::gemm_phase<EpiEvenIn, pg8::GridOrder, true, F8>(ring, DM, DM, DM, S, E); }
                { const pg8::GridOrder S = pg8::grid_order(4, 64, Fp.G, Fp.bid, EWIN + (size_t)3072 * DM * ES, 256L * DM * ES, 0, HBA, 0, 256L * DM * ES);
                  const EpiVt E{ssq + (size_t)a0 * MTOK, WSP(bf16_t, WS_VS), SC};
                  pg8::gemm_phase<EpiVt, pg8::GridOrder, true, F8>(ring, DM, DM, DM, S, E); } });
        } SEAM(pb + 0);
        if (KON(2) && IN(pb + 1)) for (int rep_ = 0; rep_ < NREP(2); ++rep_) { if (MK_DUP_BAR && rep_ == 1) { asm volatile("" ::: "memory"); xcd_barrier(bar); asm volatile("" ::: "memory"); } PH_WS();
            t_pool_p(Fp, WSP(bf16_t, WS_U), WSP(bf16_t, WS_PP));
            { const pg8::GridOrder S = pg8::grid_order(64, 4, Fp.G, Fp.bid, WSP(bf16_t, WS_VS), 4L * 256 * 512 * 2, 256L * 512 * 2, WSP(bf16_t, WS_KT), 4L * 65536 * 2, 65536L * 2);
              const EpiBf16Unit E{WSP(bf16_t, WS_LT)};
              pg8::gemm_phase(ring, 256, 512, 256, S, E); }
        } SEAM(pb + 1);
        if (KON(3) && IN(pb + 2)) for (int rep_ = 0; rep_ < NREP(3); ++rep_) { if (MK_DUP_BAR && rep_ == 1) { asm volatile("" ::: "memory"); xcd_barrier(bar); asm volatile("" ::: "memory"); } PH_WS();
            t_scan(Fp, WSP(bf16_t, WS_LT), WSP(bf16_t, WS_VS));
            { const pg8::GridOrder S = pg8::grid_order(64, 4, Fp.G, Fp.bid, WSP(bf16_t, WS_PP), 256L * 1024 * 2, 256 * 2, WSP(bf16_t, WS_EWP) + (size_t)lp * 4 * 65536, 0, 65536L * 2);
              const EpiBf16Plain E{WSP(bf16_t, WS_YCAT), 2048, f8_eout(lp) ? WSP(unsigned char, WS_Y8) : (unsigned char*)nullptr};
              pg8::gemm_phase(ring, 256, 1024, 256, S, E); }
            { bf16_t* QP = WSP(bf16_t, WS_QP);
              const pg8::GridOrder S = pg8::grid_order(64, 4, Fp.G, Fp.bid, QP + 256, 256L * 2048 * 2, 512 * 2, WSP(bf16_t, WS_KN), 256L * 1024 * 2, 256 * 2);
              const EpiQK E{QP};
              pg8::gemm_phase(ring, 256, 2048, 1024, S, E); }
        } SEAM(pb + 2);
        if (KON(4) && IN(pb + 3)) for (int rep_ = 0; rep_ < NREP(4); ++rep_) { if (MK_DUP_BAR && rep_ == 1) { asm volatile("" ::: "memory"); xcd_barrier(bar); asm volatile("" ::: "memory"); } PH_WS();
            const pg8::GridOrder S = pg8::grid_order(64, 4, Fp.G, Fp.bid, WSP(bf16_t, WS_QP), 256L * 2048 * 2, 512 * 2, WSP(bf16_t, WS_VS), 4L * 256 * 512 * 2, 256L * 512 * 2);
            const EpiRetOut E{WSP(bf16_t, WS_SG), WSP(bf16_t, WS_YCAT), f8_eout(lp) ? WSP(unsigned char, WS_Y8) : (unsigned char*)nullptr};
            pg8::gemm_phase(ring, 512, 2048, 512, S, E);
        } SEAM(pb + 3);
        if (KON(5) && IN(pb + 4)) for (int rep_ = 0; rep_ < NREP(5); ++rep_) { PH_WS();
            F8_DISPATCH(f8_eout, { constexpr int ES = F8 ? 1 : 2; constexpr bool F8W = F8;
                const pg8::GridOrder S = pg8::grid_order(64, 8, Fp.G, Fp.bid, F8W ? WSP(char, WS_Y8) : WSP(char, WS_YCAT), 256L * DM * ES, 0, WSP(char, WS_EWOUT) + (size_t)lp * DM * DM * 2, 0, 256L * DM * ES);
                if (f8_ffn(lp)) { const EpiResidual<true> E{WSP(bf16_t, WS_HB), DUMMY(5) ? WSP(bf16_t, WS_ACTM) : WSP(bf16_t, WS_HB), ssq + (size_t)(DUMMY(5) ? 8 : a0 + 1) * MTOK, F8W ? GU8_UNSCALE : 1.f, WSP(unsigned char, WS_HB8)};
                    pg8::gemm_phase<EpiResidual<true>, pg8::GridOrder, true, F8W>(ring, DM, DM, DM, S, E); }
                else { const EpiResidual<false> E{WSP(bf16_t, WS_HB), DUMMY(5) ? WSP(bf16_t, WS_ACTM) : WSP(bf16_t, WS_HB), ssq + (size_t)(DUMMY(5) ? 8 : a0 + 1) * MTOK, F8W ? GU8_UNSCALE : 1.f, nullptr};
                    pg8::gemm_phase<EpiResidual<false>, pg8::GridOrder, true, F8W>(ring, DM, DM, DM, S, E); } });
        } SEAM(pb + 4);
        if (KON(6) && IN(pb + 5)) for (int rep_ = 0; rep_ < NREP(6); ++rep_) { if (MK_DUP_BAR && rep_ == 1) { asm volatile("" ::: "memory"); xcd_barrier(bar); asm volatile("" ::: "memory"); } PH_WS();
            F8_DISPATCH(f8_ffn, { constexpr int ES = F8 ? 1 : 2;
                const pg8::GridOrder S = pg8::grid_order(64, 44, Fp.G, Fp.bid, F8 ? WSP(char, WS_HB8) : WSP(char, WS_HB), 256L * DM * ES, 0, WSP(char, WS_FGU) + (size_t)lp * 2 * FFN * DM * 2, 0, 256L * DM * ES);
                if (f8_dn(lp)) { const EpiSwiGLU<F8, true> E{ssq + (size_t)(a0 + 1) * MTOK, WSP(void, WS_ACT), FFN}; pg8::gemm_phase<EpiSwiGLU<F8, true>, pg8::GridOrder, true, F8>(ring, DM, DM, DM, S, E); }
                else { const EpiSwiGLU<F8, false> E{ssq + (size_t)(a0 + 1) * MTOK, WSP(void, WS_ACT), FFN}; pg8::gemm_phase<EpiSwiGLU<F8, false>, pg8::GridOrder, true, F8>(ring, DM, DM, DM, S, E); } });
        } SEAM(pb + 5);
        if (KON(7) && IN(pb + 6)) for (int rep_ = 0; rep_ < NREP(7); ++rep_) { if (MK_DUP_BAR && rep_ == 1) { asm volatile("" ::: "memory"); xcd_barrier(bar); asm volatile("" ::: "memory"); } PH_WS();
            F8_DISPATCH(f8_dn, { constexpr int ES = F8 ? 1 : 2; constexpr bool F8IN = F8;
                const pg8::GridOrder S = pg8::grid_order(64, 8, Fp.G, Fp.bid, WSP(char, WS_ACT), 256L * FFN * ES, 0, WSP(char, WS_FDN) + (size_t)lp * DM * FFN * 2, 0, 256L * FFN * ES);
                if (f8_oin(lp) && !DUMMY(7)) { const EpiResidual<true> E{WSP(bf16_t, WS_HB), WSP(bf16_t, WS_HB), ssq + (size_t)(a0 + 2) * MTOK, F8IN ? DN8_UNSCALE : 1.f, WSP(unsigned char, WS_HB8)};
                    pg8::gemm_phase<EpiResidual<true>, pg8::GridOrder, true, F8IN>(ring, FFN, FFN, FFN, S, E); }
                else { const EpiResidual<false> E{WSP(bf16_t, WS_HB), DUMMY(7) ? WSP(bf16_t, WS_ACTM) : WSP(bf16_t, WS_HB), ssq + (size_t)(DUMMY(7) ? 8 : a0 + 2) * MTOK, F8IN ? DN8_UNSCALE : 1.f, nullptr};
                    pg8::gemm_phase<EpiResidual<false>, pg8::GridOrder, true, F8IN>(ring, FFN, FFN, FFN, S, E); } });
        } SEAM(pb + 6);
        if (KON(8) && IN(pb + 7)) for (int rep_ = 0; rep_ < NREP(8); ++rep_) { if (MK_DUP_BAR && rep_ == 1) { asm volatile("" ::: "memory"); xcd_barrier(bar); asm volatile("" ::: "memory"); } PH_WS();
            F8_DISPATCH(f8_oin, { constexpr int ES = F8 ? 1 : 2;
                const pg8::GridOrder S = pg8::grid_order(64, 24, Fp.G, Fp.bid, F8 ? WSP(char, WS_HB8) : WSP(char, WS_HB), 256L * DM * ES, 0, WSP(char, WS_OWIN) + (size_t)lp * OIN * DM * 2, 0, 256L * DM * ES);
                const EpiOddIn E{ssq + (size_t)(a0 + 2) * MTOK, WSP(bf16_t, WS_BG), WSP(bf16_t, WS_Z), F8 ? GU8_UNSCALE : 1.f};
                pg8::gemm_phase<EpiOddIn, pg8::GridOrder, true, F8>(ring, DM, DM, DM, S, E); });
        } SEAM(pb + 7);
        if (KON(9) && IN(pb + 8)) for (int rep_ = 0; rep_ < NREP(9); ++rep_) { if (MK_DUP_BAR && rep_ == 1) { asm volatile("" ::: "memory"); xcd_barrier(bar); asm volatile("" ::: "memory"); } PH_WS(); t_conv(Fp, WSP(bf16_t, WS_BG), WSP(bf16_t, WS_Z), args.in[9] + (size_t)lp * 3 * DM, WSP(bf16_t, WS_YCAT), f8_oout(lp) ? WSP(unsigned char, WS_Y8) : (unsigned char*)nullptr); } SEAM(pb + 8);
        if (KON(10) && IN(pb + 9)) for (int rep_ = 0; rep_ < NREP(10); ++rep_) { PH_WS();
            F8_DISPATCH(f8_oout, { constexpr int ES = F8 ? 1 : 2; constexpr bool F8W = F8;
                const pg8::GridOrder S = pg8::grid_order(64, 8, Fp.G, Fp.bid, F8W ? WSP(char, WS_Y8) : WSP(char, WS_YCAT), 256L * DM * ES, 0, WSP(char, WS_OWOUT) + (size_t)lp * DM * DM * 2, 0, 256L * DM * ES);
                if (f8_moe(lp)) { const EpiResidual<true> E{WSP(bf16_t, WS_HB), DUMMY(10) ? WSP(bf16_t, WS_ACTM) : WSP(bf16_t, WS_HB), ssq + (size_t)(DUMMY(10) ? 8 : a0 + 3) * MTOK, F8W ? GU8_UNSCALE : 1.f, WSP(unsigned char, WS_HB8)};
                    pg8::gemm_phase<EpiResidual<true>, pg8::GridOrder, true, F8W>(ring, DM, DM, DM, S, E); }
                else { const EpiResidual<false> E{WSP(bf16_t, WS_HB), DUMMY(10) ? WSP(bf16_t, WS_ACTM) : WSP(bf16_t, WS_HB), ssq + (size_t)(DUMMY(10) ? 8 : a0 + 3) * MTOK, F8W ? GU8_UNSCALE : 1.f, nullptr};
                    pg8::gemm_phase<EpiResidual<false>, pg8::GridOrder, true, F8W>(ring, DM, DM, DM, S, E); } });
        } SEAM(pb + 9);
        if (KON(11) && IN(pb + 10)) for (int rep_ = 0; rep_ < NREP(11); ++rep_) { if (MK_DUP_BAR && rep_ == 1) { asm volatile("" ::: "memory"); xcd_barrier(bar); asm volatile("" ::: "memory"); } PH_WS(); const size_t dmy_ = DUMMY(11) ? 2 * MiB : 0;
            t_router(Fp, WSP(bf16_t, WS_HB), ssq + (size_t)(a0 + 3) * MTOK, args.in[2] + (2 * lp + 1) * DM, args.in[13] + (size_t)lp * DM * NEXP, (unsigned*)(Fp.ctl + CW_CNT + (DUMMY(11) ? 2 + lp : lp) * NEXP * 64),
                     WSP(int, WS_MISC + MS_TOKE + dmy_), WSP(int, WS_MISC + MS_TOKP + dmy_), WSP(int, WS_MISC + MS_ROWTOK + dmy_), WSP(float, WS_MISC + MS_ER + dmy_), WSP(float, WS_MISC + MS_EW + dmy_)); } SEAM(pb + 10);
        if (KON(12) && IN(pb + 11)) for (int rep_ = 0; rep_ < NREP(12); ++rep_) { if (MK_DUP_BAR && rep_ == 1) { asm volatile("" ::: "memory"); xcd_barrier(bar); asm volatile("" ::: "memory"); } PH_WS();
            F8_DISPATCH(f8_moe, { constexpr int ES = F8 ? 1 : 2;
                MoeOrder<true> S; S.init((unsigned*)(Fp.ctl + CW_CNT + lp * NEXP * 64), 22, Fp.G, Fp.bid); S.A0 = F8 ? WSP(char, WS_HB8) : WSP(char, WS_HB); S.B0 = WSP(char, WS_MGU) + (size_t)lp * NEXP * 2 * EXD * DM * 2;
                S.a_rt = 0; S.b_e = 2L * EXD * DM * 2; S.b_sn = 256L * DM * ES; S.rowtok = WSP(int, WS_MISC + MS_ROWTOK); S.row_bytes = DM * ES;
                const EpiMoeGU<F8> E{WSP(float, WS_MISC + MS_ER), WSP(void, WS_ACTM)};
                pg8::gemm_phase<EpiMoeGU<F8>, MoeOrder<true>, true, F8>(ring, DM, DM, DM, S, E); });
        } SEAM(pb + 11);
        if (KON(13) && IN(pb + 12)) for (int rep_ = 0; rep_ < NREP(13); ++rep_) { if (MK_DUP_BAR && rep_ == 1) { asm volatile("" ::: "memory"); xcd_barrier(bar); asm volatile("" ::: "memory"); } PH_WS();
            F8_DISPATCH(f8_moe, { constexpr int ES = F8 ? 1 : 2;
                MoeOrder<false> S; S.init((unsigned*)(Fp.ctl + CW_CNT + lp * NEXP * 64), 8, Fp.G, Fp.bid); S.A0 = WSP(char, WS_ACTM); S.B0 = WSP(char, WS_MDN) + (size_t)lp * NEXP * DM * EXD * 2;
                S.a_rt = 256L * EXD * ES; S.b_e = (long)DM * EXD * 2; S.b_sn = 256L * EXD * ES; S.rowtok = nullptr; S.row_bytes = 0;
                const EpiMoeDown E{WSP(float, WS_MISC + MS_EW), WSP(bf16_t, WS_YC), F8 ? DN8_UNSCALE : 1.f};
                pg8::gemm_phase<EpiMoeDown, MoeOrder<false>, true, F8>(ring, EXD, EXD, EXD, S, E);
                { const int total = S.tp[NEXP] * 8, maxr = (total + Fp.G - 1) / Fp.G; if ((long)(maxr - 1) * Fp.G + Fp.bid >= total) cv_extra = MK_STEAL_N; } });
        } SEAM(pb + 12);
        if (KON(14) && IN(pb + 13)) for (int rep_ = 0; rep_ < NREP(14); ++rep_) { if (MK_DUP_BAR && rep_ == 1) { asm volatile("" ::: "memory"); xcd_barrier(bar); asm volatile("" ::: "memory"); } PH_WS();
            t_combine(Fp, WSP(bf16_t, WS_HB), DUMMY(14) ? WSP(bf16_t, WS_ACTM) : WSP(bf16_t, WS_HB), WSP(bf16_t, WS_YC), (unsigned*)(Fp.ctl + CW_CNT + lp * NEXP * 64), WSP(int, WS_MISC + MS_TOKE), WSP(int, WS_MISC + MS_TOKP), ssq + (size_t)(DUMMY(14) ? 8 : a0 + 4) * MTOK, args.in[3], DUMMY(14) ? WSP(float, WS_BG) : args.out, lp == 1, (lp == 0 && f8_ein(1) && !DUMMY(14)) ? WSP(unsigned char, WS_HB8) : (unsigned char*)nullptr); } SEAM(pb + 13);
    }
#undef PH_WS
#undef WSP
#undef F8_DISPATCH
#undef IN
#undef SEAM
}

extern "C" void kernel_launch(void* const* d_in, const int* in_sizes, int n_in, void* d_out, int out_size, void* d_ws, size_t ws_size, hipStream_t stream) {
    static int grid = 0;
    if (grid == 0) {
        if (n_in != 16 || in_sizes[0] != MTOK * DM || out_size != MTOK * DM || ws_size < WS_END) { fprintf(stderr, "kernel_launch: unexpected shapes / workspace (n_in %d, in0 %d, out %d, ws %zu < %zu); nothing launched\n", n_in, n_in > 0 ? in_sizes[0] : -1, out_size, ws_size, (size_t)WS_END); grid = -1; return; }
        int dev = 0, cus = 0, per_cu = 0;
        if (hipGetDevice(&dev) != hipSuccess || hipDeviceGetAttribute(&cus, hipDeviceAttributeMultiprocessorCount, dev) != hipSuccess) { fprintf(stderr, "kernel_launch: device query failed\n"); grid = -1; return; }
        if (hipFuncSetAttribute((const void*)fwd_kernel, hipFuncAttributeMaxDynamicSharedMemorySize, LDS_BYTES) != hipSuccess) { fprintf(stderr, "kernel_launch: hipFuncSetAttribute failed\n"); grid = -1; return; }
        if (hipOccupancyMaxActiveBlocksPerMultiprocessor(&per_cu, (const void*)fwd_kernel, NWAVES * 64, LDS_BYTES) != hipSuccess || per_cu < 1) { fprintf(stderr, "kernel_launch: occupancy query reports %d blocks per CU; nothing launched\n", per_cu); (void)hipGetLastError(); grid = -1; return; }
        if (cus != 256) { fprintf(stderr, "kernel_launch: built for a 256-CU device, found %d CUs; nothing launched\n", cus); grid = -1; return; }
        grid = cus;
    }
    if (grid < 0) return;
    if (hipMemsetAsync((char*)d_ws + WS_CTL, 0, CTL_ZERO_BYTES, stream) != hipSuccess) { fprintf(stderr, "kernel_launch: memset failed\n"); return; }
    Args a{};
    for (int i = 0; i < 16; ++i) a.in[i] = (const float*)d_in[i];
    a.out = (float*)d_out; a.ws = (unsigned char*)d_ws;
#if MK_ONE_LAUNCH
    a.ph_lo = 0; a.ph_hi = N_PHASES;
    hipLaunchKernelGGL(fwd_kernel, dim3(grid), dim3(NWAVES * 64), LDS_BYTES, stream, a);
#else
    for (int p = 0; p < N_PHASES; ++p) { a.ph_lo = p; a.ph_hi = p + 1; hipLaunchKernelGGL(fwd_kernel, dim3(grid), dim3(NWAVES * 64), LDS_BYTES, stream, a); }
#endif
    const hipError_t le = hipPeekAtLastError();
    if (le != hipSuccess) fprintf(stderr, "kernel_launch: launch failed: %s\n", hipGetErrorName(le));
}
```

```cpp
#include <hip/hip_runtime.h>
#include <cstdio>
#include <cstdint>

#define LAS __attribute__((address_space(3)))
#define GAS __attribute__((address_space(1)))
typedef unsigned short bf16_t;
typedef short bf16x8 __attribute__((ext_vector_type(8)));
typedef float f32x4 __attribute__((ext_vector_type(4)));
typedef float f32x2 __attribute__((ext_vector_type(2)));
typedef unsigned u32x4 __attribute__((ext_vector_type(4)));
typedef unsigned u32x2 __attribute__((ext_vector_type(2)));
typedef GAS unsigned gu32;

#ifndef MK_FAST_GEMM
#define MK_FAST_GEMM 1
#endif
#ifndef MK_ONE_LAUNCH
#define MK_ONE_LAUNCH 1
#endif

namespace pg8 {
constexpr int BM = 256, BK = 64, HALF = 128, HTB = HALF * BK * 2  , STAGE_BYTES = 8 * HTB, NXCD = 8, WGM = 8;

__host__ __device__ __forceinline__ int lds_byte(int r, int c) { const int st = (r >> 4) * 2 + (c >> 5), rr = r & 15, cc = c & 31, ob = rr * 64 + cc * 2; return st * 1024 + (ob ^ (((ob >> 9) & 1) << 5)); }
__host__ __device__ __forceinline__ void stage_rc(int b, int& R, int& C) { const int st = b / 1024, sb = b % 1024, swz = sb ^ (((sb >> 9) & 1) << 5); R = (st >> 1) * 16 + swz / 64; C = (st & 1) * 32 + (swz % 64) / 2; }
__host__ __device__ __forceinline__ int perm32(int rho) { const int n = rho >> 4, i = rho & 15; return 8 * (i >> 2) + 4 * n + (i & 3); }

struct Unit { int pm, pn; const char* a; const char* b; int x0, x1, x2; };

__device__ __forceinline__ void tile_of(int L, int nM, int nN, int& pm, int& pn) {
    const int nwg = nM * nN; int wgid = L;
    { const int q = nwg / NXCD, r = nwg % NXCD, xcd = wgid % NXCD, off = wgid / NXCD; wgid = (xcd < r ? xcd * (q + 1) : r * (q + 1) + (xcd - r) * q) + off; }
    const int nig = WGM * nN, gid = wgid / nig, fm = gid * WGM, gsz = (nM - fm) < WGM ? (nM - fm) : WGM;
    pm = fm + ((wgid % nig) % gsz); pn = (wgid % nig) / gsz;
}

struct GridOrder {
    static constexpr bool GATHER = false;
    int nM, nN, G, c, skip_from, skip_by;
    const char *A0, *B0; long a_sm, a_sn, b_sm, b_sn;
    __device__ __forceinline__ bool next(int i, Unit& u) const {
        const long L = (long)i * G + c; if (L >= (long)nM * nN) return false;
        int pm, pn; tile_of((int)L, nM, nN, pm, pn); if (pn >= skip_from) pn += skip_by;
        u.pm = pm; u.pn = pn; u.a = A0 + pm * a_sm + pn * a_sn; u.b = B0 + pm * b_sm + pn * b_sn; u.x0 = u.x1 = u.x2 = 0; return true;
    }
    __device__ __forceinline__ unsigned goff(const Unit&, int) const { return 0u; }
};
__device__ __forceinline__ GridOrder grid_order(int nM, int nN, int G, int c, const void* A0, long a_sm, long a_sn, const void* B0, long b_sm, long b_sn, int skip_from = 1 << 30, int skip_by = 0) {
    GridOrder S; S.nM = nM; S.nN = nN; S.G = G; S.c = c; S.skip_from = skip_from; S.skip_by = skip_by; S.A0 = (const char*)A0; S.B0 = (const char*)B0; S.a_sm = a_sm; S.a_sn = a_sn; S.b_sm = b_sm; S.b_sn = b_sn; return S;
}

__device__ __forceinline__ unsigned cvt_pk_bf16(float lo, float hi) { unsigned r; asm volatile("v_cvt_pk_bf16_f32 %0, %1, %2" : "=v"(r) : "v"(lo), "v"(hi)); return r; }
__device__ __forceinline__ float bf2f(unsigned short b) { return __uint_as_float(((unsigned)b) << 16); }
__device__ __forceinline__ float bflo(unsigned w) { return __uint_as_float(w << 16); }
__device__ __forceinline__ float bfhi(unsigned w) { return __uint_as_float(w & 0xffff0000u); }

typedef int i32x8 __attribute__((ext_vector_type(8)));
typedef int i32x4 __attribute__((ext_vector_type(4)));
typedef float f32x8 __attribute__((ext_vector_type(8)));
__device__ __forceinline__ i32x8 frag8(bf16x8 lo, bf16x8 hi) { const i32x4 a = __builtin_bit_cast(i32x4, lo), b = __builtin_bit_cast(i32x4, hi); return (i32x8){a[0], a[1], a[2], a[3], b[0], b[1], b[2], b[3]}; }

constexpr int PF_SIDE_OFF = 131072 + 4096, PF_SIDE_BYTES = 2048;
template <class E, class = void> struct epi_pf { static constexpr int value = 0; };
template <class E> struct epi_pf<E, decltype((void)E::PF_BYTES)> { static constexpr int value = E::PF_BYTES; };
template <class Epi, class Sched, bool ALIGN_EPI = true>
__device__ __forceinline__ void gemm_phase_ref(LAS unsigned char* lds, const int K, const int lda, const int ldb, const Sched& S, const Epi& E) {
    const int tid = threadIdx.x, wid = __builtin_amdgcn_readfirstlane(tid >> 6), lane = tid & 63, wr = wid >> 2, wc = wid & 3, fr = lane & 15, fq = lane >> 4;
    constexpr int KT = 32, LDR = KT + 8;
    LAS bf16_t* As = (LAS bf16_t*)lds; LAS bf16_t* Bs = As + 256 * LDR;
    for (int ui = 0;; ++ui) {
        Unit u; if (!S.next(ui, u)) break;
        f32x4 acc[2][2][4][2];
#pragma unroll
        for (int a = 0; a < 2; ++a)
#pragma unroll
            for (int b = 0; b < 2; ++b)
#pragma unroll
                for (int m = 0; m < 4; ++m)
#pragma unroll
                    for (int n = 0; n < 2; ++n) acc[a][b][m][n] = (f32x4){0.f, 0.f, 0.f, 0.f};
        for (int k0 = 0; k0 < K; k0 += KT) {
            __syncthreads();
            for (int c = tid; c < 1024; c += 512) { const int row = c >> 2, ch = c & 3;
                const char* ap = Sched::GATHER ? (u.a + S.goff(u, row)) : (u.a + (size_t)row * lda * 2);
                const u32x4 va = *(const GAS u32x4*)(ap + (size_t)k0 * 2 + ch * 16); *(LAS u32x4*)(As + row * LDR + ch * 8) = va;
                const u32x4 vb = *(const GAS u32x4*)(u.b + (size_t)row * ldb * 2 + (size_t)k0 * 2 + ch * 16); *(LAS u32x4*)(Bs + row * LDR + ch * 8) = vb; }
            __syncthreads();
            for (int kk = 0; kk < KT; ++kk) {
                float av[2][4], bv[2][2][4];
#pragma unroll
                for (int ai = 0; ai < 2; ++ai)
#pragma unroll
                    for (int m = 0; m < 4; ++m) av[ai][m] = bf2f(As[(ai * 128 + wr * 64 + m * 16 + fr) * LDR + kk]);
#pragma unroll
                for (int bj = 0; bj < 2; ++bj)
#pragma unroll
                    for (int n = 0; n < 2; ++n)
#pragma unroll
                        for (int j = 0; j < 4; ++j) { const int col = Epi::PERM ? (bj * 128 + wc * 32 + 8 * fq + 4 * n + j) : (bj * 128 + wc * 32 + 16 * n + 4 * fq + j); bv[bj][n][j] = bf2f(Bs[col * LDR + kk]); }
#pragma unroll
                for (int ai = 0; ai < 2; ++ai)
#pragma unroll
                    for (int bj = 0; bj < 2; ++bj)
#pragma unroll
                        for (int m = 0; m < 4; ++m)
#pragma unroll
                            for (int n = 0; n < 2; ++n)
#pragma unroll
                                for (int j = 0; j < 4; ++j) acc[ai][bj][m][n][j] += av[ai][m] * bv[bj][n][j];
            }
        }
        if constexpr (Epi::AFTER_DRAIN) { __syncthreads(); E.fused(acc, u, wr, wc, fr, fq, lds, wid, lane); __syncthreads(); }
        else E(acc, u, wr, wc, fr, fq);
    }
    __syncthreads();
}

template <class Epi, class Sched, bool ALIGN_EPI = true, bool FP8 = false>
__device__ __forceinline__ void gemm_phase_fast(LAS unsigned char* lds, const int K, const int lda, const int ldb, const Sched& S, const Epi& E) {
    int tid_ = threadIdx.x; asm volatile("" : "+v"(tid_));
    const int tid = tid_, wid = __builtin_amdgcn_readfirstlane(tid >> 6), lane = tid & 63, wr = wid >> 2, wc = wid & 3, fr = lane & 15, fq = lane >> 4;
    constexpr int ESZ = FP8 ? 1 : 2;
    const int nt = K * ESZ / (BK * 2);
    constexpr bool GA = Sched::GATHER;
    unsigned voffA[2], voffB[2], colA[2]; int rowA[2];
#pragma unroll
    for (int i = 0; i < 2; ++i) { int R, C; stage_rc(tid * 16 + i * 8192, R, C); const int Rb = Epi::PERM ? ((R & ~31) + perm32(R & 31)) : R;
        voffA[i] = (unsigned)(R * lda * ESZ + C * 2); voffB[i] = (unsigned)(Rb * ldb * ESZ + C * 2); colA[i] = (unsigned)C * 2u; rowA[i] = R; }
    const size_t kstep = (size_t)(BK * 2);
    const size_t hstepA = GA ? (size_t)0 : (size_t)HALF * lda * ESZ, hstepB = (size_t)HALF * ldb * ESZ;
    const unsigned ldsw = (unsigned)wid * 1024u;
    const int aoff = lds_byte(wr * 64 + fr, fq * 8), boff = lds_byte(wc * 32 + fr, fq * 8);
    unsigned gC[2][2], gN[2][2];
#define PG8_SA(b, h) (((b) * 2 + (h)) * HTB)
#define PG8_SB(b, h) ((4 + (b) * 2 + (h)) * HTB)
#define PG8_GLDS(gp, bufoff, _i) __builtin_amdgcn_global_load_lds((const unsigned*)(gp), (LAS unsigned*)(lds + (bufoff) + ldsw + (_i) * 8192), 16, 0, 0)
#define PG8_STAGE_B(bufoff, gbase) do { _Pragma("unroll") for (int _i = 0; _i < 2; ++_i) PG8_GLDS((const char*)(gbase) + voffB[_i], bufoff, _i); } while (0)
#define PG8_STAGE_A(bufoff, gbase, h, nx) do { _Pragma("unroll") for (int _i = 0; _i < 2; ++_i) { \
        if constexpr (GA) PG8_GLDS((const char*)(gbase) + ((nx) ? gN[h][_i] : gC[h][_i]), bufoff, _i); \
        else PG8_GLDS((const char*)(gbase) + (h) * hstepA + voffA[_i], bufoff, _i); } } while (0)
#define PG8_LDA(dst, b, h) do { if constexpr (FP8) { _Pragma("unroll") for (int m = 0; m < 4; ++m) { dst##8[m].lo = *(const LAS i32x4*)(lds + PG8_SA(b, h) + aoff + m * 2048); dst##8[m].hi = *(const LAS i32x4*)(lds + PG8_SA(b, h) + aoff + m * 2048 + 1024); } } \
        else { _Pragma("unroll") for (int m = 0; m < 4; ++m) _Pragma("unroll") for (int k = 0; k < 2; ++k) dst[m][k] = *(const LAS bf16x8*)(lds + PG8_SA(b, h) + aoff + m * 2048 + k * 1024); } } while (0)
#define PG8_LDB(dst, b, h) do { if constexpr (FP8) { _Pragma("unroll") for (int n = 0; n < 2; ++n) { dst##8[n].lo = *(const LAS i32x4*)(lds + PG8_SB(b, h) + boff + n * 2048); dst##8[n].hi = *(const LAS i32x4*)(lds + PG8_SB(b, h) + boff + n * 2048 + 1024); } } \
        else { _Pragma("unroll") for (int n = 0; n < 2; ++n) _Pragma("unroll") for (int k = 0; k < 2; ++k) dst[n][k] = *(const LAS bf16x8*)(lds + PG8_SB(b, h) + boff + n * 2048 + k * 1024); } } while (0)
#define PG8_MMA(ai, bj, At, Bt) do { __builtin_amdgcn_s_setprio(1); _Pragma("unroll") for (int m = 0; m < 4; ++m) _Pragma("unroll") for (int n = 0; n < 2; ++n) { \
        if constexpr (FP8) asm volatile("v_mfma_scale_f32_16x16x128_f8f6f4 %0, %1, %2, %0, %3, %3 op_sel_hi:[0,0,0]" : "+v"(acc[ai][bj][m][n]) : "v"(Bt##8[n]), "v"(At##8[m]), "v"(sc1)); \
        else { _Pragma("unroll") for (int k = 0; k < 2; ++k) acc[ai][bj][m][n] = __builtin_amdgcn_mfma_f32_16x16x32_bf16(Bt[n][k], At[m][k], acc[ai][bj][m][n], 0, 0, 0); } } __builtin_amdgcn_s_setprio(0); } while (0)
#define PG8_WAIT_V(n) asm volatile("s_waitcnt vmcnt(" #n ")" ::: "memory")
#define PG8_WAIT_L(n) asm volatile("s_waitcnt lgkmcnt(" #n ")" ::: "memory")
#define PG8_BAR __builtin_amdgcn_s_barrier()
#define PG8_SCHED __builtin_amdgcn_sched_barrier(0)
    Unit cur, nxt; int ui = 0;
    if (!S.next(0, cur)) return;
    f32x4 acc[2][2][4][2];
#pragma unroll
    for (int a = 0; a < 2; ++a)
#pragma unroll
        for (int b = 0; b < 2; ++b)
#pragma unroll
            for (int m = 0; m < 4; ++m)
#pragma unroll
                for (int n = 0; n < 2; ++n) acc[a][b][m][n] = (f32x4){0.f, 0.f, 0.f, 0.f};
    bf16x8 At[4][2], B0[2][2], B1[2][2];
    i32x8 At8[4], B08[2], B18[2];
    const int sc1 = 0x7f7f7f7f;
    (void)At; (void)B0; (void)B1; (void)At8; (void)B08; (void)B18; (void)sc1;
    const char* cA = cur.a; const char* cB = cur.b;
    if constexpr (GA) {
#pragma unroll
        for (int h = 0; h < 2; ++h)
#pragma unroll
            for (int i = 0; i < 2; ++i) { gC[h][i] = S.goff(cur, h * HALF + rowA[i]) + colA[i]; gN[h][i] = gC[h][i]; }
    }
    PG8_STAGE_B(PG8_SB(0, 0), cB); PG8_STAGE_B(PG8_SB(0, 1), cB + hstepB); PG8_STAGE_A(PG8_SA(0, 0), cA, 0, false); PG8_STAGE_A(PG8_SA(0, 1), cA, 1, false);
    if (wr == 1) PG8_BAR;
    PG8_WAIT_V(2); PG8_BAR;
    PG8_STAGE_B(PG8_SB(1, 0), cB + kstep); PG8_STAGE_A(PG8_SA(1, 0), cA + kstep, 0, false); PG8_STAGE_B(PG8_SB(1, 1), cB + hstepB + kstep);
    PG8_WAIT_V(6); PG8_BAR;
#pragma unroll 1
    for (;;) {
        const bool has_next = S.next(ui + 1, nxt);
        if constexpr (epi_pf<Epi>::value > 0) {
            if (epi_pf<Epi>::value == 8 || wid < 4) { unsigned m_ = ~0u; asm volatile("" : "+s"(m_)); const int l_ = (int)__builtin_amdgcn_mbcnt_hi(m_, __builtin_amdgcn_mbcnt_lo(m_, 0u));
                __builtin_amdgcn_global_load_lds((const unsigned*)((const char*)E.pf_src(cur) + (wid * 64 + l_) * 4), (LAS unsigned*)(lds + PF_SIDE_OFF + (ui & 1) * PF_SIDE_BYTES + wid * 256), 4, 0, 0); } }
        const char* nA = has_next ? nxt.a : cA; const char* nB = has_next ? nxt.b : cB;
        if constexpr (GA) { if (has_next) {
#pragma unroll
            for (int h = 0; h < 2; ++h)
#pragma unroll
                for (int i = 0; i < 2; ++i) gN[h][i] = S.goff(nxt, h * HALF + rowA[i]) + colA[i]; } }
#pragma unroll 1
        for (int t = 0; t < nt; t += 2) {
            const bool last = (t == nt - 2);
            const char* a1 = cA + (size_t)(t + 1) * kstep;
            const char* a2 = last ? nA : cA + (size_t)(t + 2) * kstep; const char* b2 = last ? nB : cB + (size_t)(t + 2) * kstep;
            const char* a3 = a2 + kstep; const char* b3 = b2 + kstep;
            PG8_LDB(B0, 0, 0); PG8_LDB(B1, 0, 1); PG8_SCHED; PG8_LDA(At, 0, 0); PG8_STAGE_A(PG8_SA(1, 1), a1, 1, false);
            PG8_WAIT_V(8); PG8_WAIT_L(0); PG8_BAR; PG8_MMA(0, 0, At, B0); PG8_MMA(0, 1, At, B1); PG8_BAR; PG8_SCHED;
            PG8_LDA(At, 0, 1); PG8_STAGE_B(PG8_SB(0, 0), b2); PG8_STAGE_B(PG8_SB(0, 1), b2 + hstepB); PG8_STAGE_A(PG8_SA(0, 0), a2, 0, last);
            PG8_WAIT_V(8); PG8_WAIT_L(0); PG8_BAR; PG8_MMA(1, 0, At, B0); PG8_MMA(1, 1, At, B1); PG8_BAR; PG8_SCHED;
            PG8_LDB(B0, 1, 0); PG8_LDB(B1, 1, 1); PG8_SCHED; PG8_LDA(At, 1, 0); PG8_STAGE_A(PG8_SA(0, 1), a2, 1, last);
            PG8_WAIT_V(8); PG8_WAIT_L(0); PG8_BAR; PG8_MMA(0, 0, At, B0); PG8_MMA(0, 1, At, B1); PG8_BAR; PG8_SCHED;
            PG8_LDA(At, 1, 1); PG8_STAGE_B(PG8_SB(1, 0), b3); PG8_STAGE_B(PG8_SB(1, 1), b3 + hstepB); PG8_STAGE_A(PG8_SA(1, 0), a3, 0, last);
            PG8_WAIT_V(8); PG8_WAIT_L(0); PG8_BAR; PG8_MMA(1, 0, At, B0); PG8_MMA(1, 1, At, B1); PG8_BAR; PG8_SCHED;
        }
        if constexpr (ALIGN_EPI) { if (wr == 0) PG8_BAR; }
        if constexpr (FP8) asm volatile("s_nop 15\n\ts_nop 15" ::: "memory");
        if constexpr (!Epi::AFTER_DRAIN) { if constexpr (epi_pf<Epi>::value > 0) E.with_pf(acc, cur, wr, wc, fr, fq, (const LAS unsigned char*)(lds + PF_SIDE_OFF + (ui & 1) * PF_SIDE_BYTES)); else E(acc, cur, wr, wc, fr, fq);
#if defined(MK_EPI_TWICE)
            if constexpr (Epi::PROBE_TWICE) { asm volatile("" ::: "memory"); E(acc, cur, wr, wc, fr, fq); }
#endif
        }
        if (!has_next) break;
#pragma unroll
        for (int a = 0; a < 2; ++a)
#pragma unroll
            for (int b = 0; b < 2; ++b)
#pragma unroll
                for (int m = 0; m < 4; ++m)
#pragma unroll
                    for (int n = 0; n < 2; ++n) acc[a][b][m][n] = (f32x4){0.f, 0.f, 0.f, 0.f};
        cur = nxt; cA = nA; cB = nB; ++ui;
        if constexpr (GA) {
#pragma unroll
            for (int h = 0; h < 2; ++h)
#pragma unroll
                for (int i = 0; i < 2; ++i) gC[h][i] = gN[h][i]; }
        if constexpr (ALIGN_EPI) { if (wr == 1) PG8_BAR; }
    }
    PG8_WAIT_V(0);
    if constexpr (!ALIGN_EPI) { if (wr == 0) PG8_BAR; }
    PG8_BAR;
    if constexpr (Epi::AFTER_DRAIN) { E.fused(acc, cur, wr, wc, fr, fq, lds, wid, lane); PG8_BAR; }
#undef PG8_SA
#undef PG8_SB
#undef PG8_GLDS
#undef PG8_STAGE_A
#undef PG8_STAGE_B
#undef PG8_LDA
#undef PG8_LDB
#undef PG8_MMA
#undef PG8_WAIT_V
#undef PG8_WAIT_L
#undef PG8_BAR
#undef PG8_SCHED
}

template <class Epi, class Sched, bool ALIGN_EPI = true, bool FP8 = false>
__device__ __forceinline__ void gemm_phase(LAS unsigned char* lds, const int K, const int lda, const int ldb, const Sched& S, const Epi& E) {
#if MK_FAST_GEMM
    gemm_phase_fast<Epi, Sched, ALIGN_EPI, FP8>(lds, K, lda, ldb, S, E);
#else
    gemm_phase_ref<Epi, Sched, ALIGN_EPI>(lds, K, lda, ldb, S, E);
#endif
}
}

constexpr int NWAVES = 8;
constexpr int DM = 2048, SEQ = 8192, MTOK = 16384;
constexpr int EIN = 5120, FFN = 5632, EXD = 2816, NEXP = 8, OIN = 6144;
constexpr int ECAP = 16384;
constexpr int MOE_ROWS = 2 * MTOK + NEXP * 256;
constexpr float RMS_EPS = 1e-6f, GN_EPS = 1e-5f;

constexpr size_t MiB = 1u << 20;
constexpr size_t WS_CTL = 0, CTL_ZERO_BYTES = 2 * MiB;
constexpr size_t WS_MISC = 2 * MiB;
constexpr size_t WS_EWIN = 8 * MiB;
constexpr size_t WS_EWP = WS_EWIN + 40 * MiB;
constexpr size_t WS_EWOUT = WS_EWP + 1 * MiB;
constexpr size_t WS_OWIN = WS_EWOUT + 16 * MiB;
constexpr size_t WS_OWOUT = WS_OWIN + 48 * MiB;
constexpr size_t WS_FGU = WS_OWOUT + 16 * MiB;
constexpr size_t WS_FDN = WS_FGU + 88 * MiB;
constexpr size_t WS_MGU = WS_FDN + 44 * MiB;
constexpr size_t WS_MDN = WS_MGU + 352 * MiB;
constexpr size_t WS_HB = WS_MDN + 176 * MiB;
constexpr size_t WS_U = WS_HB + 64 * MiB;
constexpr size_t WS_QP = WS_U + 32 * MiB;
constexpr size_t WS_KN = WS_QP + 64 * MiB;
constexpr size_t WS_SG = WS_KN + 32 * MiB;
constexpr size_t WS_KT = WS_SG + 32 * MiB;
constexpr size_t WS_VS = WS_KT + 32 * MiB;
constexpr size_t WS_LT = WS_VS + 64 * MiB;
constexpr size_t WS_PP = WS_LT + 64 * MiB;
constexpr size_t WS_YCAT = WS_PP + 32 * MiB;
constexpr size_t WS_ACT = WS_YCAT + 64 * MiB;
constexpr size_t WS_BG = WS_ACT + 176 * MiB;
constexpr size_t WS_Z = WS_BG + 64 * MiB;
constexpr size_t WS_ACTM = WS_Z + 64 * MiB;
constexpr size_t WS_YC = WS_ACTM + 188 * MiB;
constexpr size_t WS_HB8 = WS_YC + 136 * MiB;
constexpr size_t WS_Y8 = WS_HB8 + 32 * MiB;
constexpr size_t WS_END = WS_Y8 + 32 * MiB;
static_assert((size_t)MOE_ROWS * EXD * 2 <= 188 * MiB && (size_t)MOE_ROWS * DM * 2 <= 136 * MiB, "moe buffers");
constexpr size_t MS_TOKE = 0, MS_TOKP = 128 * 1024, MS_ROWTOK = 256 * 1024, MS_ER = 768 * 1024, MS_EW = 1280 * 1024;
constexpr int CW_TMO = 0, CW_CODE = 1;
constexpr int CW_BAR = 4096;
constexpr int CW_CNT = 8192;
constexpr int CW_CONVQ = 16384;
constexpr int CW_SSQ = 65536;
static_assert((CW_SSQ + 2 * 9 * MTOK) * 4 <= (int)CTL_ZERO_BYTES, "CTL words inside the memset region");
typedef unsigned long long ssq_t;
constexpr float SSQ_SCALE = 1048576.f, SSQ_INV = 1.f / 1048576.f;

constexpr int RING_OFF = 0, RING_BYTES = 131072;
constexpr int LDSX_OFF = RING_BYTES;
constexpr int LDSCTL_OFF = RING_BYTES + 8192, MISC_OFF = LDSCTL_OFF + 320;
constexpr int LDS_BYTES = 147456;
static_assert(MISC_OFF + 128 <= LDS_BYTES, "LDS map");
static_assert(pg8::PF_SIDE_OFF == LDSX_OFF + 4096 && pg8::PF_SIDE_OFF + 2 * pg8::PF_SIDE_BYTES <= LDSCTL_OFF, "epilogue prefetch side area");

#define RLX_AGENT __ATOMIC_RELAXED, __HIP_MEMORY_SCOPE_AGENT
#define LDS_WAIT() asm volatile("s_waitcnt lgkmcnt(0)" ::: "memory")
#define VM_WAIT() asm volatile("s_waitcnt vmcnt(0)" ::: "memory")

#define XB_TMO      128
#define XB_XCNT(j)  (256  + 64 * (j))
#define XB_XSUB(j)  (1280 + 64 * (j))
#define XB_XGEN(j)  (2304 + 64 * (j))
#define XB_TOP      3328
#define XB_TOPGEN   3392
#define XCD_BAR_WORDS 3456
#define XB_SPIN_CAP (1u << 22)

__device__ __forceinline__ unsigned xb_ld(unsigned* p)              { return __hip_atomic_load(p, __ATOMIC_RELAXED, __HIP_MEMORY_SCOPE_AGENT); }
__device__ __forceinline__ unsigned xb_add(unsigned* p, unsigned v) { return __hip_atomic_fetch_add(p, v, __ATOMIC_RELAXED, __HIP_MEMORY_SCOPE_AGENT); }
__device__ __forceinline__ unsigned xb_xcc_id() { return (unsigned)__builtin_amdgcn_s_getreg((3 << 11) | 20) & 0xFu; }
#define XB_SPIN(cond, bar) do { unsigned _sp = 0; while (cond) { __builtin_amdgcn_s_sleep(1); \
    if ((++_sp & 255u) == 0u) { if (xb_ld(&(bar)[XB_TMO])) break; if (_sp > XB_SPIN_CAP) { atomicAdd(&(bar)[XB_TMO], 1u); break; } } } } while (0)

struct XcdBarrier { unsigned* bar; unsigned x; volatile LAS unsigned* st; };

__device__ __forceinline__ XcdBarrier xcd_barrier_post(unsigned* bar, volatile LAS unsigned* st) {
    XcdBarrier b; b.bar = bar; b.x = xb_xcc_id(); b.st = st;
    if (threadIdx.x == 0) (void)xb_add(&bar[XB_XCNT(b.x)], 1u);
    return b;
}
__device__ __forceinline__ void xcd_barrier_complete(unsigned* bar, unsigned x, unsigned& nloc, unsigned& nx) {
    const unsigned G = gridDim.x * gridDim.y * gridDim.z;
    unsigned sum, cnt, mine, sp = 0u;
    for (;;) {
        sum = 0u; cnt = 0u; mine = 0u;
#pragma unroll
        for (unsigned j = 0; j < 16; ++j) { const unsigned c = xb_ld(&bar[XB_XCNT(j)]); sum += c; cnt += (c > 0u) ? 1u : 0u; mine = (j == x) ? c : mine; }
        if (sum == G) break;
        __builtin_amdgcn_s_sleep(1);
        if ((++sp & 255u) == 0u) { if (xb_ld(&bar[XB_TMO])) break; if (sp > XB_SPIN_CAP) { atomicAdd(&bar[XB_TMO], 1u); break; } }
    }
    nloc = mine > 0u ? mine : 1u; nx = cnt > 0u ? cnt : 1u;
}
__device__ __forceinline__ void xcd_barrier(const XcdBarrier& b) {
    asm volatile("s_waitcnt vmcnt(0)" ::: "memory");
    __syncthreads();
    if (threadIdx.x == 0) {
        unsigned* bar = b.bar;
        __builtin_amdgcn_s_waitcnt(0);
        unsigned nloc = b.st[0], nx = b.st[1];
        if (nloc == 0u) { xcd_barrier_complete(bar, b.x, nloc, nx); b.st[0] = nloc; b.st[1] = nx; }
        const unsigned old = xb_add(&bar[XB_XSUB(b.x)], 1u);
        const unsigned gen = old / nloc;
        if (old + 1u == (gen + 1u) * nloc) {
            __builtin_amdgcn_fence(__ATOMIC_RELEASE, "agent");
            asm volatile("s_waitcnt vmcnt(0)" ::: "memory");
            const unsigned og = xb_add(&bar[XB_TOP], 1u);
            const unsigned tg = og / nx;
            if (og + 1u == (tg + 1u) * nx) xb_add(&bar[XB_TOPGEN], 1u);
            else XB_SPIN(xb_ld(&bar[XB_TOPGEN]) == tg, bar);
            __builtin_amdgcn_fence(__ATOMIC_ACQUIRE, "agent");
            xb_add(&bar[XB_XGEN(b.x)], 1u);
            asm volatile("s_waitcnt vmcnt(0)" ::: "memory");
        } else {
            XB_SPIN(xb_ld(&bar[XB_XGEN(b.x)]) == gen, bar);
            __builtin_amdgcn_fence(__ATOMIC_ACQUIRE, "agent");
            asm volatile("s_waitcnt vmcnt(0)" ::: "memory");
        }
    }
    __syncthreads();
}

__device__ __forceinline__ float wave_sum(float v) {
#pragma unroll
    for (int o = 1; o < 64; o <<= 1) v += __shfl_xor(v, o);
    return v;
}
__device__ __forceinline__ float silu_f(float x) { return x * __builtin_amdgcn_rcpf(1.f + __builtin_amdgcn_exp2f(-1.44269504f * x)); }
__device__ __forceinline__ f32x2 swiglu_pk(f32x2 a0, f32x2 a1, float r, float r3) {
    const f32x2 t = a0 * (r * -1.44269504f); f32x2 e; e.x = __builtin_amdgcn_exp2f(t.x); e.y = __builtin_amdgcn_exp2f(t.y);
    const float is = __builtin_amdgcn_rcpf(r * r3);
    const f32x2 d = e * is + is; f32x2 rc; rc.x = __builtin_amdgcn_rcpf(d.x); rc.y = __builtin_amdgcn_rcpf(d.y);
    return (a0 * a1) * rc;
}
__device__ __forceinline__ ssq_t ssq_fix(float q) { return (ssq_t)__float2ull_rn(q * SSQ_SCALE); }
template <class T> __device__ __forceinline__ GAS T* at32(const void* base, unsigned byte_off) { return (GAS T*)((GAS unsigned char*)base + byte_off); }
__device__ __forceinline__ float rs_from(unsigned long long v) { const float f = (float)(unsigned)(v >> 32) * 4294967296.f + (float)(unsigned)v;
    return __builtin_amdgcn_rsqf(f * (SSQ_INV / (float)DM) + RMS_EPS); }
__device__ __forceinline__ float rs_of(const ssq_t* ssq, int m) { return rs_from(*at32<const unsigned long long>(ssq, (unsigned)m * 8u)); }
__device__ __forceinline__ float lg_gamma(int h) { return h == 0 ? -0.04580368961312479f : (h == 1 ? -0.02272007650008353f : (h == 2 ? -0.011315313227834146f : -0.005646563141142063f)); }
__device__ __forceinline__ unsigned pk2(float lo, float hi) { return pg8::cvt_pk_bf16(lo, hi); }
#ifndef MK_F8_MASK
#define MK_F8_MASK 0xcce
#endif
constexpr float W8_SCALE = 256.f, ACT8_SCALE = 8.f, GU8_UNSCALE = 1.f / 256.f, DN8_UNSCALE = 1.f / (256.f * 8.f);
__host__ __device__ constexpr bool f8_ffn(int lp) { return ((MK_F8_MASK) >> (2 * lp)) & 1; }
__host__ __device__ constexpr bool f8_moe(int lp) { return ((MK_F8_MASK) >> (2 * lp + 1)) & 1; }
__host__ __device__ constexpr bool f8_ein(int lp) { return ((MK_F8_MASK) >> (4 + 2 * lp)) & 1; }
__host__ __device__ constexpr bool f8_oin(int lp) { return ((MK_F8_MASK) >> (5 + 2 * lp)) & 1; }
__host__ __device__ constexpr bool f8_eout(int lp) { return ((MK_F8_MASK) >> (8 + 2 * lp)) & 1; }
__host__ __device__ constexpr bool f8_oout(int lp) { return ((MK_F8_MASK) >> (9 + 2 * lp)) & 1; }
__host__ __device__ constexpr bool f8_dn(int lp) { return f8_ffn(lp) || (((MK_F8_MASK) >> (12 + lp)) & 1); }
__device__ __forceinline__ float clamp8(float v) { return __builtin_amdgcn_fmed3f(v, -448.f, 448.f); }
__device__ __forceinline__ unsigned pk4_fp8(float a, float b, float c, float d) { int p = 0; p = __builtin_amdgcn_cvt_pk_fp8_f32(clamp8(a), clamp8(b), p, false); p = __builtin_amdgcn_cvt_pk_fp8_f32(clamp8(c), clamp8(d), p, true); return (unsigned)p; }
using pg8::bflo; using pg8::bfhi; using pg8::Unit;

struct EpiEvenIn {
    static constexpr bool PERM = true, AFTER_DRAIN = false, PROBE_TWICE = false;
    const ssq_t* ssq; bf16_t *U, *QP, *KN, *KT, *SG; float sc;
    static constexpr int PF_BYTES = 8;
    __device__ __forceinline__ const void* pf_src(const Unit& u) const { return ssq + u.pm * 256; }
    __device__ __forceinline__ void operator()(const f32x4 (&acc)[2][2][4][2], const Unit& u, int wr, int wc, int fr, int fq) const { run<false>(acc, u, wr, wc, fr, fq, nullptr); }
    __device__ __forceinline__ void with_pf(const f32x4 (&acc)[2][2][4][2], const Unit& u, int wr, int wc, int fr, int fq, const LAS unsigned char* sb) const { run<true>(acc, u, wr, wc, fr, fq, sb); }
    template <bool PFD> __device__ __forceinline__ void run(const f32x4 (&acc)[2][2][4][2], const Unit& u, int wr, int wc, int fr, int fq, const LAS unsigned char* sb) const {
        asm volatile("" : "+v"(fr), "+v"(fq));
        const int ct = u.pn, rl0 = wr * 64 + fr, row0 = u.pm * 256 + rl0, cl = wc * 32 + 8 * fq;
        if (ct < 4 || ct >= 16) {
            const bool isg = ct >= 16; bf16_t* O = isg ? SG : U; const int cb = (isg ? ct - 16 : ct) * 256;
#pragma unroll
            for (int ai = 0; ai < 2; ++ai)
#pragma unroll
                for (int m = 0; m < 4; ++m) { const int row = row0 + ai * 128 + m * 16; const float r = (PFD ? rs_from(*(const LAS unsigned long long*)(sb + (rl0 + ai * 128 + m * 16) * 8)) : rs_of(ssq, row)) * sc;
#pragma unroll
                    for (int bj = 0; bj < 2; ++bj) { f32x4 v0 = acc[ai][bj][m][0] * r, v1 = acc[ai][bj][m][1] * r;
                        if (isg) {
#pragma unroll
                            for (int j = 0; j < 4; ++j) { v0[j] = silu_f(v0[j]); v1[j] = silu_f(v1[j]); } }
                        u32x4 w; w.x = pk2(v0[0], v0[1]); w.y = pk2(v0[2], v0[3]); w.z = pk2(v1[0], v1[1]); w.w = pk2(v1[2], v1[3]);
                        *(GAS u32x4*)(O + (size_t)row * 1024 + cb + bj * 128 + cl) = w; } }
        } else {
            const bool isq = ct < 8; const int head = isq ? ct - 4 : ct - 8; const float lg = lg_gamma(head);
            float inv[2][4];
#pragma unroll
            for (int n = 0; n < 2; ++n)
#pragma unroll
                for (int j = 0; j < 4; ++j) inv[n][j] = __builtin_amdgcn_exp2f(-0.10381025296523007f * (float)(cl + 4 * n + j));
#pragma unroll
            for (int ai = 0; ai < 2; ++ai)
#pragma unroll
                for (int m = 0; m < 4; ++m) { const int rl = rl0 + ai * 128 + m * 16, row = u.pm * 256 + rl; const float r = (PFD ? rs_from(*(const LAS unsigned long long*)(sb + rl * 8)) : rs_of(ssq, row)) * (isq ? 0.0625f * sc : sc); const float pos = (float)(row & (SEQ - 1));
                    f32x4 o[2][2];
#pragma unroll
                    for (int n = 0; n < 2; ++n)
#pragma unroll
                        for (int j = 0; j < 4; ++j) { const float rev = pos * inv[n][j] * 0.15915494309189535f, fr_ = rev - __builtin_floorf(rev);
                            const float sn = __builtin_amdgcn_sinf(fr_), cs = __builtin_amdgcn_cosf(fr_); const float x1 = acc[ai][0][m][n][j] * r, x2 = acc[ai][1][m][n][j] * r;
                            o[0][n][j] = x1 * cs - x2 * sn; o[1][n][j] = x2 * cs + x1 * sn; }
#pragma unroll
                    for (int bj = 0; bj < 2; ++bj) { u32x4 w; w.x = pk2(o[bj][0][0], o[bj][0][1]); w.y = pk2(o[bj][0][2], o[bj][0][3]); w.z = pk2(o[bj][1][0], o[bj][1][1]); w.w = pk2(o[bj][1][2], o[bj][1][3]);
                        if (isq) *(GAS u32x4*)(QP + (size_t)row * 2048 + head * 512 + 256 + bj * 128 + cl) = w;
                        else *(GAS u32x4*)(KN + (size_t)row * 1024 + head * 256 + bj * 128 + cl) = w; }
                    if (!isq) {
                        const float kd = __builtin_amdgcn_exp2f(lg * (float)(255 - rl)); GAS bf16_t* kt = (GAS bf16_t*)KT + ((size_t)(u.pm * 4 + head) * 256) * 256 + rl;
#pragma unroll
                        for (int bj = 0; bj < 2; ++bj)
#pragma unroll
                            for (int n = 0; n < 2; ++n)
#pragma unroll
                                for (int j = 0; j < 4; ++j) kt[(size_t)(bj * 128 + cl + 4 * n + j) * 256] = (bf16_t)(pk2(o[bj][n][j] * kd, 0.f) & 0xffffu); }
                    __builtin_amdgcn_sched_barrier(0);
                }
        }
    }
};
struct EpiVt {
    static constexpr bool PERM = true, AFTER_DRAIN = false, PROBE_TWICE = false;
    const ssq_t* ssq; bf16_t* VS; float sc;
    static constexpr int PF_BYTES = 8;
    __device__ __forceinline__ const void* pf_src(const Unit& u) const { return ssq + u.pn * 256; }
    __device__ __forceinline__ void operator()(const f32x4 (&acc)[2][2][4][2], const Unit& u, int wr, int wc, int fr, int fq) const { run<false>(acc, u, wr, wc, fr, fq, nullptr); }
    __device__ __forceinline__ void with_pf(const f32x4 (&acc)[2][2][4][2], const Unit& u, int wr, int wc, int fr, int fq, const LAS unsigned char* sb) const { run<true>(acc, u, wr, wc, fr, fq, sb); }
    template <bool PFD> __device__ __forceinline__ void run(const f32x4 (&acc)[2][2][4][2], const Unit& u, int wr, int wc, int fr, int fq, const LAS unsigned char* sb) const {
        asm volatile("" : "+v"(fr), "+v"(fq));
        const int cl = wc * 32 + 8 * fq; bf16_t* base = VS + (size_t)(u.pn * 4 + u.pm) * 256 * 512;
        f32x4 rv[2][2];
#pragma unroll
        for (int bj = 0; bj < 2; ++bj)
#pragma unroll
            for (int n = 0; n < 2; ++n)
#pragma unroll
                for (int j = 0; j < 4; ++j) rv[bj][n][j] = (PFD ? rs_from(*(const LAS unsigned long long*)(sb + (bj * 128 + cl + 4 * n + j) * 8)) : rs_of(ssq, u.pn * 256 + bj * 128 + cl + 4 * n + j)) * sc;
#pragma unroll
        for (int ai = 0; ai < 2; ++ai)
#pragma unroll
            for (int m = 0; m < 4; ++m) { const int e = ai * 128 + wr * 64 + m * 16 + fr;
#pragma unroll
                for (int bj = 0; bj < 2; ++bj) { const f32x4 v0 = acc[ai][bj][m][0] * rv[bj][0], v1 = acc[ai][bj][m][1] * rv[bj][1];
                    u32x4 w; w.x = pk2(v0[0], v0[1]); w.y = pk2(v0[2], v0[3]); w.z = pk2(v1[0], v1[1]); w.w = pk2(v1[2], v1[3]);
                    *(GAS u32x4*)(base + (size_t)e * 512 + bj * 128 + cl) = w; } }
    }
};
struct EpiQK {
    static constexpr bool PERM = true, AFTER_DRAIN = false, PROBE_TWICE = false;
    bf16_t* QP;
    __device__ __forceinline__ void operator()(const f32x4 (&acc)[2][2][4][2], const Unit& u, int wr, int wc, int fr, int fq) const {
        asm volatile("" : "+v"(fr), "+v"(fq));
        const int cl = wc * 32 + 8 * fq; const float lg = lg_gamma(u.pn);
#pragma unroll
        for (int ai = 0; ai < 2; ++ai)
#pragma unroll
            for (int m = 0; m < 4; ++m) { const int i = ai * 128 + wr * 64 + m * 16 + fr, ci = i >> 6;
#pragma unroll
                for (int bj = 0; bj < 2; ++bj) { float o[2][4];
#pragma unroll
                    for (int n = 0; n < 2; ++n)
#pragma unroll
                        for (int j = 0; j < 4; ++j) { const int jc = bj * 128 + cl + 4 * n + j, cj = jc >> 6; const int ad = i > jc ? i - jc : jc - i;
                            const float ex = (cj == ci) ? (float)(ad - i - 1) : (float)(-jc - 1);
                            o[n][j] = (cj > ci) ? 0.f : acc[ai][bj][m][n][j] * __builtin_amdgcn_exp2f(lg * ex); }
                    u32x4 w; w.x = pk2(o[0][0], o[0][1]); w.y = pk2(o[0][2], o[0][3]); w.z = pk2(o[1][0], o[1][1]); w.w = pk2(o[1][2], o[1][3]);
                    *(GAS u32x4*)(QP + (size_t)(u.pm * 256 + i) * 2048 + u.pn * 512 + bj * 128 + cl) = w; __builtin_amdgcn_sched_barrier(0); } }
    }
};
struct EpiBf16Unit {
    static constexpr bool PERM = true, AFTER_DRAIN = false, PROBE_TWICE = false;
    bf16_t* C;
    __device__ __forceinline__ void operator()(const f32x4 (&acc)[2][2][4][2], const Unit& u, int wr, int wc, int fr, int fq) const {
        asm volatile("" : "+v"(fr), "+v"(fq));
        bf16_t* base = C + (size_t)(u.pm * 4 + u.pn) * 65536; const int cl = wc * 32 + 8 * fq;
#pragma unroll
        for (int ai = 0; ai < 2; ++ai)
#pragma unroll
            for (int m = 0; m < 4; ++m) { bf16_t* rowp = base + (size_t)(ai * 128 + wr * 64 + m * 16 + fr) * 256 + cl;
#pragma unroll
                for (int bj = 0; bj < 2; ++bj) { const f32x4 v0 = acc[ai][bj][m][0], v1 = acc[ai][bj][m][1];
                    u32x4 w; w.x = pk2(v0[0], v0[1]); w.y = pk2(v0[2], v0[3]); w.z = pk2(v1[0], v1[1]); w.w = pk2(v1[2], v1[3]);
                    *(GAS u32x4*)(rowp + bj * 128) = w; } }
    }
};
struct EpiBf16Plain {
    static constexpr bool PERM = true, AFTER_DRAIN = false, PROBE_TWICE = false;
    bf16_t* O; int ldc; unsigned char* O8;
    __device__ __forceinline__ void operator()(const f32x4 (&acc)[2][2][4][2], const Unit& u, int wr, int wc, int fr, int fq) const {
        asm volatile("" : "+v"(fr), "+v"(fq));
        const int cl = wc * 32 + 8 * fq;
#pragma unroll
        for (int ai = 0; ai < 2; ++ai)
#pragma unroll
            for (int m = 0; m < 4; ++m) { const size_t ro = (size_t)(u.pm * 256 + ai * 128 + wr * 64 + m * 16 + fr) * ldc + u.pn * 256 + cl; bf16_t* rowp = O + ro;
#pragma unroll
                for (int bj = 0; bj < 2; ++bj) { const f32x4 v0 = acc[ai][bj][m][0], v1 = acc[ai][bj][m][1];
                    u32x4 w; w.x = pk2(v0[0], v0[1]); w.y = pk2(v0[2], v0[3]); w.z = pk2(v1[0], v1[1]); w.w = pk2(v1[2], v1[3]);
                    if (!O8) *(GAS u32x4*)(rowp + bj * 128) = w;
                    if (O8) { u32x2 w8; w8.x = pk4_fp8(v0[0], v0[1], v0[2], v0[3]); w8.y = pk4_fp8(v1[0], v1[1], v1[2], v1[3]); *(GAS u32x2*)(O8 + ro + bj * 128) = w8; } } }
    }
};
struct EpiRetOut {
    static constexpr bool PERM = true, AFTER_DRAIN = true, PROBE_TWICE = false;
    const bf16_t* SG; bf16_t* YCAT; unsigned char* Y8;
    __device__ __forceinline__ void fused(f32x4 (&acc)[2][2][4][2], const Unit& u, int wr, int wc, int fr, int fq, LAS unsigned char* lds, int wid, int lane) const {
        asm volatile("" : "+v"(fr), "+v"(fq));
        LAS f32x2* P = (LAS f32x2*)lds;
        const int cl = wc * 32 + 8 * fq; const float lg = lg_gamma(u.pn);
#pragma unroll
        for (int ai = 0; ai < 2; ++ai)
#pragma unroll
            for (int m = 0; m < 4; ++m) { const int i = ai * 128 + wr * 64 + m * 16 + fr; const float sc = __builtin_amdgcn_exp2f(lg * (float)(i + 1)); float s = 0.f, q = 0.f;
#pragma unroll
                for (int bj = 0; bj < 2; ++bj)
#pragma unroll
                    for (int n = 0; n < 2; ++n) { f32x4 x = acc[ai][bj][m][n] * sc; acc[ai][bj][m][n] = x; s += (x[0] + x[1]) + (x[2] + x[3]); q += (x[0] * x[0] + x[1] * x[1]) + (x[2] * x[2] + x[3] * x[3]); }
                s += __shfl_xor(s, 16); s += __shfl_xor(s, 32); q += __shfl_xor(q, 16); q += __shfl_xor(q, 32);
                if (fq == 0) P[i * 4 + wc] = (f32x2){s, q}; }
        asm volatile("s_waitcnt lgkmcnt(0)" ::: "memory"); __builtin_amdgcn_s_barrier(); asm volatile("" ::: "memory");
#pragma unroll
        for (int ai = 0; ai < 2; ++ai)
#pragma unroll
            for (int m = 0; m < 4; ++m) { const int i = ai * 128 + wr * 64 + m * 16 + fr, row = u.pm * 256 + i;
                const f32x2 p0 = P[i * 4 + 0], p1 = P[i * 4 + 1], p2 = P[i * 4 + 2], p3 = P[i * 4 + 3];
                const float mu = ((p0.x + p1.x) + (p2.x + p3.x)) * (1.f / 256.f); float var = ((p0.y + p1.y) + (p2.y + p3.y)) * (1.f / 256.f) - mu * mu; var = var > 0.f ? var : 0.f;
                const float rstd = __builtin_amdgcn_rsqf(var + GN_EPS);
#pragma unroll
                for (int bj = 0; bj < 2; ++bj) { const u32x4 g = *(const GAS u32x4*)(SG + (size_t)row * 1024 + u.pn * 256 + bj * 128 + cl);
                    const f32x4 x0 = (acc[ai][bj][m][0] - mu) * rstd, x1 = (acc[ai][bj][m][1] - mu) * rstd;
                    const float y0 = x0[0] * bflo(g.x), y1 = x0[1] * bfhi(g.x), y2 = x0[2] * bflo(g.y), y3 = x0[3] * bfhi(g.y), y4 = x1[0] * bflo(g.z), y5 = x1[1] * bfhi(g.z), y6 = x1[2] * bflo(g.w), y7 = x1[3] * bfhi(g.w);
                    u32x4 w; w.x = pk2(y0, y1); w.y = pk2(y2, y3); w.z = pk2(y4, y5); w.w = pk2(y6, y7);
                    if (!Y8) *(GAS u32x4*)(YCAT + (size_t)row * 2048 + 1024 + u.pn * 256 + bj * 128 + cl) = w;
                    if (Y8) { u32x2 w8; w8.x = pk4_fp8(y0, y1, y2, y3); w8.y = pk4_fp8(y4, y5, y6, y7); *(GAS u32x2*)(Y8 + (size_t)row * 2048 + 1024 + u.pn * 256 + bj * 128 + cl) = w8; } } __builtin_amdgcn_sched_barrier(0); }
    }
};
template <bool F8OUT> struct EpiResidual {
    static constexpr bool PERM = true, AFTER_DRAIN = false, PROBE_TWICE = false;
    const bf16_t* res_in; bf16_t* HB; ssq_t* ssq_out; float sc; unsigned char* HB8;
    __device__ __forceinline__ void operator()(const f32x4 (&acc)[2][2][4][2], const Unit& u, int wr, int wc, int fr, int fq) const {
        asm volatile("" : "+v"(fr), "+v"(fq));
        const int c0 = u.pn * 256 + wc * 32 + 8 * fq;
#pragma unroll
        for (int ai = 0; ai < 2; ++ai)
#pragma unroll
            for (int m = 0; m < 4; ++m) { const int row = u.pm * 256 + ai * 128 + wr * 64 + m * 16 + fr; const unsigned off = (unsigned)row * (unsigned)DM + (unsigned)c0; float q = 0.f;
#pragma unroll
                for (int bj = 0; bj < 2; ++bj) { const u32x4 h = *at32<const u32x4>(res_in, (off + bj * 128) * 2u); const f32x4 a0 = acc[ai][bj][m][0] * sc, a1 = acc[ai][bj][m][1] * sc;
                    const float x0 = bflo(h.x) + a0[0], x1 = bfhi(h.x) + a0[1], x2 = bflo(h.y) + a0[2], x3 = bfhi(h.y) + a0[3], x4 = bflo(h.z) + a1[0], x5 = bfhi(h.z) + a1[1], x6 = bflo(h.w) + a1[2], x7 = bfhi(h.w) + a1[3];
                    u32x4 w; w.x = pk2(x0, x1); w.y = pk2(x2, x3); w.z = pk2(x4, x5); w.w = pk2(x6, x7); *at32<u32x4>(HB, (off + bj * 128) * 2u) = w;
                    if constexpr (F8OUT) { u32x2 w8; w8.x = pk4_fp8(x0, x1, x2, x3); w8.y = pk4_fp8(x4, x5, x6, x7); *at32<u32x2>(HB8, off + bj * 128) = w8; }
                    q += ((x0 * x0 + x1 * x1) + (x2 * x2 + x3 * x3)) + ((x4 * x4 + x5 * x5) + (x6 * x6 + x7 * x7)); }
                q += __shfl_xor(q, 16); q += __shfl_xor(q, 32);
                if (fq == 0) __hip_atomic_fetch_add((GAS ssq_t*)ssq_out + row, ssq_fix(q), RLX_AGENT); }
    }
};
template <bool F8, bool F8OUT = F8> struct EpiSwiGLU {
    static constexpr bool PERM = true, AFTER_DRAIN = false, PROBE_TWICE = true;
    const ssq_t* ssq; void* ACT; int ldc;
    static constexpr int PF_BYTES = 8;
    __device__ __forceinline__ const void* pf_src(const Unit& u) const { return ssq + u.pm * 256; }
    __device__ __forceinline__ void operator()(const f32x4 (&acc)[2][2][4][2], const Unit& u, int wr, int wc, int fr, int fq) const { run<false>(acc, u, wr, wc, fr, fq, nullptr); }
    __device__ __forceinline__ void with_pf(const f32x4 (&acc)[2][2][4][2], const Unit& u, int wr, int wc, int fr, int fq, const LAS unsigned char* sb) const { run<true>(acc, u, wr, wc, fr, fq, sb); }
    template <bool PFD> __device__ __forceinline__ void run(const f32x4 (&acc)[2][2][4][2], const Unit& u, int wr, int wc, int fr, int fq, const LAS unsigned char* sb) const {
        asm volatile("" : "+v"(fr), "+v"(fq));
        const int cl = wc * 32 + 8 * fq;
#pragma unroll
        for (int ai = 0; ai < 2; ++ai)
#pragma unroll
            for (int m = 0; m < 4; ++m) { const int rl = ai * 128 + wr * 64 + m * 16 + fr, row = u.pm * 256 + rl; const float r = (PFD ? rs_from(*(const LAS unsigned long long*)(sb + rl * 8)) : rs_of(ssq, row)) * (F8 ? GU8_UNSCALE : 1.f); float o[2][4];
#pragma unroll
                for (int n = 0; n < 2; ++n)
#pragma unroll
                    for (int j = 0; j < 4; j += 2) { const f32x2 v = swiglu_pk((f32x2){acc[ai][0][m][n][j], acc[ai][0][m][n][j + 1]}, (f32x2){acc[ai][1][m][n][j], acc[ai][1][m][n][j + 1]}, r, F8OUT ? r * ACT8_SCALE : r); o[n][j] = v.x; o[n][j + 1] = v.y; }
                if constexpr (F8OUT) { u32x2 w; w.x = pk4_fp8(o[0][0], o[0][1], o[0][2], o[0][3]); w.y = pk4_fp8(o[1][0], o[1][1], o[1][2], o[1][3]); *at32<u32x2>(ACT, (unsigned)row * (unsigned)ldc + (unsigned)(u.pn * 128 + cl)) = w; }
                else { u32x4 w; w.x = pk2(o[0][0], o[0][1]); w.y = pk2(o[0][2], o[0][3]); w.z = pk2(o[1][0], o[1][1]); w.w = pk2(o[1][2], o[1][3]); *at32<u32x4>(ACT, ((unsigned)row * (unsigned)ldc + (unsigned)(u.pn * 128 + cl)) * 2u) = w; } }
    }
};
struct EpiOddIn {
    static constexpr bool PERM = true, AFTER_DRAIN = false, PROBE_TWICE = false;
    const ssq_t* ssq; bf16_t *BG, *Z; float sc;
    static constexpr int PF_BYTES = 8;
    __device__ __forceinline__ const void* pf_src(const Unit& u) const { return ssq + u.pm * 256; }
    __device__ __forceinline__ void operator()(const f32x4 (&acc)[2][2][4][2], const Unit& u, int wr, int wc, int fr, int fq) const { run<false>(acc, u, wr, wc, fr, fq, nullptr); }
    __device__ __forceinline__ void with_pf(const f32x4 (&acc)[2][2][4][2], const Unit& u, int wr, int wc, int fr, int fq, const LAS unsigned char* sb) const { run<true>(acc, u, wr, wc, fr, fq, sb); }
    template <bool PFD> __device__ __forceinline__ void run(const f32x4 (&acc)[2][2][4][2], const Unit& u, int wr, int wc, int fr, int fq, const LAS unsigned char* sb) const {
        asm volatile("" : "+v"(fr), "+v"(fq));
        const int cl = wc * 32 + 8 * fq;
#pragma unroll
        for (int ai = 0; ai < 2; ++ai)
#pragma unroll
            for (int m = 0; m < 4; ++m) { const int rl = ai * 128 + wr * 64 + m * 16 + fr, row = u.pm * 256 + rl; const float r = (PFD ? rs_from(*(const LAS unsigned long long*)(sb + rl * 8)) : rs_of(ssq, row)) * sc;
                if (u.pn < 8) {
#pragma unroll
                    for (int bj = 0; bj < 2; ++bj) { const f32x4 v0 = acc[ai][bj][m][0] * r, v1 = acc[ai][bj][m][1] * r;
                        u32x4 w; w.x = pk2(v0[0], v0[1]); w.y = pk2(v0[2], v0[3]); w.z = pk2(v1[0], v1[1]); w.w = pk2(v1[2], v1[3]);
                        *at32<u32x4>(BG, ((unsigned)row * (unsigned)DM + (unsigned)(u.pn * 256 + bj * 128 + cl)) * 2u) = w; }
                } else { const float r2 = r * r; const f32x4 v0 = acc[ai][0][m][0] * acc[ai][1][m][0] * r2, v1 = acc[ai][0][m][1] * acc[ai][1][m][1] * r2;
                    u32x4 w; w.x = pk2(v0[0], v0[1]); w.y = pk2(v0[2], v0[3]); w.z = pk2(v1[0], v1[1]); w.w = pk2(v1[2], v1[3]);
                    *at32<u32x4>(Z, ((unsigned)row * (unsigned)DM + (unsigned)((u.pn - 8) * 128 + cl)) * 2u) = w; } }
    }
};

__device__ __forceinline__ unsigned load_counts8(const unsigned* cntw) {
    const int l = (int)__builtin_amdgcn_mbcnt_hi(~0u, __builtin_amdgcn_mbcnt_lo(~0u, 0u)); unsigned v = 0u;
    if (l < NEXP) v = __hip_atomic_load(cntw + 64 * l, RLX_AGENT);
    return v;
}
template <bool GATHER_> struct MoeOrder {
    static constexpr bool GATHER = GATHER_;
    int tp[NEXP + 1], cnt[NEXP]; int nN, G, c; const char *A0, *B0; long a_rt, b_e, b_sn; const int* rowtok; unsigned row_bytes;
    __device__ __forceinline__ void init(const unsigned* cntw, int nN_, int G_, int c_) { nN = nN_; G = G_; c = c_; tp[0] = 0;
        const unsigned cv = load_counts8(cntw);
#pragma unroll
        for (int e = 0; e < NEXP; ++e) { int v = (int)__builtin_amdgcn_readlane(cv, e); v = v < 0 ? 0 : (v > ECAP ? ECAP : v); cnt[e] = v; tp[e + 1] = tp[e] + ((v + 255) >> 8); } }
    __device__ __forceinline__ bool next(int i, Unit& u) const {
        const long L = (long)i * G + c; const int nM = tp[NEXP]; if (L >= (long)nM * nN) return false;
        int rt, pn; pg8::tile_of((int)L, nM, nN, rt, pn); int e = 0;
#pragma unroll
        for (int k = 1; k < NEXP; ++k) e = (rt >= tp[k]) ? k : e;
        int ce = cnt[0], te = tp[0];
#pragma unroll
        for (int k = 1; k < NEXP; ++k) { ce = (e == k) ? cnt[k] : ce; te = (e == k) ? tp[k] : te; }
        u.pm = rt; u.pn = pn; u.x0 = e; u.x1 = (rt - te) * 256; u.x2 = ce;
        u.a = A0 + (GATHER_ ? 0 : (long)rt * a_rt); u.b = B0 + e * b_e + pn * b_sn; return true;
    }
    __device__ __forceinline__ unsigned goff(const Unit& u, int r) const {
        const int ep = u.x1 + r; const int tok = (ep < u.x2) ? ((const GAS int*)rowtok)[u.x0 * ECAP + ep] : 0; return (unsigned)tok * row_bytes;
    }
};
template <bool F8> struct EpiMoeGU {
    static constexpr bool PERM = true, AFTER_DRAIN = false, PROBE_TWICE = true;
    const float* er; void* ACTM;
    static constexpr int PF_BYTES = 4;
    __device__ __forceinline__ const void* pf_src(const Unit& u) const { return er + u.x0 * ECAP + u.x1; }
    __device__ __forceinline__ void operator()(const f32x4 (&acc)[2][2][4][2], const Unit& u, int wr, int wc, int fr, int fq) const { run<false>(acc, u, wr, wc, fr, fq, nullptr); }
    __device__ __forceinline__ void with_pf(const f32x4 (&acc)[2][2][4][2], const Unit& u, int wr, int wc, int fr, int fq, const LAS unsigned char* sb) const { run<true>(acc, u, wr, wc, fr, fq, sb); }
    template <bool PFD> __device__ __forceinline__ void run(const f32x4 (&acc)[2][2][4][2], const Unit& u, int wr, int wc, int fr, int fq, const LAS unsigned char* sb) const {
        asm volatile("" : "+v"(fr), "+v"(fq));
        const int cl = wc * 32 + 8 * fq;
#pragma unroll
        for (int ai = 0; ai < 2; ++ai)
#pragma unroll
            for (int m = 0; m < 4; ++m) { const int i = ai * 128 + wr * 64 + m * 16 + fr, ep = u.x1 + i; const float r = ((ep < u.x2) ? (PFD ? *(const LAS float*)(sb + i * 4) : ((const GAS float*)er)[u.x0 * ECAP + ep]) : 0.f) * (F8 ? GU8_UNSCALE : 1.f); float o[2][4];
#pragma unroll
                for (int n = 0; n < 2; ++n)
#pragma unroll
                    for (int j = 0; j < 4; j += 2) { const f32x2 v = swiglu_pk((f32x2){acc[ai][0][m][n][j], acc[ai][0][m][n][j + 1]}, (f32x2){acc[ai][1][m][n][j], acc[ai][1][m][n][j + 1]}, r, F8 ? r * ACT8_SCALE : r); o[n][j] = v.x; o[n][j + 1] = v.y; }
                if constexpr (F8) { u32x2 w; w.x = pk4_fp8(o[0][0], o[0][1], o[0][2], o[0][3]); w.y = pk4_fp8(o[1][0], o[1][1], o[1][2], o[1][3]); *at32<u32x2>(ACTM, (unsigned)(u.pm * 256 + i) * (unsigned)EXD + (unsigned)(u.pn * 128 + cl)) = w; }
                else { u32x4 w; w.x = pk2(o[0][0], o[0][1]); w.y = pk2(o[0][2], o[0][3]); w.z = pk2(o[1][0], o[1][1]); w.w = pk2(o[1][2], o[1][3]); *at32<u32x4>(ACTM, ((unsigned)(u.pm * 256 + i) * (unsigned)EXD + (unsigned)(u.pn * 128 + cl)) * 2u) = w; } }
    }
};
struct EpiMoeDown {
    static constexpr bool PERM = true, AFTER_DRAIN = false, PROBE_TWICE = false;
    const float* ew; bf16_t* YC; float sc;
    static constexpr int PF_BYTES = 4;
    __device__ __forceinline__ const void* pf_src(const Unit& u) const { return ew + u.x0 * ECAP + u.x1; }
    __device__ __forceinline__ void operator()(const f32x4 (&acc)[2][2][4][2], const Unit& u, int wr, int wc, int fr, int fq) const { run<false>(acc, u, wr, wc, fr, fq, nullptr); }
    __device__ __forceinline__ void with_pf(const f32x4 (&acc)[2][2][4][2], const Unit& u, int wr, int wc, int fr, int fq, const LAS unsigned char* sb) const { run<true>(acc, u, wr, wc, fr, fq, sb); }
    template <bool PFD> __device__ __forceinline__ void run(const f32x4 (&acc)[2][2][4][2], const Unit& u, int wr, int wc, int fr, int fq, const LAS unsigned char* sb) const {
        asm volatile("" : "+v"(fr), "+v"(fq));
        const int cl = wc * 32 + 8 * fq;
#pragma unroll
        for (int ai = 0; ai < 2; ++ai)
#pragma unroll
            for (int m = 0; m < 4; ++m) { const int i = ai * 128 + wr * 64 + m * 16 + fr, ep = u.x1 + i; const float wt = ((ep < u.x2) ? (PFD ? *(const LAS float*)(sb + i * 4) : ((const GAS float*)ew)[u.x0 * ECAP + ep]) : 0.f) * sc;
#pragma unroll
                for (int bj = 0; bj < 2; ++bj) { const f32x4 v0 = acc[ai][bj][m][0] * wt, v1 = acc[ai][bj][m][1] * wt;
                    u32x4 w; w.x = pk2(v0[0], v0[1]); w.y = pk2(v0[2], v0[3]); w.z = pk2(v1[0], v1[1]); w.w = pk2(v1[2], v1[3]);
                    *at32<u32x4>(YC, ((unsigned)(u.pm * 256 + i) * (unsigned)DM + (unsigned)(u.pn * 256 + bj * 128 + cl)) * 2u) = w; } }
    }
};

struct Frame {
    LAS unsigned char* lds;
    volatile LAS unsigned* MISC;
    gu32* ctl;
    int tid, lane, wave, G, bid;
    unsigned char* ws;
    const float* const* in;
};
template <class T> __device__ __forceinline__ T* wsp(const Frame& F, size_t off) { return (T*)(F.ws + off); }

__device__ __forceinline__ int conv_src_col(int mode, int N, int n) {
    if (mode == 0) return n;
    if (mode == 1) { const int t = n >> 8, w = n & 255; return (w < 128) ? t * 128 + w : (N >> 1) + t * 128 + (w - 128); }
    if (n < 2048) return n;
    const int np = n - 2048, t = np >> 8, w = np & 255; return 2048 + ((w < 128) ? t * 128 + w : 2048 + t * 128 + (w - 128));
}
struct ConvJob { const float* W; bf16_t* WT; const float* gain; const float* scale; int K, N, mode, start; };
constexpr int N_CONV_JOBS = 52;
#ifndef MK_CV_SH
#define MK_CV_SH 1
#endif
constexpr int CV_SH = MK_CV_SH;
#ifndef MK_STEAL_N
#define MK_STEAL_N 0
#endif
__device__ __forceinline__ ConvJob conv_job_desc(const Frame& F, int j, int& deadline) {
    const int i = j / 26, q = j % 26; const int pb = 1 + 14 * i;
    int r, d;
    if (q == 0) { r = 0; d = 0; } else if (q < 5) { r = q; d = 2; } else if (q == 5) { r = 5; d = 4; } else if (q == 6) { r = 8; d = 5; } else if (q == 7) { r = 9; d = 6; }
    else if (q == 8) { r = 6; d = 7; } else if (q == 9) { r = 7; d = 9; } else if (q < 18) { r = q; d = 11; } else { r = q; d = 12; }
    deadline = pb + d;
    ConvJob J; J.gain = nullptr; J.scale = nullptr; J.mode = 0; J.start = 0;
    if (r == 0) { J.W = F.in[4] + (size_t)i * DM * EIN; J.K = DM; J.N = EIN; J.WT = wsp<bf16_t>(F, WS_EWIN) + (size_t)i * EIN * DM; J.gain = F.in[1] + (2 * i) * DM; J.mode = f8_ein(i) ? 256 : 0; }
    else if (r < 5) { const int g = r - 1; J.W = F.in[5] + (size_t)(i * 4 + g) * 65536; J.K = 256; J.N = 256; J.WT = wsp<bf16_t>(F, WS_EWP) + (size_t)(i * 4 + g) * 65536; J.scale = F.in[6] + i * 1024 + g * 256; }
    else if (r == 5) { J.W = F.in[7] + (size_t)i * DM * DM; J.K = DM; J.N = DM; J.WT = wsp<bf16_t>(F, WS_EWOUT) + (size_t)i * DM * DM; J.mode = f8_eout(i) ? 256 : 0; }
    else if (r == 6) { J.W = F.in[8] + (size_t)i * DM * OIN; J.K = DM; J.N = OIN; J.WT = wsp<bf16_t>(F, WS_OWIN) + (size_t)i * OIN * DM; J.gain = F.in[1] + (2 * i + 1) * DM; J.mode = 2 | (f8_oin(i) ? 256 : 0); }
    else if (r == 7) { J.W = F.in[10] + (size_t)i * DM * DM; J.K = DM; J.N = DM; J.WT = wsp<bf16_t>(F, WS_OWOUT) + (size_t)i * DM * DM; J.mode = f8_oout(i) ? 256 : 0; }
    else if (r == 8) { J.W = F.in[11] + (size_t)i * DM * 2 * FFN; J.K = DM; J.N = 2 * FFN; J.WT = wsp<bf16_t>(F, WS_FGU) + (size_t)i * 2 * FFN * DM; J.gain = F.in[2] + (2 * i) * DM; J.mode = 1 | (f8_ffn(i) ? 256 : 0); }
    else if (r == 9) { J.W = F.in[12] + (size_t)i * FFN * DM; J.K = FFN; J.N = DM; J.WT = wsp<bf16_t>(F, WS_FDN) + (size_t)i * DM * FFN; J.mode = f8_dn(i) ? 256 : 0; }
    else if (r < 18) { const int e = r - 10; J.W = F.in[14] + (size_t)(i * NEXP + e) * DM * 2 * EXD; J.K = DM; J.N = 2 * EXD; J.WT = wsp<bf16_t>(F, WS_MGU) + (size_t)(i * NEXP + e) * 2 * EXD * DM; J.gain = F.in[2] + (2 * i + 1) * DM; J.mode = 1 | (f8_moe(i) ? 256 : 0); }
    else { const int e = r - 18; J.W = F.in[15] + (size_t)(i * NEXP + e) * EXD * DM; J.K = EXD; J.N = DM; J.WT = wsp<bf16_t>(F, WS_MDN) + (size_t)(i * NEXP + e) * DM * EXD; J.mode = f8_moe(i) ? 256 : 0; }
    return J;
}
constexpr int CV_JP = 0, CV_JI = 1664, CV_JD = 2496, CV_ST = 2704, CV_GT = 2816, CV_MAXG = 24;
#define CV_PTRS(F_) LAS unsigned long long* jp = (LAS unsigned long long*)((F_).lds + LDSX_OFF + CV_JP); LAS int* ji = (LAS int*)((F_).lds + LDSX_OFF + CV_JI); LAS int* jd = (LAS int*)((F_).lds + LDSX_OFF + CV_JD); LAS int* st = (LAS int*)((F_).lds + LDSX_OFF + CV_ST); \
    LAS int* gst = (LAS int*)((F_).lds + LDSX_OFF + CV_GT); LAS int* gdl = gst + CV_MAXG + 1; (void)jp; (void)ji; (void)jd; (void)st; (void)gst; (void)gdl
__device__ __forceinline__ void conv_init(const Frame& F) {
    CV_PTRS(F);
    if (F.tid < N_CONV_JOBS) { int dl; const ConvJob J = conv_job_desc(F, F.tid, dl); const int j = F.tid;
        jp[j * 4 + 0] = (unsigned long long)J.W; jp[j * 4 + 1] = (unsigned long long)J.WT; jp[j * 4 + 2] = (unsigned long long)J.gain; jp[j * 4 + 3] = (unsigned long long)J.scale;
        ji[j * 4 + 0] = J.K; ji[j * 4 + 1] = J.N; ji[j * 4 + 2] = J.mode; ji[j * 4 + 3] = 0; jd[j] = dl; }
    __syncthreads();
    if (F.tid == 0) { int acc = 0, ng = 0;
        for (int j = 0; j < N_CONV_JOBS; ++j) { if (j == 0 || jd[j] != jd[j - 1]) { gst[ng] = acc; gdl[ng] = jd[j]; ++ng; } ji[j * 4 + 3] = acc; acc += (ji[j * 4 + 0] >> 7) * (ji[j * 4 + 1] >> 7); }
        gst[ng] = acc; st[0] = acc; st[2] = 0; st[3] = 0; st[5] = (F.bid < gst[1]) ? F.bid : -1; st[6] = (F.bid < gst[1]) ? 0 : 1; st[7] = ng; st[8] = -1; st[9] = -1; }
    __syncthreads();
}
__device__ __forceinline__ unsigned* conv_qhead(const Frame& F, int gi) { return (unsigned*)(F.ctl + CW_CONVQ + (gi * 8 + (F.bid & (CV_SH - 1))) * 32); }
__device__ __forceinline__ int conv_claim_finish(const Frame& F, unsigned l) {
    CV_PTRS(F);
    int cg = st[6]; const int ng = st[7], sh = F.bid & (CV_SH - 1); int res = -1;
    while (cg < ng) {
        const int r = (int)((l + (cg == 0 ? (unsigned)(F.G / CV_SH) : 0u)) * (unsigned)CV_SH) + sh;
        if (r < gst[cg + 1] - gst[cg]) { res = gst[cg] + r; break; }
        if (++cg < ng) l = xb_add(conv_qhead(F, cg), 1u);
    }
    st[6] = cg; return res;
}
struct ConvRegs { f32x4 v[8]; f32x4 sn; float gk[8]; bf16_t* WT; int K, kb, n0, f8; };
__device__ __forceinline__ void conv_load(const Frame& F, int g, int j, ConvRegs& R) {
    CV_PTRS(F);
    const float* W = (const float*)jp[j * 4 + 0]; const float* gain = (const float*)jp[j * 4 + 2]; const float* scale = (const float*)jp[j * 4 + 3];
    const int N = ji[j * 4 + 1], mode = ji[j * 4 + 2], it = g - ji[j * 4 + 3], nblk = N >> 7;
    R.WT = (bf16_t*)jp[j * 4 + 1]; R.K = ji[j * 4 + 0]; R.kb = it / nblk; R.n0 = (it % nblk) << 7; R.f8 = (mode >> 8) & 1;
    const int sc = conv_src_col(mode & 255, N, R.n0 + 4 * (F.lane & 31)), k0 = R.kb * 128 + F.wave * 16 + 8 * (F.lane >> 5);
#pragma unroll
    for (int r = 0; r < 8; ++r) R.v[r] = *(const GAS f32x4*)(W + (size_t)(k0 + r) * N + sc);
    R.sn = scale ? *(const GAS f32x4*)(scale + sc) : (f32x4){1.f, 1.f, 1.f, 1.f};
#pragma unroll
    for (int r = 0; r < 8; ++r) R.gk[r] = gain ? ((const GAS float*)gain)[k0 + r] : 1.f;
}
__device__ __forceinline__ void conv_pack(const Frame& F, const ConvRegs& R, LAS unsigned* tile) {
    const int nl = 4 * (F.lane & 31), kl = F.wave * 16 + 8 * (F.lane >> 5);
    if (R.f8) {
#pragma unroll
        for (int hh = 0; hh < 2; ++hh)
#pragma unroll
            for (int q = 0; q < 4; ++q) { const float s_ = R.sn[q] * W8_SCALE;
                tile[(nl + q) * 33 + (kl >> 2) + hh] = pk4_fp8(R.v[4 * hh][q] * (R.gk[4 * hh] * s_), R.v[4 * hh + 1][q] * (R.gk[4 * hh + 1] * s_), R.v[4 * hh + 2][q] * (R.gk[4 * hh + 2] * s_), R.v[4 * hh + 3][q] * (R.gk[4 * hh + 3] * s_)); }
    } else {
#pragma unroll
        for (int rp = 0; rp < 4; ++rp)
#pragma unroll
            for (int q = 0; q < 4; ++q) tile[(nl + q) * 65 + (kl >> 1) + rp] = pk2(R.v[2 * rp][q] * (R.gk[2 * rp] * R.sn[q]), R.v[2 * rp + 1][q] * (R.gk[2 * rp + 1] * R.sn[q]));
    }
}
__device__ __forceinline__ void conv_store(const Frame& F, const LAS unsigned* tile, bf16_t* WT, int K, int kb, int n0, int f8) {
    if (f8) {
#pragma unroll
        for (int p = 0; p < 2; ++p) { const int row = p * 64 + (F.tid >> 3), c = F.tid & 7; const LAS unsigned* s = tile + row * 33 + 4 * c;
            u32x4 o; o.x = s[0]; o.y = s[1]; o.z = s[2]; o.w = s[3];
            *(GAS u32x4*)((unsigned char*)WT + (size_t)(n0 + row) * K + kb * 128 + 16 * c) = o; }
    } else {
#pragma unroll
        for (int p = 0; p < 4; ++p) { const int row = p * 32 + (F.tid >> 4), c = F.tid & 15; const LAS unsigned* s = tile + row * 65 + 4 * c;
            u32x4 o; o.x = s[0]; o.y = s[1]; o.z = s[2]; o.w = s[3];
            *(GAS u32x4*)(WT + (size_t)(n0 + row) * K + kb * 128 + 8 * c) = o; }
    }
}
__device__ __forceinline__ int conv_run(const Frame& F0, int max_phase, int extra) {
    Frame F = F0; { int t_ = threadIdx.x; asm volatile("" : "+v"(t_)); F.tid = t_; F.lane = t_ & 63; F.wave = __builtin_amdgcn_readfirstlane(t_ >> 6); }
    CV_PTRS(F);
    __syncthreads();
    int g = st[5], j = st[2], par = st[3], slot = 0, n = 0; const bool t0 = (F.tid == 0);
#define CV_ELIGIBLE(g_) ({ bool ok_ = false; if ((g_) >= 0) { while ((g_) >= ji[j * 4 + 3] + (ji[j * 4 + 0] >> 7) * (ji[j * 4 + 1] >> 7)) ++j; ok_ = jd[j] <= max_phase; if (!ok_ && extra > 0) { --extra; ok_ = true; } } ok_; })
    ConvRegs R; unsigned cl = 0u;
    bool have = CV_ELIGIBLE(g);
    if (have) { if (t0 && st[6] < st[7]) cl = xb_add(conv_qhead(F, st[6]), 1u); conv_load(F, g, j, R); if (t0) st[8] = conv_claim_finish(F, cl); }
    while (have) {
        LAS unsigned* tile = (LAS unsigned*)(F.lds + RING_OFF) + par * (128 * 65);
        conv_pack(F, R, tile);
        bf16_t* const WTc = R.WT; const int Kc = R.K, kbc = R.kb, n0c = R.n0, f8c = R.f8;
        ++n; par ^= 1;
        __syncthreads();
        g = st[8 + slot];
        have = CV_ELIGIBLE(g);
        if (have) { if (t0 && st[6] < st[7]) cl = xb_add(conv_qhead(F, st[6]), 1u); conv_load(F, g, j, R); }
        conv_store(F, tile, WTc, Kc, kbc, n0c, f8c);
        if (have && t0) st[8 + (slot ^ 1)] = conv_claim_finish(F, cl);
        slot ^= 1;
    }
#undef CV_ELIGIBLE
    __syncthreads();
    if (t0) { st[5] = g; st[2] = j; st[3] = par; }
    return n;
}
__device__ __forceinline__ void p_prologue(const Frame& F) {
    conv_init(F);
    const int gw = F.bid * NWAVES + F.wave, NGW = F.G * NWAVES; bf16_t* HB = wsp<bf16_t>(F, WS_HB); ssq_t* ssq0 = (ssq_t*)(F.ctl + CW_SSQ);
    for (int m0 = gw; m0 < MTOK; m0 += 2 * NGW) {
        f32x4 xv[2][8];
#pragma unroll
        for (int u = 0; u < 2; ++u) { const int m = (m0 + u * NGW < MTOK) ? m0 + u * NGW : m0; const GAS f32x4* xr = (const GAS f32x4*)(F.in[0] + (size_t)m * DM) + F.lane;
#pragma unroll
            for (int jj = 0; jj < 8; ++jj) xv[u][jj] = xr[64 * jj]; }
#pragma unroll
        for (int u = 0; u < 2; ++u) { const int m = m0 + u * NGW; if (m >= MTOK) continue; GAS u32x2* o = (GAS u32x2*)(HB + (size_t)m * DM) + F.lane; float q = 0.f;
#pragma unroll
            for (int jj = 0; jj < 8; ++jj) { const f32x4 vv = xv[u][jj]; q += (vv[0] * vv[0] + vv[1] * vv[1]) + (vv[2] * vv[2] + vv[3] * vv[3]); u32x2 w; w.x = pk2(vv[0], vv[1]); w.y = pk2(vv[2], vv[3]); o[64 * jj] = w;
                if (f8_ein(0)) ((GAS unsigned*)(wsp<unsigned char>(F, WS_HB8) + (size_t)m * DM))[64 * jj + F.lane] = pk4_fp8(vv[0], vv[1], vv[2], vv[3]); }
            q = wave_sum(q); if (F.lane == 0) ((GAS ssq_t*)ssq0)[m] = ssq_fix(q); } }
}
#define PP_ACC(s_, v_, op_) do { s_[0] op_ bflo(v_.x); s_[1] op_ bfhi(v_.x); s_[2] op_ bflo(v_.y); s_[3] op_ bfhi(v_.y); s_[4] op_ bflo(v_.z); s_[5] op_ bfhi(v_.z); s_[6] op_ bflo(v_.w); s_[7] op_ bfhi(v_.w); } while (0)
__device__ __forceinline__ void t_pool_p(const Frame& F, const bf16_t* U, bf16_t* PP) {
    const int gw = F.bid * NWAVES + F.wave, NGW = F.G * NWAVES; constexpr int RUN = 16;
    for (int it = gw; it < (MTOK / RUN) * 2; it += NGW) { const int row0 = (it >> 1) * RUN, c0 = (it & 1) * 512 + F.lane * 8, g = c0 >> 8, w = 2 << g, t0 = row0 & (SEQ - 1);
        const GAS u32x4* up = (const GAS u32x4*)(U + (size_t)row0 * 1024 + c0); GAS u32x4* pp = (GAS u32x4*)(PP + (size_t)row0 * 1024 + c0);
        float s[8];
#pragma unroll
        for (int j = 0; j < 8; ++j) s[j] = 0.f;
#pragma unroll
        for (int k = 1; k < 16; ++k) if (k < w && t0 > 0) { const u32x4 v = up[-128 * k]; PP_ACC(s, v, +=); }
#pragma unroll 8
        for (int i = 0; i < RUN; ++i) { const u32x4 v = up[128 * i]; PP_ACC(s, v, +=);
            const int t = t0 + i, cnt = (t + 1) < w ? (t + 1) : w; const float ic = 1.f / (float)cnt;
            u32x4 o; o.x = pk2(s[0] * ic - bflo(v.x), s[1] * ic - bfhi(v.x)); o.y = pk2(s[2] * ic - bflo(v.y), s[3] * ic - bfhi(v.y));
            o.z = pk2(s[4] * ic - bflo(v.z), s[5] * ic - bfhi(v.z)); o.w = pk2(s[6] * ic - bflo(v.w), s[7] * ic - bfhi(v.w));
            pp[128 * i] = o;
            if (t - w + 1 >= 0) { const u32x4 d = up[128 * (i - w + 1)]; PP_ACC(s, d, -=); } }
    }
}
#undef PP_ACC
__device__ __forceinline__ void t_scan(const Frame& F, const bf16_t* LT, bf16_t* VS) {
    for (int gid = F.bid * (NWAVES * 64) + F.tid; gid < 8 * 16384; gid += F.G * NWAVES * 64) {
        const int bh = gid >> 14, rem = gid & 16383, e = rem >> 6, d4 = (rem & 63) * 4, b = bh >> 2, h = bh & 3; const float cd = __builtin_amdgcn_exp2f(lg_gamma(h) * 256.f);
        f32x4 s = (f32x4){0.f, 0.f, 0.f, 0.f};
#pragma unroll
        for (int g = 0; g < 32; ++g) { const size_t unit = (size_t)((b * 32 + g) * 4 + h);
            u32x2 w; w.x = pk2(s[0], s[1]); w.y = pk2(s[2], s[3]); *(GAS u32x2*)(VS + (unit * 256 + e) * 512 + 256 + d4) = w;
            const u32x2 l = *(const GAS u32x2*)(LT + (unit * 256 + e) * 256 + d4); s = s * cd + (f32x4){bflo(l.x), bfhi(l.x), bflo(l.y), bfhi(l.y)}; }
    }
}
__device__ __forceinline__ void t_conv(const Frame& F, const bf16_t* BG, const bf16_t* Z, const float* cw, bf16_t* Y, unsigned char* Y8) {
    const int gw = F.bid * NWAVES + F.wave, NGW = F.G * NWAVES; constexpr int RUN = 32;
    for (int it = gw; it < (MTOK / RUN) * 4; it += NGW) { const int row0 = (it >> 2) * RUN, c0 = (it & 3) * 512 + F.lane * 8, t0 = row0 & (SEQ - 1);
        float w0[8], w1[8], w2[8];
#pragma unroll
        for (int h = 0; h < 2; ++h) { const f32x4 a = *(const GAS f32x4*)(cw + c0 + 4 * h), b = *(const GAS f32x4*)(cw + DM + c0 + 4 * h), c = *(const GAS f32x4*)(cw + 2 * DM + c0 + 4 * h);
#pragma unroll
            for (int j = 0; j < 4; ++j) { w0[4 * h + j] = a[j]; w1[4 * h + j] = b[j]; w2[4 * h + j] = c[j]; } }
        u32x4 z0 = (u32x4){0u, 0u, 0u, 0u}, z1 = z0;
        if (t0 >= 2) { z0 = *(const GAS u32x4*)(Z + (size_t)(row0 - 2) * DM + c0); z1 = *(const GAS u32x4*)(Z + (size_t)(row0 - 1) * DM + c0); }
#pragma unroll 8
        for (int i = 0; i < RUN; ++i) { const size_t off = (size_t)(row0 + i) * DM + c0;
            const u32x4 z2 = *(const GAS u32x4*)(Z + off), bg = *(const GAS u32x4*)(BG + off);
            float o[8];
            o[0] = bflo(bg.x) * (bflo(z0.x) * w0[0] + bflo(z1.x) * w1[0] + bflo(z2.x) * w2[0]); o[1] = bfhi(bg.x) * (bfhi(z0.x) * w0[1] + bfhi(z1.x) * w1[1] + bfhi(z2.x) * w2[1]);
            o[2] = bflo(bg.y) * (bflo(z0.y) * w0[2] + bflo(z1.y) * w1[2] + bflo(z2.y) * w2[2]); o[3] = bfhi(bg.y) * (bfhi(z0.y) * w0[3] + bfhi(z1.y) * w1[3] + bfhi(z2.y) * w2[3]);
            o[4] = bflo(bg.z) * (bflo(z0.z) * w0[4] + bflo(z1.z) * w1[4] + bflo(z2.z) * w2[4]); o[5] = bfhi(bg.z) * (bfhi(z0.z) * w0[5] + bfhi(z1.z) * w1[5] + bfhi(z2.z) * w2[5]);
            o[6] = bflo(bg.w) * (bflo(z0.w) * w0[6] + bflo(z1.w) * w1[6] + bflo(z2.w) * w2[6]); o[7] = bfhi(bg.w) * (bfhi(z0.w) * w0[7] + bfhi(z1.w) * w1[7] + bfhi(z2.w) * w2[7]);
            u32x4 w; w.x = pk2(o[0], o[1]); w.y = pk2(o[2], o[3]); w.z = pk2(o[4], o[5]); w.w = pk2(o[6], o[7]);
            if (!Y8) *(GAS u32x4*)(Y + off) = w;
            z0 = z1; z1 = z2;
            if (Y8) { u32x2 w8; w8.x = pk4_fp8(o[0], o[1], o[2], o[3]); w8.y = pk4_fp8(o[4], o[5], o[6], o[7]); *(GAS u32x2*)(Y8 + off) = w8; } }
    }
}
__device__ __forceinline__ void t_router(const Frame& F, const bf16_t* HB, const ssq_t* ssq, const float* gain, const float* R, unsigned* cntw, int* tok_e, int* tok_pos, int* rowtok, float* er, float* ew) {
    constexpr int RPITCH = 4096 + 16;
    LAS unsigned char* Rh = F.lds + RING_OFF; LAS unsigned char* Rlo = Rh + 8 * RPITCH;
#pragma unroll
    for (int m = 0; m < DM / (NWAVES * 64); ++m) { const int k = F.tid + m * (NWAVES * 64); const f32x4 r0 = *(const GAS f32x4*)(R + (size_t)k * NEXP), r1 = *(const GAS f32x4*)(R + (size_t)k * NEXP + 4); const float gk = ((const GAS float*)gain)[k];
#pragma unroll
        for (int e = 0; e < NEXP; ++e) { const float v = (e < 4 ? r0[e & 3] : r1[e & 3]) * gk;
            const unsigned hi = pk2(v, 0.f) & 0xffffu; const float rem = v - __uint_as_float(hi << 16);
            *(LAS bf16_t*)(Rh + e * RPITCH + k * 2) = (bf16_t)hi; *(LAS bf16_t*)(Rlo + e * RPITCH + k * 2) = (bf16_t)(pk2(rem, 0.f) & 0xffffu); } }
    if (F.tid < NEXP) ((LAS unsigned*)(F.lds + RING_OFF + 16 * RPITCH + 64 + 4096))[F.tid] = 0u;
    __syncthreads();
    const int gw = F.bid * NWAVES + F.wave, NGW = F.G * NWAVES, fr = F.lane & 15, fq = F.lane >> 4, kh = F.wave & 1;
    LAS f32x4* xch = (LAS f32x4*)(F.lds + RING_OFF + 16 * RPITCH + 64) + (F.wave >> 1) * 64 + F.lane;
    LAS unsigned* lcnt = (LAS unsigned*)(F.lds + RING_OFF + 16 * RPITCH + 64 + 4096);
    for (int grp0 = 0; grp0 < MTOK / 16; grp0 += NGW >> 1) { const int grp = grp0 + (gw >> 1); const bool live = grp < MTOK / 16; const int t = (live ? grp : 0) * 16 + fr;
        const GAS bf16x8* hrow = (const GAS bf16x8*)(HB + (size_t)t * DM) + fq + kh * (DM / 16);
        const LAS bf16x8* rh = (const LAS bf16x8*)(Rh + (fr & 7) * RPITCH) + fq + kh * (DM / 16); const LAS bf16x8* rl = (const LAS bf16x8*)(Rlo + (fr & 7) * RPITCH) + fq + kh * (DM / 16);
        f32x4 ah = (f32x4){0.f, 0.f, 0.f, 0.f}, al = ah;
#pragma unroll 16
        for (int s = 0; s < DM / 64; ++s) { const bf16x8 hv = hrow[4 * s];
            ah = __builtin_amdgcn_mfma_f32_16x16x32_bf16(rh[4 * s], hv, ah, 0, 0, 0); al = __builtin_amdgcn_mfma_f32_16x16x32_bf16(rl[4 * s], hv, al, 0, 0, 0); }
        ah = ah + al;
        if (kh) *xch = ah;
        __syncthreads();
        if (!kh) ah = ah + *xch;
        __syncthreads();
        const bool act = !kh && live;
        int e1 = 0, e2 = 1; float w1 = 0.f, w2 = 0.f, r = 0.f;
        if (act) {
            r = rs_of(ssq, t);
            float p[NEXP];
#pragma unroll
            for (int j = 0; j < 4; ++j) { const float mine = ah[j] * r, other = __shfl_xor(mine, 16); p[j] = (fq & 1) ? other : mine; p[4 + j] = (fq & 1) ? mine : other; }
            float v1 = p[0];
#pragma unroll
            for (int e = 1; e < NEXP; ++e) if (p[e] > v1) { v1 = p[e]; e1 = e; }
            e2 = -1; float v2 = -3.0e38f;
#pragma unroll
            for (int e = 0; e < NEXP; ++e) if (e != e1 && p[e] > v2) { v2 = p[e]; e2 = e; }
            const float ex = __builtin_amdgcn_exp2f((v2 - v1) * 1.44269504f); w1 = 1.f / (1.f + ex); w2 = ex * w1;
        }
        unsigned l1 = 0u, l2 = 0u;
        if (act && fq == 0) { l1 = __hip_atomic_fetch_add(lcnt + e1, 1u, __ATOMIC_RELAXED, __HIP_MEMORY_SCOPE_WORKGROUP); l2 = __hip_atomic_fetch_add(lcnt + e2, 1u, __ATOMIC_RELAXED, __HIP_MEMORY_SCOPE_WORKGROUP); }
        __syncthreads();
        if (F.tid < NEXP) { const unsigned c = lcnt[F.tid]; lcnt[NEXP + F.tid] = c ? __hip_atomic_fetch_add((GAS unsigned*)cntw + 64 * F.tid, c, RLX_AGENT) : 0u; lcnt[F.tid] = 0u; }
        __syncthreads();
        if (act && fq == 0) {
            const int p1 = (int)(lcnt[NEXP + e1] + l1), p2 = (int)(lcnt[NEXP + e2] + l2);
            GAS int* te_ = (GAS int*)tok_e; GAS int* tp_ = (GAS int*)tok_pos; GAS int* rt_ = (GAS int*)rowtok; GAS float* er_ = (GAS float*)er; GAS float* ew_ = (GAS float*)ew;
            te_[2 * t] = e1; te_[2 * t + 1] = e2; tp_[2 * t] = p1; tp_[2 * t + 1] = p2;
            if (p1 < ECAP) { rt_[e1 * ECAP + p1] = t; er_[e1 * ECAP + p1] = r; ew_[e1 * ECAP + p1] = w1; }
            if (p2 < ECAP) { rt_[e2 * ECAP + p2] = t; er_[e2 * ECAP + p2] = r; ew_[e2 * ECAP + p2] = w2; } }
    }
    __syncthreads();
}
__device__ __forceinline__ void t_combine(const Frame& F, const bf16_t* HB, bf16_t* HBout, const bf16_t* YC, const unsigned* cntw, const int* tok_e, const int* tok_pos, ssq_t* ssq_next, const float* gfin, float* out, bool final_, unsigned char* HB8) {
    int tp[NEXP + 1]; tp[0] = 0;
    const unsigned cv = load_counts8(cntw);
#pragma unroll
    for (int e = 0; e < NEXP; ++e) { int v = (int)__builtin_amdgcn_readlane(cv, e); v = v < 0 ? 0 : (v > ECAP ? ECAP : v); tp[e + 1] = tp[e] + ((v + 255) >> 8); }
    const int gw = F.bid * NWAVES + F.wave, NGW = F.G * NWAVES;
    for (int t0 = gw; t0 < MTOK; t0 += 2 * NGW) {
        u32x4 rh[2][4], ra[2][4], rb[2][4]; int tt[2]; bool ok[2];
#pragma unroll
        for (int u = 0; u < 2; ++u) { const int tq = t0 + u * NGW; ok[u] = tq < MTOK; const int t = ok[u] ? tq : t0; tt[u] = t;
            const int e1 = ((const GAS int*)tok_e)[2 * t], e2 = ((const GAS int*)tok_e)[2 * t + 1], p1 = ((const GAS int*)tok_pos)[2 * t], p2 = ((const GAS int*)tok_pos)[2 * t + 1]; int b1 = 0, b2 = 0;
#pragma unroll
            for (int k = 1; k < NEXP; ++k) { b1 = (e1 == k) ? tp[k] : b1; b2 = (e2 == k) ? tp[k] : b2; }
            const size_t s1 = (size_t)b1 * 256 + p1, s2 = (size_t)b2 * 256 + p2;
            const GAS u32x4* hr = (const GAS u32x4*)(HB + (size_t)t * DM) + F.lane; const GAS u32x4* y1 = (const GAS u32x4*)(YC + s1 * DM) + F.lane; const GAS u32x4* y2 = (const GAS u32x4*)(YC + s2 * DM) + F.lane;
#pragma unroll
            for (int j = 0; j < 4; ++j) { rh[u][j] = hr[64 * j]; ra[u][j] = y1[64 * j]; rb[u][j] = y2[64 * j]; } }
#pragma unroll
        for (int u = 0; u < 2; ++u) { if (!ok[u]) continue; const int t = tt[u];
            float v[4][8]; float q = 0.f;
#pragma unroll
            for (int j = 0; j < 4; ++j) { const u32x4 h = rh[u][j], a = ra[u][j], b = rb[u][j];
                v[j][0] = bflo(h.x) + (bflo(a.x) + bflo(b.x)); v[j][1] = bfhi(h.x) + (bfhi(a.x) + bfhi(b.x)); v[j][2] = bflo(h.y) + (bflo(a.y) + bflo(b.y)); v[j][3] = bfhi(h.y) + (bfhi(a.y) + bfhi(b.y));
                v[j][4] = bflo(h.z) + (bflo(a.z) + bflo(b.z)); v[j][5] = bfhi(h.z) + (bfhi(a.z) + bfhi(b.z)); v[j][6] = bflo(h.w) + (bflo(a.w) + bflo(b.w)); v[j][7] = bfhi(h.w) + (bfhi(a.w) + bfhi(b.w));
#pragma unroll
                for (int i = 0; i < 8; ++i) q += v[j][i] * v[j][i]; }
            q = wave_sum(q);
            if (!final_) { GAS u32x4* o = (GAS u32x4*)(HBout + (size_t)t * DM) + F.lane;
#pragma unroll
                for (int j = 0; j < 4; ++j) { u32x4 w; w.x = pk2(v[j][0], v[j][1]); w.y = pk2(v[j][2], v[j][3]); w.z = pk2(v[j][4], v[j][5]); w.w = pk2(v[j][6], v[j][7]); o[64 * j] = w;
                    if (HB8) { u32x2 w8; w8.x = pk4_fp8(v[j][0], v[j][1], v[j][2], v[j][3]); w8.y = pk4_fp8(v[j][4], v[j][5], v[j][6], v[j][7]); ((GAS u32x2*)(HB8 + (size_t)t * DM))[64 * j + F.lane] = w8; } }
                if (F.lane == 0) ((GAS ssq_t*)ssq_next)[t] = ssq_fix(q);
            } else { const float r = __builtin_amdgcn_rsqf(q * (1.f / (float)DM) + RMS_EPS); GAS f32x4* o = (GAS f32x4*)(out + (size_t)t * DM) + 2 * F.lane; const GAS f32x4* gg = (const GAS f32x4*)gfin + 2 * F.lane;
#pragma unroll
                for (int j = 0; j < 4; ++j) { const f32x4 g0 = gg[128 * j], g1 = gg[128 * j + 1];
                    o[128 * j] = (f32x4){v[j][0] * r * g0[0], v[j][1] * r * g0[1], v[j][2] * r * g0[2], v[j][3] * r * g0[3]}; o[128 * j + 1] = (f32x4){v[j][4] * r * g1[0], v[j][5] * r * g1[1], v[j][6] * r * g1[2], v[j][7] * r * g1[3]}; } } }
    }
}

constexpr int N_PHASES = 29;
struct Args { const float* in[16]; float* out; unsigned char* ws; int ph_lo, ph_hi; };
__global__ void __launch_bounds__(NWAVES * 64, 2) fwd_kernel(Args args) {
    extern __shared__ __attribute__((aligned(16))) unsigned char lds_raw[];
    Frame F;
    F.lds = (LAS unsigned char*)lds_raw;
    F.MISC = (volatile LAS unsigned*)(F.lds + MISC_OFF);
    F.tid = threadIdx.x; F.lane = F.tid & 63; F.wave = __builtin_amdgcn_readfirstlane(F.tid >> 6);
    F.G = gridDim.x; F.bid = blockIdx.x;
    F.ws = args.ws; F.ctl = (gu32*)(args.ws + WS_CTL); F.in = args.in;
    for (int u = F.tid; u < (LDS_BYTES - LDSCTL_OFF) / 4; u += NWAVES * 64) ((LAS unsigned*)(F.lds + LDSCTL_OFF))[u] = 0u;
    __syncthreads();
    XcdBarrier bar; bar.bar = (unsigned*)(F.ctl + CW_BAR); bar.x = 0; bar.st = nullptr;
#if MK_ONE_LAUNCH
    bar = xcd_barrier_post((unsigned*)(F.ctl + CW_BAR), F.MISC + 8);
#endif
    const int lo = args.ph_lo, hi = args.ph_hi;
#ifndef MK_KIND_MASK
#define MK_KIND_MASK 0x7fff
#endif
#define KON(kind) (((MK_KIND_MASK) >> (kind)) & 1)
#ifndef MK_DUP_MASK
#define MK_DUP_MASK 0
#endif
#define NREP(kind) ((((MK_DUP_MASK) >> (kind)) & 1) ? 2 : 1)
#ifndef MK_DUP_BAR
#define MK_DUP_BAR 0
#endif
#define DUMMY(kind) (NREP(kind) == 2 && rep_ == 0)
#define IN(k) (lo <= (k) && (k) < hi)
#if MK_ONE_LAUNCH
#ifndef MK_BAR_REP
#define MK_BAR_REP 1
#endif
#define SEAM(k) do { if (IN(k) && IN((k) + 1)) { (void)conv_run(F, (k) + 1, cv_extra); cv_extra = 0; xcd_barrier(bar); } } while (0)
#else
#define SEAM(k) do { } while (0)
#endif
    LAS unsigned char* ring = F.lds + RING_OFF;
    int cv_extra = 0;
#define PH_WS() unsigned char* ws_ = args.ws; asm volatile("" : "+s"(ws_)); Frame Fp = F; { int t_ = threadIdx.x; asm volatile("" : "+v"(t_)); Fp.tid = t_; Fp.lane = t_ & 63; Fp.wave = __builtin_amdgcn_readfirstlane(t_ >> 6); int g_ = gridDim.x, b_ = blockIdx.x; asm volatile("" : "+s"(g_), "+s"(b_)); Fp.G = g_; Fp.bid = b_; } Fp.ws = ws_; Fp.ctl = (gu32*)(ws_ + WS_CTL); ssq_t* ssq = (ssq_t*)(Fp.ctl + CW_SSQ); (void)ssq
#define WSP(T, off) ((T*)(ws_ + (off)))
#define F8_DISPATCH(flagfn, ...) do { if constexpr (flagfn(0) == flagfn(1)) { constexpr bool F8 = flagfn(0); __VA_ARGS__ } else { if (flagfn(lp)) { constexpr bool F8 = true; __VA_ARGS__ } else { constexpr bool F8 = false; __VA_ARGS__ } } } while (0)

    if (KON(0) && IN(0)) for (int rep_ = 0; rep_ < NREP(0); ++rep_) { if (MK_DUP_BAR && rep_ == 1) { asm volatile("" ::: "memory"); xcd_barrier(bar); asm volatile("" ::: "memory"); } PH_WS(); p_prologue(Fp); } SEAM(0);

    for (int lp = 0; lp < 2; ++lp) {
        const int pb = 1 + lp * 14, a0 = lp * 4;
        if (KON(1) && IN(pb + 0)) for (int rep_ = 0; rep_ < NREP(1); ++rep_) { if (MK_DUP_BAR && rep_ == 1) { asm volatile("" ::: "memory"); xcd_barrier(bar); asm volatile("" ::: "memory"); } PH_WS();
            F8_DISPATCH(f8_ein, { constexpr int ES = F8 ? 1 : 2; constexpr float SC = F8 ? GU8_UNSCALE : 1.f;
                const char* EWIN = WSP(char, WS_EWIN) + (size_t)lp * EIN * DM * 2; const char* HBA = F8 ? WSP(char, WS_HB8) : WSP(char, WS_HB);
                { const pg8::GridOrder S = pg8::grid_order(64, 16, Fp.G, Fp.bid, HBA, 256L * DM * ES, 0, EWIN, 0, 256L * DM * ES, 12, 4);
                  const EpiEvenIn E{ssq + (size_t)a0 * MTOK, WSP(bf16_t, WS_U), WSP(bf16_t, WS_QP), WSP(bf16_t, WS_KN), WSP(bf16_t, WS_KT), WSP(bf16_t, WS_SG), SC};
                  pg8::gemm_phase<EpiEvenIn, pg8::GridOrder, true, F8>(ring, DM, DM, DM, S, E); }
                { const pg8::GridOrder S = pg8::grid_order(4, 64, Fp.G, Fp.bid, EWIN + (size_t)3072 * DM * ES, 256L * DM * ES, 0, HBA, 0, 256L * DM * ES);
                  const EpiVt E{ssq + (size_t)a0 * MTOK, WSP(bf16_t, WS_VS), SC};
                  pg8::gemm_phase<EpiVt, pg8::GridOrder, true, F8>(ring, DM, DM, DM, S, E); } });
        } SEAM(pb + 0);
        if (KON(2) && IN(pb + 1)) for (int rep_ = 0; rep_ < NREP(2); ++rep_) { if (MK_DUP_BAR && rep_ == 1) { asm volatile("" ::: "memory"); xcd_barrier(bar); asm volatile("" ::: "memory"); } PH_WS();
            t_pool_p(Fp, WSP(bf16_t, WS_U), WSP(bf16_t, WS_PP));
            { const pg8::GridOrder S = pg8::grid_order(64, 4, Fp.G, Fp.bid, WSP(bf16_t, WS_VS), 4L * 256 * 512 * 2, 256L * 512 * 2, WSP(bf16_t, WS_KT), 4L * 65536 * 2, 65536L * 2);
              const EpiBf16Unit E{WSP(bf16_t, WS_LT)};
              pg8::gemm_phase(ring, 256, 512, 256, S, E); }
        } SEAM(pb + 1);
        if (KON(3) && IN(pb + 2)) for (int rep_ = 0; rep_ < NREP(3); ++rep_) { if (MK_DUP_BAR && rep_ == 1) { asm volatile("" ::: "memory"); xcd_barrier(bar); asm volatile("" ::: "memory"); } PH_WS();
            t_scan(Fp, WSP(bf16_t, WS_LT), WSP(bf16_t, WS_VS));
            { const pg8::GridOrder S = pg8::grid_order(64, 4, Fp.G, Fp.bid, WSP(bf16_t, WS_PP), 256L * 1024 * 2, 256 * 2, WSP(bf16_t, WS_EWP) + (size_t)lp * 4 * 65536, 0, 65536L * 2);
              const EpiBf16Plain E{WSP(bf16_t, WS_YCAT), 2048, f8_eout(lp) ? WSP(unsigned char, WS_Y8) : (unsigned char*)nullptr};
              pg8::gemm_phase(ring, 256, 1024, 256, S, E); }
            { bf16_t* QP = WSP(bf16_t, WS_QP);
              const pg8::GridOrder S = pg8::grid_order(64, 4, Fp.G, Fp.bid, QP + 256, 256L * 2048 * 2, 512 * 2, WSP(bf16_t, WS_KN), 256L * 1024 * 2, 256 * 2);
              const EpiQK E{QP};
              pg8::gemm_phase(ring, 256, 2048, 1024, S, E); }
        } SEAM(pb + 2);
        if (KON(4) && IN(pb + 3)) for (int rep_ = 0; rep_ < NREP(4); ++rep_) { if (MK_DUP_BAR && rep_ == 1) { asm volatile("" ::: "memory"); xcd_barrier(bar); asm volatile("" ::: "memory"); } PH_WS();
            const pg8::GridOrder S = pg8::grid_order(64, 4, Fp.G, Fp.bid, WSP(bf16_t, WS_QP), 256L * 2048 * 2, 512 * 2, WSP(bf16_t, WS_VS), 4L * 256 * 512 * 2, 256L * 512 * 2);
            const EpiRetOut E{WSP(bf16_t, WS_SG), WSP(bf16_t, WS_YCAT), f8_eout(lp) ? WSP(unsigned char, WS_Y8) : (unsigned char*)nullptr};
            pg8::gemm_phase(ring, 512, 2048, 512, S, E);
        } SEAM(pb + 3);
        if (KON(5) && IN(pb + 4)) for (int rep_ = 0; rep_ < NREP(5); ++rep_) { PH_WS();
            F8_DISPATCH(f8_eout, { constexpr int ES = F8 ? 1 : 2; constexpr bool F8W = F8;
                const pg8::GridOrder S = pg8::grid_order(64, 8, Fp.G, Fp.bid, F8W ? WSP(char, WS_Y8) : WSP(char, WS_YCAT), 256L * DM * ES, 0, WSP(char, WS_EWOUT) + (size_t)lp * DM * DM * 2, 0, 256L * DM * ES);
                if (f8_ffn(lp)) { const EpiResidual<true> E{WSP(bf16_t, WS_HB), DUMMY(5) ? WSP(bf16_t, WS_ACTM) : WSP(bf16_t, WS_HB), ssq + (size_t)(DUMMY(5) ? 8 : a0 + 1) * MTOK, F8W ? GU8_UNSCALE : 1.f, WSP(unsigned char, WS_HB8)};
                    pg8::gemm_phase<EpiResidual<true>, pg8::GridOrder, true, F8W>(ring, DM, DM, DM, S, E); }
                else { const EpiResidual<false> E{WSP(bf16_t, WS_HB), DUMMY(5) ? WSP(bf16_t, WS_ACTM) : WSP(bf16_t, WS_HB), ssq + (size_t)(DUMMY(5) ? 8 : a0 + 1) * MTOK, F8W ? GU8_UNSCALE : 1.f, nullptr};
                    pg8::gemm_phase<EpiResidual<false>, pg8::GridOrder, true, F8W>(ring, DM, DM, DM, S, E); } });
        } SEAM(pb + 4);
        if (KON(6) && IN(pb + 5)) for (int rep_ = 0; rep_ < NREP(6); ++rep_) { if (MK_DUP_BAR && rep_ == 1) { asm volatile("" ::: "memory"); xcd_barrier(bar); asm volatile("" ::: "memory"); } PH_WS();
            F8_DISPATCH(f8_ffn, { constexpr int ES = F8 ? 1 : 2;
                const pg8::GridOrder S = pg8::grid_order(64, 44, Fp.G, Fp.bid, F8 ? WSP(char, WS_HB8) : WSP(char, WS_HB), 256L * DM * ES, 0, WSP(char, WS_FGU) + (size_t)lp * 2 * FFN * DM * 2, 0, 256L * DM * ES);
                if (f8_dn(lp)) { const EpiSwiGLU<F8, true> E{ssq + (size_t)(a0 + 1) * MTOK, WSP(void, WS_ACT), FFN}; pg8::gemm_phase<EpiSwiGLU<F8, true>, pg8::GridOrder, true, F8>(ring, DM, DM, DM, S, E); }
                else { const EpiSwiGLU<F8, false> E{ssq + (size_t)(a0 + 1) * MTOK, WSP(void, WS_ACT), FFN}; pg8::gemm_phase<EpiSwiGLU<F8, false>, pg8::GridOrder, true, F8>(ring, DM, DM, DM, S, E); } });
        } SEAM(pb + 5);
        if (KON(7) && IN(pb + 6)) for (int rep_ = 0; rep_ < NREP(7); ++rep_) { if (MK_DUP_BAR && rep_ == 1) { asm volatile("" ::: "memory"); xcd_barrier(bar); asm volatile("" ::: "memory"); } PH_WS();
            F8_DISPATCH(f8_dn, { constexpr int ES = F8 ? 1 : 2; constexpr bool F8IN = F8;
                const pg8::GridOrder S = pg8::grid_order(64, 8, Fp.G, Fp.bid, WSP(char, WS_ACT), 256L * FFN * ES, 0, WSP(char, WS_FDN) + (size_t)lp * DM * FFN * 2, 0, 256L * FFN * ES);
                if (f8_oin(lp) && !DUMMY(7)) { const EpiResidual<true> E{WSP(bf16_t, WS_HB), WSP(bf16_t, WS_HB), ssq + (size_t)(a0 + 2) * MTOK, F8IN ? DN8_UNSCALE : 1.f, WSP(unsigned char, WS_HB8)};
                    pg8::gemm_phase<EpiResidual<true>, pg8::GridOrder, true, F8IN>(ring, FFN, FFN, FFN, S, E); }
                else { const EpiResidual<false> E{WSP(bf16_t, WS_HB), DUMMY(7) ? WSP(bf16_t, WS_ACTM) : WSP(bf16_t, WS_HB), ssq + (size_t)(DUMMY(7) ? 8 : a0 + 2) * MTOK, F8IN ? DN8_UNSCALE : 1.f, nullptr};
                    pg8::gemm_phase<EpiResidual<false>, pg8::GridOrder, true, F8IN>(ring, FFN, FFN, FFN, S, E); } });
        } SEAM(pb + 6);
        if (KON(8) && IN(pb + 7)) for (int rep_ = 0; rep_ < NREP(8); ++rep_) { if (MK_DUP_BAR && rep_ == 1) { asm volatile("" ::: "memory"); xcd_barrier(bar); asm volatile("" ::: "memory"); } PH_WS();
            F8_DISPATCH(f8_oin, { constexpr int ES = F8 ? 1 : 2;
                const pg8::GridOrder S = pg8::grid_order(64, 24, Fp.G, Fp.bid, F8 ? WSP(char, WS_HB8) : WSP(char, WS_HB), 256L * DM * ES, 0, WSP(char, WS_OWIN) + (size_t)lp * OIN * DM * 2, 0, 256L * DM * ES);
                const EpiOddIn E{ssq + (size_t)(a0 + 2) * MTOK, WSP(bf16_t, WS_BG), WSP(bf16_t, WS_Z), F8 ? GU8_UNSCALE : 1.f};
                pg8::gemm_phase<EpiOddIn, pg8::GridOrder, true, F8>(ring, DM, DM, DM, S, E); });
        } SEAM(pb + 7);
        if (KON(9) && IN(pb + 8)) for (int rep_ = 0; rep_ < NREP(9); ++rep_) { if (MK_DUP_BAR && rep_ == 1) { asm volatile("" ::: "memory"); xcd_barrier(bar); asm volatile("" ::: "memory"); } PH_WS(); t_conv(Fp, WSP(bf16_t, WS_BG), WSP(bf16_t, WS_Z), args.in[9] + (size_t)lp * 3 * DM, WSP(bf16_t, WS_YCAT), f8_oout(lp) ? WSP(unsigned char, WS_Y8) : (unsigned char*)nullptr); } SEAM(pb + 8);
        if (KON(10) && IN(pb + 9)) for (int rep_ = 0; rep_ < NREP(10); ++rep_) { PH_WS();
            F8_DISPATCH(f8_oout, { constexpr int ES = F8 ? 1 : 2; constexpr bool F8W = F8;
                const pg8::GridOrder S = pg8::grid_order(64, 8, Fp.G, Fp.bid, F8W ? WSP(char, WS_Y8) : WSP(char, WS_YCAT), 256L * DM * ES, 0, WSP(char, WS_OWOUT) + (size_t)lp * DM * DM * 2, 0, 256L * DM * ES);
                if (f8_moe(lp)) { const EpiResidual<true> E{WSP(bf16_t, WS_HB), DUMMY(10) ? WSP(bf16_t, WS_ACTM) : WSP(bf16_t, WS_HB), ssq + (size_t)(DUMMY(10) ? 8 : a0 + 3) * MTOK, F8W ? GU8_UNSCALE : 1.f, WSP(unsigned char, WS_HB8)};
                    pg8::gemm_phase<EpiResidual<true>, pg8::GridOrder, true, F8W>(ring, DM, DM, DM, S, E); }
                else { const EpiResidual<false> E{WSP(bf16_t, WS_HB), DUMMY(10) ? WSP(bf16_t, WS_ACTM) : WSP(bf16_t, WS_HB), ssq + (size_t)(DUMMY(10) ? 8 : a0 + 3) * MTOK, F8W ? GU8_UNSCALE : 1.f, nullptr};
                    pg8::gemm_phase<EpiResidual<false>, pg8::GridOrder, true, F8W>(ring, DM, DM, DM, S, E); } });
        } SEAM(pb + 9);
        if (KON(11) && IN(pb + 10)) for (int rep_ = 0; rep_ < NREP(11); ++rep_) { if (MK_DUP_BAR && rep_ == 1) { asm volatile("" ::: "memory"); xcd_barrier(bar); asm volatile("" ::: "memory"); } PH_WS(); const size_t dmy_ = DUMMY(11) ? 2 * MiB : 0;
            t_router(Fp, WSP(bf16_t, WS_HB), ssq + (size_t)(a0 + 3) * MTOK, args.in[2] + (2 * lp + 1) * DM, args.in[13] + (size_t)lp * DM * NEXP, (unsigned*)(Fp.ctl + CW_CNT + (DUMMY(11) ? 2 + lp : lp) * NEXP * 64),
                     WSP(int, WS_MISC + MS_TOKE + dmy_), WSP(int, WS_MISC + MS_TOKP + dmy_), WSP(int, WS_MISC + MS_ROWTOK + dmy_), WSP(float, WS_MISC + MS_ER + dmy_), WSP(float, WS_MISC + MS_EW + dmy_)); } SEAM(pb + 10);
        if (KON(12) && IN(pb + 11)) for (int rep_ = 0; rep_ < NREP(12); ++rep_) { if (MK_DUP_BAR && rep_ == 1) { asm volatile("" ::: "memory"); xcd_barrier(bar); asm volatile("" ::: "memory"); } PH_WS();
            F8_DISPATCH(f8_moe, { constexpr int ES = F8 ? 1 : 2;
                MoeOrder<true> S; S.init((unsigned*)(Fp.ctl + CW_CNT + lp * NEXP * 64), 22, Fp.G, Fp.bid); S.A0 = F8 ? WSP(char, WS_HB8) : WSP(char, WS_HB); S.B0 = WSP(char, WS_MGU) + (size_t)lp * NEXP * 2 * EXD * DM * 2;
                S.a_rt = 0; S.b_e = 2L * EXD * DM * 2; S.b_sn = 256L * DM * ES; S.rowtok = WSP(int, WS_MISC + MS_ROWTOK); S.row_bytes = DM * ES;
                const EpiMoeGU<F8> E{WSP(float, WS_MISC + MS_ER), WSP(void, WS_ACTM)};
                pg8::gemm_phase<EpiMoeGU<F8>, MoeOrder<true>, true, F8>(ring, DM, DM, DM, S, E); });
        } SEAM(pb + 11);
        if (KON(13) && IN(pb + 12)) for (int rep_ = 0; rep_ < NREP(13); ++rep_) { if (MK_DUP_BAR && rep_ == 1) { asm volatile("" ::: "memory"); xcd_barrier(bar); asm volatile("" ::: "memory"); } PH_WS();
            F8_DISPATCH(f8_moe, { constexpr int ES = F8 ? 1 : 2;
                MoeOrder<false> S; S.init((unsigned*)(Fp.ctl + CW_CNT + lp * NEXP * 64), 8, Fp.G, Fp.bid); S.A0 = WSP(char, WS_ACTM); S.B0 = WSP(char, WS_MDN) + (size_t)lp * NEXP * DM * EXD * 2;
                S.a_rt = 256L * EXD * ES; S.b_e = (long)DM * EXD * 2; S.b_sn = 256L * EXD * ES; S.rowtok = nullptr; S.row_bytes = 0;
                const EpiMoeDown E{WSP(float, WS_MISC + MS_EW), WSP(bf16_t, WS_YC), F8 ? DN8_UNSCALE : 1.f};
                pg8::gemm_phase<EpiMoeDown, MoeOrder<false>, true, F8>(ring, EXD, EXD, EXD, S, E);
                { const int total = S.tp[NEXP] * 8, maxr = (total + Fp.G - 1) / Fp.G; if ((long)(maxr - 1) * Fp.G + Fp.bid >= total) cv_extra = MK_STEAL_N; } });
        } SEAM(pb + 12);
        if (KON(14) && IN(pb + 13)) for (int rep_ = 0; rep_ < NREP(14); ++rep_) { if (MK_DUP_BAR && rep_ == 1) { asm volatile("" ::: "memory"); xcd_barrier(bar); asm volatile("" ::: "memory"); } PH_WS();
            t_combine(Fp, WSP(bf16_t, WS_HB), DUMMY(14) ? WSP(bf16_t, WS_ACTM) : WSP(bf16_t, WS_HB), WSP(bf16_t, WS_YC), (unsigned*)(Fp.ctl + CW_CNT + lp * NEXP * 64), WSP(int, WS_MISC + MS_TOKE), WSP(int, WS_MISC + MS_TOKP), ssq + (size_t)(DUMMY(14) ? 8 : a0 + 4) * MTOK, args.in[3], DUMMY(14) ? WSP(float, WS_BG) : args.out, lp == 1, (lp == 0 && f8_ein(1) && !DUMMY(14)) ? WSP(unsigned char, WS_HB8) : (unsigned char*)nullptr); } SEAM(pb + 13);
    }
#undef PH_WS
#undef WSP
#undef F8_DISPATCH
#undef IN
#undef SEAM
}

extern "C" void kernel_launch(void* const* d_in, const int* in_sizes, int n_in, void* d_out, int out_size, void* d_ws, size_t ws_size, hipStream_t stream) {
    static int grid = 0;
    if (grid == 0) {
        if (n_in != 16 || in_sizes[0] != MTOK * DM || out_size != MTOK * DM || ws_size < WS_END) { fprintf(stderr, "kernel_launch: unexpected shapes / workspace (n_in %d, in0 %d, out %d, ws %zu < %zu); nothing launched\n", n_in, n_in > 0 ? in_sizes[0] : -1, out_size, ws_size, (size_t)WS_END); grid = -1; return; }
        int dev = 0, cus = 0, per_cu = 0;
        if (hipGetDevice(&dev) != hipSuccess || hipDeviceGetAttribute(&cus, hipDeviceAttributeMultiprocessorCount, dev) != hipSuccess) { fprintf(stderr, "kernel_launch: device query failed\n"); grid = -1; return; }
        if (hipFuncSetAttribute((const void*)fwd_kernel, hipFuncAttributeMaxDynamicSharedMemorySize, LDS_BYTES) != hipSuccess) { fprintf(stderr, "kernel_launch: hipFuncSetAttribute failed\n"); grid = -1; return; }
        if (hipOccupancyMaxActiveBlocksPerMultiprocessor(&per_cu, (const void*)fwd_kernel, NWAVES * 64, LDS_BYTES) != hipSuccess || per_cu < 1) { fprintf(stderr, "kernel_launch: occupancy query reports %d blocks per CU; nothing launched\n", per_cu); (void)hipGetLastError(); grid = -1; return; }
        if (cus != 256) { fprintf(stderr, "kernel_launch: built for a 256-CU device, found %d CUs; nothing launched\n", cus); grid = -1; return; }
        grid = cus;
    }
    if (grid < 0) return;
    if (hipMemsetAsync((char*)d_ws + WS_CTL, 0, CTL_ZERO_BYTES, stream) != hipSuccess) { fprintf(stderr, "kernel_launch: memset failed\n"); return; }
    Args a{};
    for (int i = 0; i < 16; ++i) a.in[i] = (const float*)d_in[i];
    a.out = (float*)d_out; a.ws = (unsigned char*)d_ws;
#if MK_ONE_LAUNCH
    a.ph_lo = 0; a.ph_hi = N_PHASES;
    hipLaunchKernelGGL(fwd_kernel, dim3(grid), dim3(NWAVES * 64), LDS_BYTES, stream, a);
#else
    for (int p = 0; p < N_PHASES; ++p) { a.ph_lo = p; a.ph_hi = p + 1; hipLaunchKernelGGL(fwd_kernel, dim3(grid), dim3(NWAVES * 64), LDS_BYTES, stream, a); }
#endif
    const hipError_t le = hipPeekAtLastError();
    if (le != hipSuccess) fprintf(stderr, "kernel_launch: launch failed: %s\n", hipGetErrorName(le));
}
```

```cpp
#include <hip/hip_runtime.h>
#include <cstdio>
#include <cstdint>

#define LAS __attribute__((address_space(3)))
#define GAS __attribute__((address_space(1)))
typedef unsigned short bf16_t;
typedef short bf16x8 __attribute__((ext_vector_type(8)));
typedef float f32x4 __attribute__((ext_vector_type(4)));
typedef float f32x2 __attribute__((ext_vector_type(2)));
typedef unsigned u32x4 __attribute__((ext_vector_type(4)));
typedef unsigned u32x2 __attribute__((ext_vector_type(2)));
typedef GAS unsigned gu32;

#ifndef MK_FAST_GEMM
#define MK_FAST_GEMM 1
#endif
#ifndef MK_ONE_LAUNCH
#define MK_ONE_LAUNCH 1
#endif

namespace pg8 {
constexpr int BM = 256, BK = 64, HALF = 128, HTB = HALF * BK * 2  , STAGE_BYTES = 8 * HTB, NXCD = 8, WGM = 8;

__host__ __device__ __forceinline__ int lds_byte(int r, int c) { const int st = (r >> 4) * 2 + (c >> 5), rr = r & 15, cc = c & 31, ob = rr * 64 + cc * 2; return st * 1024 + (ob ^ (((ob >> 9) & 1) << 5)); }
__host__ __device__ __forceinline__ void stage_rc(int b, int& R, int& C) { const int st = b / 1024, sb = b % 1024, swz = sb ^ (((sb >> 9) & 1) << 5); R = (st >> 1) * 16 + swz / 64; C = (st & 1) * 32 + (swz % 64) / 2; }
__host__ __device__ __forceinline__ int perm32(int rho) { const int n = rho >> 4, i = rho & 15; return 8 * (i >> 2) + 4 * n + (i & 3); }

struct Unit { int pm, pn; const char* a; const char* b; int x0, x1, x2; };

__device__ __forceinline__ void tile_of(int L, int nM, int nN, int& pm, int& pn) {
    const int nwg = nM * nN; int wgid = L;
    { const int q = nwg / NXCD, r = nwg % NXCD, xcd = wgid % NXCD, off = wgid / NXCD; wgid = (xcd < r ? xcd * (q + 1) : r * (q + 1) + (xcd - r) * q) + off; }
    const int nig = WGM * nN, gid = wgid / nig, fm = gid * WGM, gsz = (nM - fm) < WGM ? (nM - fm) : WGM;
    pm = fm + ((wgid % nig) % gsz); pn = (wgid % nig) / gsz;
}

struct GridOrder {
    static constexpr bool GATHER = false;
    int nM, nN, G, c, skip_from, skip_by;
    const char *A0, *B0; long a_sm, a_sn, b_sm, b_sn;
    __device__ __forceinline__ bool next(int i, Unit& u) const {
        const long L = (long)i * G + c; if (L >= (long)nM * nN) return false;
        int pm, pn; tile_of((int)L, nM, nN, pm, pn); if (pn >= skip_from) pn += skip_by;
        u.pm = pm; u.pn = pn; u.a = A0 + pm * a_sm + pn * a_sn; u.b = B0 + pm * b_sm + pn * b_sn; u.x0 = u.x1 = u.x2 = 0; return true;
    }
    __device__ __forceinline__ unsigned goff(const Unit&, int) const { return 0u; }
};
__device__ __forceinline__ GridOrder grid_order(int nM, int nN, int G, int c, const void* A0, long a_sm, long a_sn, const void* B0, long b_sm, long b_sn, int skip_from = 1 << 30, int skip_by = 0) {
    GridOrder S; S.nM = nM; S.nN = nN; S.G = G; S.c = c; S.skip_from = skip_from; S.skip_by = skip_by; S.A0 = (const char*)A0; S.B0 = (const char*)B0; S.a_sm = a_sm; S.a_sn = a_sn; S.b_sm = b_sm; S.b_sn = b_sn; return S;
}

__device__ __forceinline__ unsigned cvt_pk_bf16(float lo, float hi) { unsigned r; asm volatile("v_cvt_pk_bf16_f32 %0, %1, %2" : "=v"(r) : "v"(lo), "v"(hi)); return r; }
__device__ __forceinline__ float bf2f(unsigned short b) { return __uint_as_float(((unsigned)b) << 16); }
__device__ __forceinline__ float bflo(unsigned w) { return __uint_as_float(w << 16); }
__device__ __forceinline__ float bfhi(unsigned w) { return __uint_as_float(w & 0xffff0000u); }

typedef int i32x8 __attribute__((ext_vector_type(8)));
typedef int i32x4 __attribute__((ext_vector_type(4)));
typedef float f32x8 __attribute__((ext_vector_type(8)));
__device__ __forceinline__ i32x8 frag8(bf16x8 lo, bf16x8 hi) { const i32x4 a = __builtin_bit_cast(i32x4, lo), b = __builtin_bit_cast(i32x4, hi); return (i32x8){a[0], a[1], a[2], a[3], b[0], b[1], b[2], b[3]}; }

constexpr int PF_SIDE_OFF = 131072 + 4096, PF_SIDE_BYTES = 2048;
template <class E, class = void> struct epi_pf { static constexpr int value = 0; };
template <class E> struct epi_pf<E, decltype((void)E::PF_BYTES)> { static constexpr int value = E::PF_BYTES; };
template <class Epi, class Sched, bool ALIGN_EPI = true>
__device__ __forceinline__ void gemm_phase_ref(LAS unsigned char* lds, const int K, const int lda, const int ldb, const Sched& S, const Epi& E) {
    const int tid = threadIdx.x, wid = __builtin_amdgcn_readfirstlane(tid >> 6), lane = tid & 63, wr = wid >> 2, wc = wid & 3, fr = lane & 15, fq = lane >> 4;
    constexpr int KT = 32, LDR = KT + 8;
    LAS bf16_t* As = (LAS bf16_t*)lds; LAS bf16_t* Bs = As + 256 * LDR;
    for (int ui = 0;; ++ui) {
        Unit u; if (!S.next(ui, u)) break;
        f32x4 acc[2][2][4][2];
#pragma unroll
        for (int a = 0; a < 2; ++a)
#pragma unroll
            for (int b = 0; b < 2; ++b)
#pragma unroll
                for (int m = 0; m < 4; ++m)
#pragma unroll
                    for (int n = 0; n < 2; ++n) acc[a][b][m][n] = (f32x4){0.f, 0.f, 0.f, 0.f};
        for (int k0 = 0; k0 < K; k0 += KT) {
            __syncthreads();
            for (int c = tid; c < 1024; c += 512) { const int row = c >> 2, ch = c & 3;
                const char* ap = Sched::GATHER ? (u.a + S.goff(u, row)) : (u.a + (size_t)row * lda * 2);
                const u32x4 va = *(const GAS u32x4*)(ap + (size_t)k0 * 2 + ch * 16); *(LAS u32x4*)(As + row * LDR + ch * 8) = va;
                const u32x4 vb = *(const GAS u32x4*)(u.b + (size_t)row * ldb * 2 + (size_t)k0 * 2 + ch * 16); *(LAS u32x4*)(Bs + row * LDR + ch * 8) = vb; }
            __syncthreads();
            for (int kk = 0; kk < KT; ++kk) {
                float av[2][4], bv[2][2][4];
#pragma unroll
                for (int ai = 0; ai < 2; ++ai)
#pragma unroll
                    for (int m = 0; m < 4; ++m) av[ai][m] = bf2f(As[(ai * 128 + wr * 64 + m * 16 + fr) * LDR + kk]);
#pragma unroll
                for (int bj = 0; bj < 2; ++bj)
#pragma unroll
                    for (int n = 0; n < 2; ++n)
#pragma unroll
                        for (int j = 0; j < 4; ++j) { const int col = Epi::PERM ? (bj * 128 + wc * 32 + 8 * fq + 4 * n + j) : (bj * 128 + wc * 32 + 16 * n + 4 * fq + j); bv[bj][n][j] = bf2f(Bs[col * LDR + kk]); }
#pragma unroll
                for (int ai = 0; ai < 2; ++ai)
#pragma unroll
                    for (int bj = 0; bj < 2; ++bj)
#pragma unroll
                        for (int m = 0; m < 4; ++m)
#pragma unroll
                            for (int n = 0; n < 2; ++n)
#pragma unroll
                                for (int j = 0; j < 4; ++j) acc[ai][bj][m][n][j] += av[ai][m] * bv[bj][n][j];
            }
        }
        if constexpr (Epi::AFTER_DRAIN) { __syncthreads(); E.fused(acc, u, wr, wc, fr, fq, lds, wid, lane); __syncthreads(); }
        else E(acc, u, wr, wc, fr, fq);
    }
    __syncthreads();
}

template <class Epi, class Sched, bool ALIGN_EPI = true, bool FP8 = false>
__device__ __forceinline__ void gemm_phase_fast(LAS unsigned char* lds, const int K, const int lda, const int ldb, const Sched& S, const Epi& E) {
    int tid_ = threadIdx.x; asm volatile("" : "+v"(tid_));
    const int tid = tid_, wid = __builtin_amdgcn_readfirstlane(tid >> 6), lane = tid & 63, wr = wid >> 2, wc = wid & 3, fr = lane & 15, fq = lane >> 4;
    constexpr int ESZ = FP8 ? 1 : 2;
    const int nt = K * ESZ / (BK * 2);
    constexpr bool GA = Sched::GATHER;
    unsigned voffA[2], voffB[2], colA[2]; int rowA[2];
#pragma unroll
    for (int i = 0; i < 2; ++i) { int R, C; stage_rc(tid * 16 + i * 8192, R, C); const int Rb = Epi::PERM ? ((R & ~31) + perm32(R & 31)) : R;
        voffA[i] = (unsigned)(R * lda * ESZ + C * 2); voffB[i] = (unsigned)(Rb * ldb * ESZ + C * 2); colA[i] = (unsigned)C * 2u; rowA[i] = R; }
    const size_t kstep = (size_t)(BK * 2);
    const size_t hstepA = GA ? (size_t)0 : (size_t)HALF * lda * ESZ, hstepB = (size_t)HALF * ldb * ESZ;
    const unsigned ldsw = (unsigned)wid * 1024u;
    const int aoff = lds_byte(wr * 64 + fr, fq * 8), boff = lds_byte(wc * 32 + fr, fq * 8);
    unsigned gC[2][2], gN[2][2];
#define PG8_SA(b, h) (((b) * 2 + (h)) * HTB)
#define PG8_SB(b, h) ((4 + (b) * 2 + (h)) * HTB)
#define PG8_GLDS(gp, bufoff, _i) __builtin_amdgcn_global_load_lds((const unsigned*)(gp), (LAS unsigned*)(lds + (bufoff) + ldsw + (_i) * 8192), 16, 0, 0)
#define PG8_STAGE_B(bufoff, gbase) do { _Pragma("unroll") for (int _i = 0; _i < 2; ++_i) PG8_GLDS((const char*)(gbase) + voffB[_i], bufoff, _i); } while (0)
#define PG8_STAGE_A(bufoff, gbase, h, nx) do { _Pragma("unroll") for (int _i = 0; _i < 2; ++_i) { \
        if constexpr (GA) PG8_GLDS((const char*)(gbase) + ((nx) ? gN[h][_i] : gC[h][_i]), bufoff, _i); \
        else PG8_GLDS((const char*)(gbase) + (h) * hstepA + voffA[_i], bufoff, _i); } } while (0)
#define PG8_LDA(dst, b, h) do { if constexpr (FP8) { _Pragma("unroll") for (int m = 0; m < 4; ++m) { dst##8[m].lo = *(const LAS i32x4*)(lds + PG8_SA(b, h) + aoff + m * 2048); dst##8[m].hi = *(const LAS i32x4*)(lds + PG8_SA(b, h) + aoff + m * 2048 + 1024); } } \
        else { _Pragma("unroll") for (int m = 0; m < 4; ++m) _Pragma("unroll") for (int k = 0; k < 2; ++k) dst[m][k] = *(const LAS bf16x8*)(lds + PG8_SA(b, h) + aoff + m * 2048 + k * 1024); } } while (0)
#define PG8_LDB(dst, b, h) do { if constexpr (FP8) { _Pragma("unroll") for (int n = 0; n < 2; ++n) { dst##8[n].lo = *(const LAS i32x4*)(lds + PG8_SB(b, h) + boff + n * 2048); dst##8[n].hi = *(const LAS i32x4*)(lds + PG8_SB(b, h) + boff + n * 2048 + 1024); } } \
        else { _Pragma("unroll") for (int n = 0; n < 2; ++n) _Pragma("unroll") for (int k = 0; k < 2; ++k) dst[n][k] = *(const LAS bf16x8*)(lds + PG8_SB(b, h) + boff + n * 2048 + k * 1024); } } while (0)
#define PG8_MMA(ai, bj, At, Bt) do { __builtin_amdgcn_s_setprio(1); _Pragma("unroll") for (int m = 0; m < 4; ++m) _Pragma("unroll") for (int n = 0; n < 2; ++n) { \
        if constexpr (FP8) asm volatile("v_mfma_scale_f32_16x16x128_f8f6f4 %0, %1, %2, %0, %3, %3 op_sel_hi:[0,0,0]" : "+v"(acc[ai][bj][m][n]) : "v"(Bt##8[n]), "v"(At##8[m]), "v"(sc1)); \
        else { _Pragma("unroll") for (int k = 0; k < 2; ++k) acc[ai][bj][m][n] = __builtin_amdgcn_mfma_f32_16x16x32_bf16(Bt[n][k], At[m][k], acc[ai][bj][m][n], 0, 0, 0); } } __builtin_amdgcn_s_setprio(0); } while (0)
#define PG8_WAIT_V(n) asm volatile("s_waitcnt vmcnt(" #n ")" ::: "memory")
#define PG8_WAIT_L(n) asm volatile("s_waitcnt lgkmcnt(" #n ")" ::: "memory")
#define PG8_BAR __builtin_amdgcn_s_barrier()
#define PG8_SCHED __builtin_amdgcn_sched_barrier(0)
    Unit cur, nxt; int ui = 0;
    if (!S.next(0, cur)) return;
    f32x4 acc[2][2][4][2];
#pragma unroll
    for (int a = 0; a < 2; ++a)
#pragma unroll
        for (int b = 0; b < 2; ++b)
#pragma unroll
            for (int m = 0; m < 4; ++m)
#pragma unroll
                for (int n = 0; n < 2; ++n) acc[a][b][m][n] = (f32x4){0.f, 0.f, 0.f, 0.f};
    bf16x8 At[4][2], B0[2][2], B1[2][2];
    i32x8 At8[4], B08[2], B18[2];
    const int sc1 = 0x7f7f7f7f;
    (void)At; (void)B0; (void)B1; (void)At8; (void)B08; (void)B18; (void)sc1;
    const char* cA = cur.a; const char* cB = cur.b;
    if constexpr (GA) {
#pragma unroll
        for (int h = 0; h < 2; ++h)
#pragma unroll
            for (int i = 0; i < 2; ++i) { gC[h][i] = S.goff(cur, h * HALF + rowA[i]) + colA[i]; gN[h][i] = gC[h][i]; }
    }
    PG8_STAGE_B(PG8_SB(0, 0), cB); PG8_STAGE_B(PG8_SB(0, 1), cB + hstepB); PG8_STAGE_A(PG8_SA(0, 0), cA, 0, false); PG8_STAGE_A(PG8_SA(0, 1), cA, 1, false);
    if (wr == 1) PG8_BAR;
    PG8_WAIT_V(2); PG8_BAR;
    PG8_STAGE_B(PG8_SB(1, 0), cB + kstep); PG8_STAGE_A(PG8_SA(1, 0), cA + kstep, 0, false); PG8_STAGE_B(PG8_SB(1, 1), cB + hstepB + kstep);
    PG8_WAIT_V(6); PG8_BAR;
#pragma unroll 1
    for (;;) {
        const bool has_next = S.next(ui + 1, nxt);
        if constexpr (epi_pf<Epi>::value > 0) {
            if (epi_pf<Epi>::value == 8 || wid < 4) { unsigned m_ = ~0u; asm volatile("" : "+s"(m_)); const int l_ = (int)__builtin_amdgcn_mbcnt_hi(m_, __builtin_amdgcn_mbcnt_lo(m_, 0u));
                __builtin_amdgcn_global_load_lds((const unsigned*)((const char*)E.pf_src(cur) + (wid * 64 + l_) * 4), (LAS unsigned*)(lds + PF_SIDE_OFF + (ui & 1) * PF_SIDE_BYTES + wid * 256), 4, 0, 0); } }
        const char* nA = has_next ? nxt.a : cA; const char* nB = has_next ? nxt.b : cB;
        if constexpr (GA) { if (has_next) {
#pragma unroll
            for (int h = 0; h < 2; ++h)
#pragma unroll
                for (int i = 0; i < 2; ++i) gN[h][i] = S.goff(nxt, h * HALF + rowA[i]) + colA[i]; } }
#pragma unroll 1
        for (int t = 0; t < nt; t += 2) {
            const bool last = (t == nt - 2);
            const char* a1 = cA + (size_t)(t + 1) * kstep;
            const char* a2 = last ? nA : cA + (size_t)(t + 2) * kstep; const char* b2 = last ? nB : cB + (size_t)(t + 2) * kstep;
            const char* a3 = a2 + kstep; const char* b3 = b2 + kstep;
            PG8_LDB(B0, 0, 0); PG8_LDB(B1, 0, 1); PG8_SCHED; PG8_LDA(At, 0, 0); PG8_STAGE_A(PG8_SA(1, 1), a1, 1, false);
            PG8_WAIT_V(8); PG8_WAIT_L(0); PG8_BAR; PG8_MMA(0, 0, At, B0); PG8_MMA(0, 1, At, B1); PG8_BAR; PG8_SCHED;
            PG8_LDA(At, 0, 1); PG8_STAGE_B(PG8_SB(0, 0), b2); PG8_STAGE_B(PG8_SB(0, 1), b2 + hstepB); PG8_STAGE_A(PG8_SA(0, 0), a2, 0, last);
            PG8_WAIT_V(8); PG8_WAIT_L(0); PG8_BAR; PG8_MMA(1, 0, At, B0); PG8_MMA(1, 1, At, B1); PG8_BAR; PG8_SCHED;
            PG8_LDB(B0, 1, 0); PG8_LDB(B1, 1, 1); PG8_SCHED; PG8_LDA(At, 1, 0); PG8_STAGE_A(PG8_SA(0, 1), a2, 1, last);
            PG8_WAIT_V(8); PG8_WAIT_L(0); PG8_BAR; PG8_MMA(0, 0, At, B0); PG8_MMA(0, 1, At, B1); PG8_BAR; PG8_SCHED;
            PG8_LDA(At, 1, 1); PG8_STAGE_B(PG8_SB(1, 0), b3); PG8_STAGE_B(PG8_SB(1, 1), b3 + hstepB); PG8_STAGE_A(PG8_SA(1, 0), a3, 0, last);
            PG8_WAIT_V(8); PG8_WAIT_L(0); PG8_BAR; PG8_MMA(1, 0, At, B0); PG8_MMA(1, 1, At, B1); PG8_BAR; PG8_SCHED;
        }
        if constexpr (ALIGN_EPI) { if (wr == 0) PG8_BAR; }
        if constexpr (FP8) asm volatile("s_nop 15\n\ts_nop 15" ::: "memory");
        if constexpr (!Epi::AFTER_DRAIN) { if constexpr (epi_pf<Epi>::value > 0) E.with_pf(acc, cur, wr, wc, fr, fq, (const LAS unsigned char*)(lds + PF_SIDE_OFF + (ui & 1) * PF_SIDE_BYTES)); else E(acc, cur, wr, wc, fr, fq);
#if defined(MK_EPI_TWICE)
            if constexpr (Epi::PROBE_TWICE) { asm volatile("" ::: "memory"); E(acc, cur, wr, wc, fr, fq); }
#endif
        }
        if (!has_next) break;
#pragma unroll
        for (int a = 0; a < 2; ++a)
#pragma unroll
            for (int b = 0; b < 2; ++b)
#pragma unroll
                for (int m = 0; m < 4; ++m)
#pragma unroll
                    for (int n = 0; n < 2; ++n) acc[a][b][m][n] = (f32x4){0.f, 0.f, 0.f, 0.f};
        cur = nxt; cA = nA; cB = nB; ++ui;
        if constexpr (GA) {
#pragma unroll
            for (int h = 0; h < 2; ++h)
#pragma unroll
                for (int i = 0; i < 2; ++i) gC[h][i] = gN[h][i]; }
        if constexpr (ALIGN_EPI) { if (wr == 1) PG8_BAR; }
    }
    PG8_WAIT_V(0);
    if constexpr (!ALIGN_EPI) { if (wr == 0) PG8_BAR; }
    PG8_BAR;
    if constexpr (Epi::AFTER_DRAIN) { E.fused(acc, cur, wr, wc, fr, fq, lds, wid, lane); PG8_BAR; }
#undef PG8_SA
#undef PG8_SB
#undef PG8_GLDS
#undef PG8_STAGE_A
#undef PG8_STAGE_B
#undef PG8_LDA
#undef PG8_LDB
#undef PG8_MMA
#undef PG8_WAIT_V
#undef PG8_WAIT_L
#undef PG8_BAR
#undef PG8_SCHED
}

template <class Epi, class Sched, bool ALIGN_EPI = true, bool FP8 = false>
__device__ __forceinline__ void gemm_phase(LAS unsigned char* lds, const int K, const int lda, const int ldb, const Sched& S, const Epi& E) {
#if MK_FAST_GEMM
    gemm_phase_fast<Epi, Sched, ALIGN_EPI, FP8>(lds, K, lda, ldb, S, E);
#else
    gemm_phase_ref<Epi, Sched, ALIGN_EPI>(lds, K, lda, ldb, S, E);
#endif
}
}

constexpr int NWAVES = 8;
constexpr int DM = 2048, SEQ = 8192, MTOK = 16384;
constexpr int EIN = 5120, FFN = 5632, EXD = 2816, NEXP = 8, OIN = 6144;
constexpr int ECAP = 16384;
constexpr int MOE_ROWS = 2 * MTOK + NEXP * 256;
constexpr float RMS_EPS = 1e-6f, GN_EPS = 1e-5f;

constexpr size_t MiB = 1u << 20;
constexpr size_t WS_CTL = 0, CTL_ZERO_BYTES = 2 * MiB;
constexpr size_t WS_MISC = 2 * MiB;
constexpr size_t WS_EWIN = 8 * MiB;
constexpr size_t WS_EWP = WS_EWIN + 40 * MiB;
constexpr size_t WS_EWOUT = WS_EWP + 1 * MiB;
constexpr size_t WS_OWIN = WS_EWOUT + 16 * MiB;
constexpr size_t WS_OWOUT = WS_OWIN + 48 * MiB;
constexpr size_t WS_FGU = WS_OWOUT + 16 * MiB;
constexpr size_t WS_FDN = WS_FGU + 88 * MiB;
constexpr size_t WS_MGU = WS_FDN + 44 * MiB;
constexpr size_t WS_MDN = WS_MGU + 352 * MiB;
constexpr size_t WS_HB = WS_MDN + 176 * MiB;
constexpr size_t WS_U = WS_HB + 64 * MiB;
constexpr size_t WS_QP = WS_U + 32 * MiB;
constexpr size_t WS_KN = WS_QP + 64 * MiB;
constexpr size_t WS_SG = WS_KN + 32 * MiB;
constexpr size_t WS_KT = WS_SG + 32 * MiB;
constexpr size_t WS_VS = WS_KT + 32 * MiB;
constexpr size_t WS_LT = WS_VS + 64 * MiB;
constexpr size_t WS_PP = WS_LT + 64 * MiB;
constexpr size_t WS_YCAT = WS_PP + 32 * MiB;
constexpr size_t WS_ACT = WS_YCAT + 64 * MiB;
constexpr size_t WS_BG = WS_ACT + 176 * MiB;
constexpr size_t WS_Z = WS_BG + 64 * MiB;
constexpr size_t WS_ACTM = WS_Z + 64 * MiB;
constexpr size_t WS_YC = WS_ACTM + 188 * MiB;
constexpr size_t WS_HB8 = WS_YC + 136 * MiB;
constexpr size_t WS_Y8 = WS_HB8 + 32 * MiB;
constexpr size_t WS_END = WS_Y8 + 32 * MiB;
static_assert((size_t)MOE_ROWS * EXD * 2 <= 188 * MiB && (size_t)MOE_ROWS * DM * 2 <= 136 * MiB, "moe buffers");
constexpr size_t MS_TOKE = 0, MS_TOKP = 128 * 1024, MS_ROWTOK = 256 * 1024, MS_ER = 768 * 1024, MS_EW = 1280 * 1024;
constexpr int CW_TMO = 0, CW_CODE = 1;
constexpr int CW_BAR = 4096;
constexpr int CW_CNT = 8192;
constexpr int CW_CONVQ = 16384;
constexpr int CW_SSQ = 65536;
static_assert((CW_SSQ + 2 * 9 * MTOK) * 4 <= (int)CTL_ZERO_BYTES, "CTL words inside the memset region");
typedef unsigned long long ssq_t;
constexpr float SSQ_SCALE = 1048576.f, SSQ_INV = 1.f / 1048576.f;

constexpr int RING_OFF = 0, RING_BYTES = 131072;
constexpr int LDSX_OFF = RING_BYTES;
constexpr int LDSCTL_OFF = RING_BYTES + 8192, MISC_OFF = LDSCTL_OFF + 320;
constexpr int LDS_BYTES = 147456;
static_assert(MISC_OFF + 128 <= LDS_BYTES, "LDS map");
static_assert(pg8::PF_SIDE_OFF == LDSX_OFF + 4096 && pg8::PF_SIDE_OFF + 2 * pg8::PF_SIDE_BYTES <= LDSCTL_OFF, "epilogue prefetch side area");

#define RLX_AGENT __ATOMIC_RELAXED, __HIP_MEMORY_SCOPE_AGENT
#define LDS_WAIT() asm volatile("s_waitcnt lgkmcnt(0)" ::: "memory")
#define VM_WAIT() asm volatile("s_waitcnt vmcnt(0)" ::: "memory")

#define XB_TMO      128
#define XB_XCNT(j)  (256  + 64 * (j))
#define XB_XSUB(j)  (1280 + 64 * (j))
#define XB_XGEN(j)  (2304 + 64 * (j))
#define XB_TOP      3328
#define XB_TOPGEN   3392
#define XCD_BAR_WORDS 3456
#define XB_SPIN_CAP (1u << 22)

__device__ __forceinline__ unsigned xb_ld(unsigned* p)              { return __hip_atomic_load(p, __ATOMIC_RELAXED, __HIP_MEMORY_SCOPE_AGENT); }
__device__ __forceinline__ unsigned xb_add(unsigned* p, unsigned v) { return __hip_atomic_fetch_add(p, v, __ATOMIC_RELAXED, __HIP_MEMORY_SCOPE_AGENT); }
__device__ __forceinline__ unsigned xb_xcc_id() { return (unsigned)__builtin_amdgcn_s_getreg((3 << 11) | 20) & 0xFu; }
#define XB_SPIN(cond, bar) do { unsigned _sp = 0; while (cond) { __builtin_amdgcn_s_sleep(1); \
    if ((++_sp & 255u) == 0u) { if (xb_ld(&(bar)[XB_TMO])) break; if (_sp > XB_SPIN_CAP) { atomicAdd(&(bar)[XB_TMO], 1u); break; } } } } while (0)

struct XcdBarrier { unsigned* bar; unsigned x; volatile LAS unsigned* st; };

__device__ __forceinline__ XcdBarrier xcd_barrier_post(unsigned* bar, volatile LAS unsigned* st) {
    XcdBarrier b; b.bar = bar; b.x = xb_xcc_id(); b.st = st;
    if (threadIdx.x == 0) (void)xb_add(&bar[XB_XCNT(b.x)], 1u);
    return b;
}
__device__ __forceinline__ void xcd_barrier_complete(unsigned* bar, unsigned x, unsigned& nloc, unsigned& nx) {
    const unsigned G = gridDim.x * gridDim.y * gridDim.z;
    unsigned sum, cnt, mine, sp = 0u;
    for (;;) {
        sum = 0u; cnt = 0u; mine = 0u;
#pragma unroll
        for (unsigned j = 0; j < 16; ++j) { const unsigned c = xb_ld(&bar[XB_XCNT(j)]); sum += c; cnt += (c > 0u) ? 1u : 0u; mine = (j == x) ? c : mine; }
        if (sum == G) break;
        __builtin_amdgcn_s_sleep(1);
        if ((++sp & 255u) == 0u) { if (xb_ld(&bar[XB_TMO])) break; if (sp > XB_SPIN_CAP) { atomicAdd(&bar[XB_TMO], 1u); break; } }
    }
    nloc = mine > 0u ? mine : 1u; nx = cnt > 0u ? cnt : 1u;
}
__device__ __forceinline__ void xcd_barrier(const XcdBarrier& b) {
    asm volatile("s_waitcnt vmcnt(0)" ::: "memory");
    __syncthreads();
    if (threadIdx.x == 0) {
        unsigned* bar = b.bar;
        __builtin_amdgcn_s_waitcnt(0);
        unsigned nloc = b.st[0], nx = b.st[1];
        if (nloc == 0u) { xcd_barrier_complete(bar, b.x, nloc, nx); b.st[0] = nloc; b.st[1] = nx; }
        const unsigned old = xb_add(&bar[XB_XSUB(b.x)], 1u);
        const unsigned gen = old / nloc;
        if (old + 1u == (gen + 1u) * nloc) {
            __builtin_amdgcn_fence(__ATOMIC_RELEASE, "agent");
            asm volatile("s_waitcnt vmcnt(0)" ::: "memory");
            const unsigned og = xb_add(&bar[XB_TOP], 1u);
            const unsigned tg = og / nx;
            if (og + 1u == (tg + 1u) * nx) xb_add(&bar[XB_TOPGEN], 1u);
            else XB_SPIN(xb_ld(&bar[XB_TOPGEN]) == tg, bar);
            __builtin_amdgcn_fence(__ATOMIC_ACQUIRE, "agent");
            xb_add(&bar[XB_XGEN(b.x)], 1u);
            asm volatile("s_waitcnt vmcnt(0)" ::: "memory");
        } else {
            XB_SPIN(xb_ld(&bar[XB_XGEN(b.x)]) == gen, bar);
            __builtin_amdgcn_fence(__ATOMIC_ACQUIRE, "agent");
            asm volatile("s_waitcnt vmcnt(0)" ::: "memory");
        }
    }
    __syncthreads();
}

__device__ __forceinline__ float wave_sum(float v) {
#pragma unroll
    for (int o = 1; o < 64; o <<= 1) v += __shfl_xor(v, o);
    return v;
}
__device__ __forceinline__ float silu_f(float x) { return x * __builtin_amdgcn_rcpf(1.f + __builtin_amdgcn_exp2f(-1.44269504f * x)); }
__device__ __forceinline__ f32x2 swiglu_pk(f32x2 a0, f32x2 a1, float r, float r3) {
    const f32x2 t = a0 * (r * -1.44269504f); f32x2 e; e.x = __builtin_amdgcn_exp2f(t.x); e.y = __builtin_amdgcn_exp2f(t.y);
    const float is = __builtin_amdgcn_rcpf(r * r3);
    const f32x2 d = e * is + is; f32x2 rc; rc.x = __builtin_amdgcn_rcpf(d.x); rc.y = __builtin_amdgcn_rcpf(d.y);
    return (a0 * a1) * rc;
}
__device__ __forceinline__ ssq_t ssq_fix(float q) { return (ssq_t)__float2ull_rn(q * SSQ_SCALE); }
template <class T> __device__ __forceinline__ GAS T* at32(const void* base, unsigned byte_off) { return (GAS T*)((GAS unsigned char*)base + byte_off); }
__device__ __forceinline__ float rs_from(unsigned long long v) { const float f = (float)(unsigned)(v >> 32) * 4294967296.f + (float)(unsigned)v;
    return __builtin_amdgcn_rsqf(f * (SSQ_INV / (float)DM) + RMS_EPS); }
__device__ __forceinline__ float rs_of(const ssq_t* ssq, int m) { return rs_from(*at32<const unsigned long long>(ssq, (unsigned)m * 8u)); }
__device__ __forceinline__ float lg_gamma(int h) { return h == 0 ? -0.04580368961312479f : (h == 1 ? -0.02272007650008353f : (h == 2 ? -0.011315313227834146f : -0.005646563141142063f)); }
__device__ __forceinline__ unsigned pk2(float lo, float hi) { return pg8::cvt_pk_bf16(lo, hi); }
#ifndef MK_F8_MASK
#define MK_F8_MASK 0x1cce
#endif
constexpr float W8_SCALE = 256.f, ACT8_SCALE = 8.f, GU8_UNSCALE = 1.f / 256.f, DN8_UNSCALE = 1.f / (256.f * 8.f);
__host__ __device__ constexpr bool f8_ffn(int lp) { return ((MK_F8_MASK) >> (2 * lp)) & 1; }
__host__ __device__ constexpr bool f8_moe(int lp) { return ((MK_F8_MASK) >> (2 * lp + 1)) & 1; }
__host__ __device__ constexpr bool f8_ein(int lp) { return ((MK_F8_MASK) >> (4 + 2 * lp)) & 1; }
__host__ __device__ constexpr bool f8_oin(int lp) { return ((MK_F8_MASK) >> (5 + 2 * lp)) & 1; }
__host__ __device__ constexpr bool f8_eout(int lp) { return ((MK_F8_MASK) >> (8 + 2 * lp)) & 1; }
__host__ __device__ constexpr bool f8_oout(int lp) { return ((MK_F8_MASK) >> (9 + 2 * lp)) & 1; }
__host__ __device__ constexpr bool f8_dn(int lp) { return f8_ffn(lp) || (((MK_F8_MASK) >> (12 + lp)) & 1); }
__device__ __forceinline__ float clamp8(float v) { return __builtin_amdgcn_fmed3f(v, -448.f, 448.f); }
__device__ __forceinline__ unsigned pk4_fp8(float a, float b, float c, float d) { int p = 0; p = __builtin_amdgcn_cvt_pk_fp8_f32(clamp8(a), clamp8(b), p, false); p = __builtin_amdgcn_cvt_pk_fp8_f32(clamp8(c), clamp8(d), p, true); return (unsigned)p; }
using pg8::bflo; using pg8::bfhi; using pg8::Unit;

struct EpiEvenIn {
    static constexpr bool PERM = true, AFTER_DRAIN = false, PROBE_TWICE = false;
    const ssq_t* ssq; bf16_t *U, *QP, *KN, *KT, *SG; float sc;
    static constexpr int PF_BYTES = 8;
    __device__ __forceinline__ const void* pf_src(const Unit& u) const { return ssq + u.pm * 256; }
    __device__ __forceinline__ void operator()(const f32x4 (&acc)[2][2][4][2], const Unit& u, int wr, int wc, int fr, int fq) const { run<false>(acc, u, wr, wc, fr, fq, nullptr); }
    __device__ __forceinline__ void with_pf(const f32x4 (&acc)[2][2][4][2], const Unit& u, int wr, int wc, int fr, int fq, const LAS unsigned char* sb) const { run<true>(acc, u, wr, wc, fr, fq, sb); }
    template <bool PFD> __device__ __forceinline__ void run(const f32x4 (&acc)[2][2][4][2], const Unit& u, int wr, int wc, int fr, int fq, const LAS unsigned char* sb) const {
        asm volatile("" : "+v"(fr), "+v"(fq));
        const int ct = u.pn, rl0 = wr * 64 + fr, row0 = u.pm * 256 + rl0, cl = wc * 32 + 8 * fq;
        if (ct < 4 || ct >= 16) {
            const bool isg = ct >= 16; bf16_t* O = isg ? SG : U; const int cb = (isg ? ct - 16 : ct) * 256;
#pragma unroll
            for (int ai = 0; ai < 2; ++ai)
#pragma unroll
                for (int m = 0; m < 4; ++m) { const int row = row0 + ai * 128 + m * 16; const float r = (PFD ? rs_from(*(const LAS unsigned long long*)(sb + (rl0 + ai * 128 + m * 16) * 8)) : rs_of(ssq, row)) * sc;
#pragma unroll
                    for (int bj = 0; bj < 2; ++bj) { f32x4 v0 = acc[ai][bj][m][0] * r, v1 = acc[ai][bj][m][1] * r;
                        if (isg) {
#pragma unroll
                            for (int j = 0; j < 4; ++j) { v0[j] = silu_f(v0[j]); v1[j] = silu_f(v1[j]); } }
                        u32x4 w; w.x = pk2(v0[0], v0[1]); w.y = pk2(v0[2], v0[3]); w.z = pk2(v1[0], v1[1]); w.w = pk2(v1[2], v1[3]);
                        *(GAS u32x4*)(O + (size_t)row * 1024 + cb + bj * 128 + cl) = w; } }
        } else {
            const bool isq = ct < 8; const int head = isq ? ct - 4 : ct - 8; const float lg = lg_gamma(head);
            float inv[2][4];
#pragma unroll
            for (int n = 0; n < 2; ++n)
#pragma unroll
                for (int j = 0; j < 4; ++j) inv[n][j] = __builtin_amdgcn_exp2f(-0.10381025296523007f * (float)(cl + 4 * n + j));
#pragma unroll
            for (int ai = 0; ai < 2; ++ai)
#pragma unroll
                for (int m = 0; m < 4; ++m) { const int rl = rl0 + ai * 128 + m * 16, row = u.pm * 256 + rl; const float r = (PFD ? rs_from(*(const LAS unsigned long long*)(sb + rl * 8)) : rs_of(ssq, row)) * (isq ? 0.0625f * sc : sc); const float pos = (float)(row & (SEQ - 1));
                    f32x4 o[2][2];
#pragma unroll
                    for (int n = 0; n < 2; ++n)
#pragma unroll
                        for (int j = 0; j < 4; ++j) { const float rev = pos * inv[n][j] * 0.15915494309189535f, fr_ = rev - __builtin_floorf(rev);
                            const float sn = __builtin_amdgcn_sinf(fr_), cs = __builtin_amdgcn_cosf(fr_); const float x1 = acc[ai][0][m][n][j] * r, x2 = acc[ai][1][m][n][j] * r;
                            o[0][n][j] = x1 * cs - x2 * sn; o[1][n][j] = x2 * cs + x1 * sn; }
#pragma unroll
                    for (int bj = 0; bj < 2; ++bj) { u32x4 w; w.x = pk2(o[bj][0][0], o[bj][0][1]); w.y = pk2(o[bj][0][2], o[bj][0][3]); w.z = pk2(o[bj][1][0], o[bj][1][1]); w.w = pk2(o[bj][1][2], o[bj][1][3]);
                        if (isq) *(GAS u32x4*)(QP + (size_t)row * 2048 + head * 512 + 256 + bj * 128 + cl) = w;
                        else *(GAS u32x4*)(KN + (size_t)row * 1024 + head * 256 + bj * 128 + cl) = w; }
                    if (!isq) {
                        const float kd = __builtin_amdgcn_exp2f(lg * (float)(255 - rl)); GAS bf16_t* kt = (GAS bf16_t*)KT + ((size_t)(u.pm * 4 + head) * 256) * 256 + rl;
#pragma unroll
                        for (int bj = 0; bj < 2; ++bj)
#pragma unroll
                            for (int n = 0; n < 2; ++n)
#pragma unroll
                                for (int j = 0; j < 4; ++j) kt[(size_t)(bj * 128 + cl + 4 * n + j) * 256] = (bf16_t)(pk2(o[bj][n][j] * kd, 0.f) & 0xffffu); }
                    __builtin_amdgcn_sched_barrier(0);
                }
        }
    }
};
struct EpiVt {
    static constexpr bool PERM = true, AFTER_DRAIN = false, PROBE_TWICE = false;
    const ssq_t* ssq; bf16_t* VS; float sc;
    static constexpr int PF_BYTES = 8;
    __device__ __forceinline__ const void* pf_src(const Unit& u) const { return ssq + u.pn * 256; }
    __device__ __forceinline__ void operator()(const f32x4 (&acc)[2][2][4][2], const Unit& u, int wr, int wc, int fr, int fq) const { run<false>(acc, u, wr, wc, fr, fq, nullptr); }
    __device__ __forceinline__ void with_pf(const f32x4 (&acc)[2][2][4][2], const Unit& u, int wr, int wc, int fr, int fq, const LAS unsigned char* sb) const { run<true>(acc, u, wr, wc, fr, fq, sb); }
    template <bool PFD> __device__ __forceinline__ void run(const f32x4 (&acc)[2][2][4][2], const Unit& u, int wr, int wc, int fr, int fq, const LAS unsigned char* sb) const {
        asm volatile("" : "+v"(fr), "+v"(fq));
        const int cl = wc * 32 + 8 * fq; bf16_t* base = VS + (size_t)(u.pn * 4 + u.pm) * 256 * 512;
        f32x4 rv[2][2];
#pragma unroll
        for (int bj = 0; bj < 2; ++bj)
#pragma unroll
            for (int n = 0; n < 2; ++n)
#pragma unroll
                for (int j = 0; j < 4; ++j) rv[bj][n][j] = (PFD ? rs_from(*(const LAS unsigned long long*)(sb + (bj * 128 + cl + 4 * n + j) * 8)) : rs_of(ssq, u.pn * 256 + bj * 128 + cl + 4 * n + j)) * sc;
#pragma unroll
        for (int ai = 0; ai < 2; ++ai)
#pragma unroll
            for (int m = 0; m < 4; ++m) { const int e = ai * 128 + wr * 64 + m * 16 + fr;
#pragma unroll
                for (int bj = 0; bj < 2; ++bj) { const f32x4 v0 = acc[ai][bj][m][0] * rv[bj][0], v1 = acc[ai][bj][m][1] * rv[bj][1];
                    u32x4 w; w.x = pk2(v0[0], v0[1]); w.y = pk2(v0[2], v0[3]); w.z = pk2(v1[0], v1[1]); w.w = pk2(v1[2], v1[3]);
                    *(GAS u32x4*)(base + (size_t)e * 512 + bj * 128 + cl) = w; } }
    }
};
struct EpiQK {
    static constexpr bool PERM = true, AFTER_DRAIN = false, PROBE_TWICE = false;
    bf16_t* QP;
    __device__ __forceinline__ void operator()(const f32x4 (&acc)[2][2][4][2], const Unit& u, int wr, int wc, int fr, int fq) const {
        asm volatile("" : "+v"(fr), "+v"(fq));
        const int cl = wc * 32 + 8 * fq; const float lg = lg_gamma(u.pn);
#pragma unroll
        for (int ai = 0; ai < 2; ++ai)
#pragma unroll
            for (int m = 0; m < 4; ++m) { const int i = ai * 128 + wr * 64 + m * 16 + fr, ci = i >> 6;
#pragma unroll
                for (int bj = 0; bj < 2; ++bj) { float o[2][4];
#pragma unroll
                    for (int n = 0; n < 2; ++n)
#pragma unroll
                        for (int j = 0; j < 4; ++j) { const int jc = bj * 128 + cl + 4 * n + j, cj = jc >> 6; const int ad = i > jc ? i - jc : jc - i;
                            const float ex = (cj == ci) ? (float)(ad - i - 1) : (float)(-jc - 1);
                            o[n][j] = (cj > ci) ? 0.f : acc[ai][bj][m][n][j] * __builtin_amdgcn_exp2f(lg * ex); }
                    u32x4 w; w.x = pk2(o[0][0], o[0][1]); w.y = pk2(o[0][2], o[0][3]); w.z = pk2(o[1][0], o[1][1]); w.w = pk2(o[1][2], o[1][3]);
                    *(GAS u32x4*)(QP + (size_t)(u.pm * 256 + i) * 2048 + u.pn * 512 + bj * 128 + cl) = w; __builtin_amdgcn_sched_barrier(0); } }
    }
};
struct EpiBf16Unit {
    static constexpr bool PERM = true, AFTER_DRAIN = false, PROBE_TWICE = false;
    bf16_t* C;
    __device__ __forceinline__ void operator()(const f32x4 (&acc)[2][2][4][2], const Unit& u, int wr, int wc, int fr, int fq) const {
        asm volatile("" : "+v"(fr), "+v"(fq));
        bf16_t* base = C + (size_t)(u.pm * 4 + u.pn) * 65536; const int cl = wc * 32 + 8 * fq;
#pragma unroll
        for (int ai = 0; ai < 2; ++ai)
#pragma unroll
            for (int m = 0; m < 4; ++m) { bf16_t* rowp = base + (size_t)(ai * 128 + wr * 64 + m * 16 + fr) * 256 + cl;
#pragma unroll
                for (int bj = 0; bj < 2; ++bj) { const f32x4 v0 = acc[ai][bj][m][0], v1 = acc[ai][bj][m][1];
                    u32x4 w; w.x = pk2(v0[0], v0[1]); w.y = pk2(v0[2], v0[3]); w.z = pk2(v1[0], v1[1]); w.w = pk2(v1[2], v1[3]);
                    *(GAS u32x4*)(rowp + bj * 128) = w; } }
    }
};
struct EpiBf16Plain {
    static constexpr bool PERM = true, AFTER_DRAIN = false, PROBE_TWICE = false;
    bf16_t* O; int ldc; unsigned char* O8;
    __device__ __forceinline__ void operator()(const f32x4 (&acc)[2][2][4][2], const Unit& u, int wr, int wc, int fr, int fq) const {
        asm volatile("" : "+v"(fr), "+v"(fq));
        const int cl = wc * 32 + 8 * fq;
#pragma unroll
        for (int ai = 0; ai < 2; ++ai)
#pragma unroll
            for (int m = 0; m < 4; ++m) { const size_t ro = (size_t)(u.pm * 256 + ai * 128 + wr * 64 + m * 16 + fr) * ldc + u.pn * 256 + cl; bf16_t* rowp = O + ro;
#pragma unroll
                for (int bj = 0; bj < 2; ++bj) { const f32x4 v0 = acc[ai][bj][m][0], v1 = acc[ai][bj][m][1];
                    u32x4 w; w.x = pk2(v0[0], v0[1]); w.y = pk2(v0[2], v0[3]); w.z = pk2(v1[0], v1[1]); w.w = pk2(v1[2], v1[3]);
                    if (!O8) *(GAS u32x4*)(rowp + bj * 128) = w;
                    if (O8) { u32x2 w8; w8.x = pk4_fp8(v0[0], v0[1], v0[2], v0[3]); w8.y = pk4_fp8(v1[0], v1[1], v1[2], v1[3]); *(GAS u32x2*)(O8 + ro + bj * 128) = w8; } } }
    }
};
struct EpiRetOut {
    static constexpr bool PERM = true, AFTER_DRAIN = true, PROBE_TWICE = false;
    const bf16_t* SG; bf16_t* YCAT; unsigned char* Y8;
    __device__ __forceinline__ void fused(f32x4 (&acc)[2][2][4][2], const Unit& u, int wr, int wc, int fr, int fq, LAS unsigned char* lds, int wid, int lane) const {
        asm volatile("" : "+v"(fr), "+v"(fq));
        LAS f32x2* P = (LAS f32x2*)lds;
        const int cl = wc * 32 + 8 * fq; const float lg = lg_gamma(u.pn);
#pragma unroll
        for (int ai = 0; ai < 2; ++ai)
#pragma unroll
            for (int m = 0; m < 4; ++m) { const int i = ai * 128 + wr * 64 + m * 16 + fr; const float sc = __builtin_amdgcn_exp2f(lg * (float)(i + 1)); float s = 0.f, q = 0.f;
#pragma unroll
                for (int bj = 0; bj < 2; ++bj)
#pragma unroll
                    for (int n = 0; n < 2; ++n) { f32x4 x = acc[ai][bj][m][n] * sc; acc[ai][bj][m][n] = x; s += (x[0] + x[1]) + (x[2] + x[3]); q += (x[0] * x[0] + x[1] * x[1]) + (x[2] * x[2] + x[3] * x[3]); }
                s += __shfl_xor(s, 16); s += __shfl_xor(s, 32); q += __shfl_xor(q, 16); q += __shfl_xor(q, 32);
                if (fq == 0) P[i * 4 + wc] = (f32x2){s, q}; }
        asm volatile("s_waitcnt lgkmcnt(0)" ::: "memory"); __builtin_amdgcn_s_barrier(); asm volatile("" ::: "memory");
#pragma unroll
        for (int ai = 0; ai < 2; ++ai)
#pragma unroll
            for (int m = 0; m < 4; ++m) { const int i = ai * 128 + wr * 64 + m * 16 + fr, row = u.pm * 256 + i;
                const f32x2 p0 = P[i * 4 + 0], p1 = P[i * 4 + 1], p2 = P[i * 4 + 2], p3 = P[i * 4 + 3];
                const float mu = ((p0.x + p1.x) + (p2.x + p3.x)) * (1.f / 256.f); float var = ((p0.y + p1.y) + (p2.y + p3.y)) * (1.f / 256.f) - mu * mu; var = var > 0.f ? var : 0.f;
                const float rstd = __builtin_amdgcn_rsqf(var + GN_EPS);
#pragma unroll
                for (int bj = 0; bj < 2; ++bj) { const u32x4 g = *(const GAS u32x4*)(SG + (size_t)row * 1024 + u.pn * 256 + bj * 128 + cl);
                    const f32x4 x0 = (acc[ai][bj][m][0] - mu) * rstd, x1 = (acc[ai][bj][m][1] - mu) * rstd;
                    const float y0 = x0[0] * bflo(g.x), y1 = x0[1] * bfhi(g.x), y2 = x0[2] * bflo(g.y), y3 = x0[3] * bfhi(g.y), y4 = x1[0] * bflo(g.z), y5 = x1[1] * bfhi(g.z), y6 = x1[2] * bflo(g.w), y7 = x1[3] * bfhi(g.w);
                    u32x4 w; w.x = pk2(y0, y1); w.y = pk2(y2, y3); w.z = pk2(y4, y5); w.w = pk2(y6, y7);
                    if (!Y8) *(GAS u32x4*)(YCAT + (size_t)row * 2048 + 1024 + u.pn * 256 + bj * 128 + cl) = w;
                    if (Y8) { u32x2 w8; w8.x = pk4_fp8(y0, y1, y2, y3); w8.y = pk4_fp8(y4, y5, y6, y7); *(GAS u32x2*)(Y8 + (size_t)row * 2048 + 1024 + u.pn * 256 + bj * 128 + cl) = w8; } } __builtin_amdgcn_sched_barrier(0); }
    }
};
template <bool F8OUT> struct EpiResidual {
    static constexpr bool PERM = true, AFTER_DRAIN = false, PROBE_TWICE = false;
    const bf16_t* res_in; bf16_t* HB; ssq_t* ssq_out; float sc; unsigned char* HB8;
    __device__ __forceinline__ void operator()(const f32x4 (&acc)[2][2][4][2], const Unit& u, int wr, int wc, int fr, int fq) const {
        asm volatile("" : "+v"(fr), "+v"(fq));
        const int c0 = u.pn * 256 + wc * 32 + 8 * fq;
#pragma unroll
        for (int ai = 0; ai < 2; ++ai)
#pragma unroll
            for (int m = 0; m < 4; ++m) { const int row = u.pm * 256 + ai * 128 + wr * 64 + m * 16 + fr; const unsigned off = (unsigned)row * (unsigned)DM + (unsigned)c0; float q = 0.f;
#pragma unroll
                for (int bj = 0; bj < 2; ++bj) { const u32x4 h = *at32<const u32x4>(res_in, (off + bj * 128) * 2u); const f32x4 a0 = acc[ai][bj][m][0] * sc, a1 = acc[ai][bj][m][1] * sc;
                    const float x0 = bflo(h.x) + a0[0], x1 = bfhi(h.x) + a0[1], x2 = bflo(h.y) + a0[2], x3 = bfhi(h.y) + a0[3], x4 = bflo(h.z) + a1[0], x5 = bfhi(h.z) + a1[1], x6 = bflo(h.w) + a1[2], x7 = bfhi(h.w) + a1[3];
                    u32x4 w; w.x = pk2(x0, x1); w.y = pk2(x2, x3); w.z = pk2(x4, x5); w.w = pk2(x6, x7); *at32<u32x4>(HB, (off + bj * 128) * 2u) = w;
                    if constexpr (F8OUT) { u32x2 w8; w8.x = pk4_fp8(x0, x1, x2, x3); w8.y = pk4_fp8(x4, x5, x6, x7); *at32<u32x2>(HB8, off + bj * 128) = w8; }
                    q += ((x0 * x0 + x1 * x1) + (x2 * x2 + x3 * x3)) + ((x4 * x4 + x5 * x5) + (x6 * x6 + x7 * x7)); }
                q += __shfl_xor(q, 16); q += __shfl_xor(q, 32);
                if (fq == 0) __hip_atomic_fetch_add((GAS ssq_t*)ssq_out + row, ssq_fix(q), RLX_AGENT); }
    }
};
template <bool F8, bool F8OUT = F8> struct EpiSwiGLU {
    static constexpr bool PERM = true, AFTER_DRAIN = false, PROBE_TWICE = true;
    const ssq_t* ssq; void* ACT; int ldc;
    static constexpr int PF_BYTES = 8;
    __device__ __forceinline__ const void* pf_src(const Unit& u) const { return ssq + u.pm * 256; }
    __device__ __forceinline__ void operator()(const f32x4 (&acc)[2][2][4][2], const Unit& u, int wr, int wc, int fr, int fq) const { run<false>(acc, u, wr, wc, fr, fq, nullptr); }
    __device__ __forceinline__ void with_pf(const f32x4 (&acc)[2][2][4][2], const Unit& u, int wr, int wc, int fr, int fq, const LAS unsigned char* sb) const { run<true>(acc, u, wr, wc, fr, fq, sb); }
    template <bool PFD> __device__ __forceinline__ void run(const f32x4 (&acc)[2][2][4][2], const Unit& u, int wr, int wc, int fr, int fq, const LAS unsigned char* sb) const {
        asm volatile("" : "+v"(fr), "+v"(fq));
        const int cl = wc * 32 + 8 * fq;
#pragma unroll
        for (int ai = 0; ai < 2; ++ai)
#pragma unroll
            for (int m = 0; m < 4; ++m) { const int rl = ai * 128 + wr * 64 + m * 16 + fr, row = u.pm * 256 + rl; const float r = (PFD ? rs_from(*(const LAS unsigned long long*)(sb + rl * 8)) : rs_of(ssq, row)) * (F8 ? GU8_UNSCALE : 1.f); float o[2][4];
#pragma unroll
                for (int n = 0; n < 2; ++n)
#pragma unroll
                    for (int j = 0; j < 4; j += 2) { const f32x2 v = swiglu_pk((f32x2){acc[ai][0][m][n][j], acc[ai][0][m][n][j + 1]}, (f32x2){acc[ai][1][m][n][j], acc[ai][1][m][n][j + 1]}, r, F8OUT ? r * ACT8_SCALE : r); o[n][j] = v.x; o[n][j + 1] = v.y; }
                if constexpr (F8OUT) { u32x2 w; w.x = pk4_fp8(o[0][0], o[0][1], o[0][2], o[0][3]); w.y = pk4_fp8(o[1][0], o[1][1], o[1][2], o[1][3]); *at32<u32x2>(ACT, (unsigned)row * (unsigned)ldc + (unsigned)(u.pn * 128 + cl)) = w; }
                else { u32x4 w; w.x = pk2(o[0][0], o[0][1]); w.y = pk2(o[0][2], o[0][3]); w.z = pk2(o[1][0], o[1][1]); w.w = pk2(o[1][2], o[1][3]); *at32<u32x4>(ACT, ((unsigned)row * (unsigned)ldc + (unsigned)(u.pn * 128 + cl)) * 2u) = w; } }
    }
};
struct EpiOddIn {
    static constexpr bool PERM = true, AFTER_DRAIN = false, PROBE_TWICE = false;
    const ssq_t* ssq; bf16_t *BG, *Z; float sc;
    static constexpr int PF_BYTES = 8;
    __device__ __forceinline__ const void* pf_src(const Unit& u) const { return ssq + u.pm * 256; }
    __device__ __forceinline__ void operator()(const f32x4 (&acc)[2][2][4][2], const Unit& u, int wr, int wc, int fr, int fq) const { run<false>(acc, u, wr, wc, fr, fq, nullptr); }
    __device__ __forceinline__ void with_pf(const f32x4 (&acc)[2][2][4][2], const Unit& u, int wr, int wc, int fr, int fq, const LAS unsigned char* sb) const { run<true>(acc, u, wr, wc, fr, fq, sb); }
    template <bool PFD> __device__ __forceinline__ void run(const f32x4 (&acc)[2][2][4][2], const Unit& u, int wr, int wc, int fr, int fq, const LAS unsigned char* sb) const {
        asm volatile("" : "+v"(fr), "+v"(fq));
        const int cl = wc * 32 + 8 * fq;
#pragma unroll
        for (int ai = 0; ai < 2; ++ai)
#pragma unroll
            for (int m = 0; m < 4; ++m) { const int rl = ai * 128 + wr * 64 + m * 16 + fr, row = u.pm * 256 + rl; const float r = (PFD ? rs_from(*(const LAS unsigned long long*)(sb + rl * 8)) : rs_of(ssq, row)) * sc;
                if (u.pn < 8) {
#pragma unroll
                    for (int bj = 0; bj < 2; ++bj) { const f32x4 v0 = acc[ai][bj][m][0] * r, v1 = acc[ai][bj][m][1] * r;
                        u32x4 w; w.x = pk2(v0[0], v0[1]); w.y = pk2(v0[2], v0[3]); w.z = pk2(v1[0], v1[1]); w.w = pk2(v1[2], v1[3]);
                        *at32<u32x4>(BG, ((unsigned)row * (unsigned)DM + (unsigned)(u.pn * 256 + bj * 128 + cl)) * 2u) = w; }
                } else { const float r2 = r * r; const f32x4 v0 = acc[ai][0][m][0] * acc[ai][1][m][0] * r2, v1 = acc[ai][0][m][1] * acc[ai][1][m][1] * r2;
                    u32x4 w; w.x = pk2(v0[0], v0[1]); w.y = pk2(v0[2], v0[3]); w.z = pk2(v1[0], v1[1]); w.w = pk2(v1[2], v1[3]);
                    *at32<u32x4>(Z, ((unsigned)row * (unsigned)DM + (unsigned)((u.pn - 8) * 128 + cl)) * 2u) = w; } }
    }
};

__device__ __forceinline__ unsigned load_counts8(const unsigned* cntw) {
    const int l = (int)__builtin_amdgcn_mbcnt_hi(~0u, __builtin_amdgcn_mbcnt_lo(~0u, 0u)); unsigned v = 0u;
    if (l < NEXP) v = __hip_atomic_load(cntw + 64 * l, RLX_AGENT);
    return v;
}
template <bool GATHER_> struct MoeOrder {
    static constexpr bool GATHER = GATHER_;
    int tp[NEXP + 1], cnt[NEXP]; int nN, G, c; const char *A0, *B0; long a_rt, b_e, b_sn; const int* rowtok; unsigned row_bytes;
    __device__ __forceinline__ void init(const unsigned* cntw, int nN_, int G_, int c_) { nN = nN_; G = G_; c = c_; tp[0] = 0;
        const unsigned cv = load_counts8(cntw);
#pragma unroll
        for (int e = 0; e < NEXP; ++e) { int v = (int)__builtin_amdgcn_readlane(cv, e); v = v < 0 ? 0 : (v > ECAP ? ECAP : v); cnt[e] = v; tp[e + 1] = tp[e] + ((v + 255) >> 8); } }
    __device__ __forceinline__ bool next(int i, Unit& u) const {
        const long L = (long)i * G + c; const int nM = tp[NEXP]; if (L >= (long)nM * nN) return false;
        int rt, pn; pg8::tile_of((int)L, nM, nN, rt, pn); int e = 0;
#pragma unroll
        for (int k = 1; k < NEXP; ++k) e = (rt >= tp[k]) ? k : e;
        int ce = cnt[0], te = tp[0];
#pragma unroll
        for (int k = 1; k < NEXP; ++k) { ce = (e == k) ? cnt[k] : ce; te = (e == k) ? tp[k] : te; }
        u.pm = rt; u.pn = pn; u.x0 = e; u.x1 = (rt - te) * 256; u.x2 = ce;
        u.a = A0 + (GATHER_ ? 0 : (long)rt * a_rt); u.b = B0 + e * b_e + pn * b_sn; return true;
    }
    __device__ __forceinline__ unsigned goff(const Unit& u, int r) const {
        const int ep = u.x1 + r; const int tok = (ep < u.x2) ? ((const GAS int*)rowtok)[u.x0 * ECAP + ep] : 0; return (unsigned)tok * row_bytes;
    }
};
template <bool F8> struct EpiMoeGU {
    static constexpr bool PERM = true, AFTER_DRAIN = false, PROBE_TWICE = true;
    const float* er; void* ACTM;
    static constexpr int PF_BYTES = 4;
    __device__ __forceinline__ const void* pf_src(const Unit& u) const { return er + u.x0 * ECAP + u.x1; }
    __device__ __forceinline__ void operator()(const f32x4 (&acc)[2][2][4][2], const Unit& u, int wr, int wc, int fr, int fq) const { run<false>(acc, u, wr, wc, fr, fq, nullptr); }
    __device__ __forceinline__ void with_pf(const f32x4 (&acc)[2][2][4][2], const Unit& u, int wr, int wc, int fr, int fq, const LAS unsigned char* sb) const { run<true>(acc, u, wr, wc, fr, fq, sb); }
    template <bool PFD> __device__ __forceinline__ void run(const f32x4 (&acc)[2][2][4][2], const Unit& u, int wr, int wc, int fr, int fq, const LAS unsigned char* sb) const {
        asm volatile("" : "+v"(fr), "+v"(fq));
        const int cl = wc * 32 + 8 * fq;
#pragma unroll
        for (int ai = 0; ai < 2; ++ai)
#pragma unroll
            for (int m = 0; m < 4; ++m) { const int i = ai * 128 + wr * 64 + m * 16 + fr, ep = u.x1 + i; const float r = ((ep < u.x2) ? (PFD ? *(const LAS float*)(sb + i * 4) : ((const GAS float*)er)[u.x0 * ECAP + ep]) : 0.f) * (F8 ? GU8_UNSCALE : 1.f); float o[2][4];
#pragma unroll
                for (int n = 0; n < 2; ++n)
#pragma unroll
                    for (int j = 0; j < 4; j += 2) { const f32x2 v = swiglu_pk((f32x2){acc[ai][0][m][n][j], acc[ai][0][m][n][j + 1]}, (f32x2){acc[ai][1][m][n][j], acc[ai][1][m][n][j + 1]}, r, F8 ? r * ACT8_SCALE : r); o[n][j] = v.x; o[n][j + 1] = v.y; }
                if constexpr (F8) { u32x2 w; w.x = pk4_fp8(o[0][0], o[0][1], o[0][2], o[0][3]); w.y = pk4_fp8(o[1][0], o[1][1], o[1][2], o[1][3]); *at32<u32x2>(ACTM, (unsigned)(u.pm * 256 + i) * (unsigned)EXD + (unsigned)(u.pn * 128 + cl)) = w; }
                else { u32x4 w; w.x = pk2(o[0][0], o[0][1]); w.y = pk2(o[0][2], o[0][3]); w.z = pk2(o[1][0], o[1][1]); w.w = pk2(o[1][2], o[1][3]); *at32<u32x4>(ACTM, ((unsigned)(u.pm * 256 + i) * (unsigned)EXD + (unsigned)(u.pn * 128 + cl)) * 2u) = w; } }
    }
};
struct EpiMoeDown {
    static constexpr bool PERM = true, AFTER_DRAIN = false, PROBE_TWICE = false;
    const float* ew; bf16_t* YC; float sc;
    static constexpr int PF_BYTES = 4;
    __device__ __forceinline__ const void* pf_src(const Unit& u) const { return ew + u.x0 * ECAP + u.x1; }
    __device__ __forceinline__ void operator()(const f32x4 (&acc)[2][2][4][2], const Unit& u, int wr, int wc, int fr, int fq) const { run<false>(acc, u, wr, wc, fr, fq, nullptr); }
    __device__ __forceinline__ void with_pf(const f32x4 (&acc)[2][2][4][2], const Unit& u, int wr, int wc, int fr, int fq, const LAS unsigned char* sb) const { run<true>(acc, u, wr, wc, fr, fq, sb); }
    template <bool PFD> __device__ __forceinline__ void run(const f32x4 (&acc)[2][2][4][2], const Unit& u, int wr, int wc, int fr, int fq, const LAS unsigned char* sb) const {
        asm volatile("" : "+v"(fr), "+v"(fq));
        const int cl = wc * 32 + 8 * fq;
#pragma unroll
        for (int ai = 0; ai < 2; ++ai)
#pragma unroll
            for (int m = 0; m < 4; ++m) { const int i = ai * 128 + wr * 64 + m * 16 + fr, ep = u.x1 + i; const float wt = ((ep < u.x2) ? (PFD ? *(const LAS float*)(sb + i * 4) : ((const GAS float*)ew)[u.x0 * ECAP + ep]) : 0.f) * sc;
#pragma unroll
                for (int bj = 0; bj < 2; ++bj) { const f32x4 v0 = acc[ai][bj][m][0] * wt, v1 = acc[ai][bj][m][1] * wt;
                    u32x4 w; w.x = pk2(v0[0], v0[1]); w.y = pk2(v0[2], v0[3]); w.z = pk2(v1[0], v1[1]); w.w = pk2(v1[2], v1[3]);
                    *at32<u32x4>(YC, ((unsigned)(u.pm * 256 + i) * (unsigned)DM + (unsigned)(u.pn * 256 + bj * 128 + cl)) * 2u) = w; } }
    }
};

struct Frame {
    LAS unsigned char* lds;
    volatile LAS unsigned* MISC;
    gu32* ctl;
    int tid, lane, wave, G, bid;
    unsigned char* ws;
    const float* const* in;
};
template <class T> __device__ __forceinline__ T* wsp(const Frame& F, size_t off) { return (T*)(F.ws + off); }

__device__ __forceinline__ int conv_src_col(int mode, int N, int n) {
    if (mode == 0) return n;
    if (mode == 1) { const int t = n >> 8, w = n & 255; return (w < 128) ? t * 128 + w : (N >> 1) + t * 128 + (w - 128); }
    if (n < 2048) return n;
    const int np = n - 2048, t = np >> 8, w = np & 255; return 2048 + ((w < 128) ? t * 128 + w : 2048 + t * 128 + (w - 128));
}
struct ConvJob { const float* W; bf16_t* WT; const float* gain; const float* scale; int K, N, mode, start; };
constexpr int N_CONV_JOBS = 52;
#ifndef MK_CV_SH
#define MK_CV_SH 1
#endif
constexpr int CV_SH = MK_CV_SH;
#ifndef MK_STEAL_N
#define MK_STEAL_N 0
#endif
__device__ __forceinline__ ConvJob conv_job_desc(const Frame& F, int j, int& deadline) {
    const int i = j / 26, q = j % 26; const int pb = 1 + 14 * i;
    int r, d;
    if (q == 0) { r = 0; d = 0; } else if (q < 5) { r = q; d = 2; } else if (q == 5) { r = 5; d = 4; } else if (q == 6) { r = 8; d = 5; } else if (q == 7) { r = 9; d = 6; }
    else if (q == 8) { r = 6; d = 7; } else if (q == 9) { r = 7; d = 9; } else if (q < 18) { r = q; d = 11; } else { r = q; d = 12; }
    deadline = pb + d;
    ConvJob J; J.gain = nullptr; J.scale = nullptr; J.mode = 0; J.start = 0;
    if (r == 0) { J.W = F.in[4] + (size_t)i * DM * EIN; J.K = DM; J.N = EIN; J.WT = wsp<bf16_t>(F, WS_EWIN) + (size_t)i * EIN * DM; J.gain = F.in[1] + (2 * i) * DM; J.mode = f8_ein(i) ? 256 : 0; }
    else if (r < 5) { const int g = r - 1; J.W = F.in[5] + (size_t)(i * 4 + g) * 65536; J.K = 256; J.N = 256; J.WT = wsp<bf16_t>(F, WS_EWP) + (size_t)(i * 4 + g) * 65536; J.scale = F.in[6] + i * 1024 + g * 256; }
    else if (r == 5) { J.W = F.in[7] + (size_t)i * DM * DM; J.K = DM; J.N = DM; J.WT = wsp<bf16_t>(F, WS_EWOUT) + (size_t)i * DM * DM; J.mode = f8_eout(i) ? 256 : 0; }
    else if (r == 6) { J.W = F.in[8] + (size_t)i * DM * OIN; J.K = DM; J.N = OIN; J.WT = wsp<bf16_t>(F, WS_OWIN) + (size_t)i * OIN * DM; J.gain = F.in[1] + (2 * i + 1) * DM; J.mode = 2 | (f8_oin(i) ? 256 : 0); }
    else if (r == 7) { J.W = F.in[10] + (size_t)i * DM * DM; J.K = DM; J.N = DM; J.WT = wsp<bf16_t>(F, WS_OWOUT) + (size_t)i * DM * DM; J.mode = f8_oout(i) ? 256 : 0; }
    else if (r == 8) { J.W = F.in[11] + (size_t)i * DM * 2 * FFN; J.K = DM; J.N = 2 * FFN; J.WT = wsp<bf16_t>(F, WS_FGU) + (size_t)i * 2 * FFN * DM; J.gain = F.in[2] + (2 * i) * DM; J.mode = 1 | (f8_ffn(i) ? 256 : 0); }
    else if (r == 9) { J.W = F.in[12] + (size_t)i * FFN * DM; J.K = FFN; J.N = DM; J.WT = wsp<bf16_t>(F, WS_FDN) + (size_t)i * DM * FFN; J.mode = f8_dn(i) ? 256 : 0; }
    else if (r < 18) { const int e = r - 10; J.W = F.in[14] + (size_t)(i * NEXP + e) * DM * 2 * EXD; J.K = DM; J.N = 2 * EXD; J.WT = wsp<bf16_t>(F, WS_MGU) + (size_t)(i * NEXP + e) * 2 * EXD * DM; J.gain = F.in[2] + (2 * i + 1) * DM; J.mode = 1 | (f8_moe(i) ? 256 : 0); }
    else { const int e = r - 18; J.W = F.in[15] + (size_t)(i * NEXP + e) * EXD * DM; J.K = EXD; J.N = DM; J.WT = wsp<bf16_t>(F, WS_MDN) + (size_t)(i * NEXP + e) * DM * EXD; J.mode = f8_moe(i) ? 256 : 0; }
    return J;
}
constexpr int CV_JP = 0, CV_JI = 1664, CV_JD = 2496, CV_ST = 2704, CV_GT = 2816, CV_MAXG = 24;
#define CV_PTRS(F_) LAS unsigned long long* jp = (LAS unsigned long long*)((F_).lds + LDSX_OFF + CV_JP); LAS int* ji = (LAS int*)((F_).lds + LDSX_OFF + CV_JI); LAS int* jd = (LAS int*)((F_).lds + LDSX_OFF + CV_JD); LAS int* st = (LAS int*)((F_).lds + LDSX_OFF + CV_ST); \
    LAS int* gst = (LAS int*)((F_).lds + LDSX_OFF + CV_GT); LAS int* gdl = gst + CV_MAXG + 1; (void)jp; (void)ji; (void)jd; (void)st; (void)gst; (void)gdl
__device__ __forceinline__ void conv_init(const Frame& F) {
    CV_PTRS(F);
    if (F.tid < N_CONV_JOBS) { int dl; const ConvJob J = conv_job_desc(F, F.tid, dl); const int j = F.tid;
        jp[j * 4 + 0] = (unsigned long long)J.W; jp[j * 4 + 1] = (unsigned long long)J.WT; jp[j * 4 + 2] = (unsigned long long)J.gain; jp[j * 4 + 3] = (unsigned long long)J.scale;
        ji[j * 4 + 0] = J.K; ji[j * 4 + 1] = J.N; ji[j * 4 + 2] = J.mode; ji[j * 4 + 3] = 0; jd[j] = dl; }
    __syncthreads();
    if (F.tid == 0) { int acc = 0, ng = 0;
        for (int j = 0; j < N_CONV_JOBS; ++j) { if (j == 0 || jd[j] != jd[j - 1]) { gst[ng] = acc; gdl[ng] = jd[j]; ++ng; } ji[j * 4 + 3] = acc; acc += (ji[j * 4 + 0] >> 7) * (ji[j * 4 + 1] >> 7); }
        gst[ng] = acc; st[0] = acc; st[2] = 0; st[3] = 0; st[5] = (F.bid < gst[1]) ? F.bid : -1; st[6] = (F.bid < gst[1]) ? 0 : 1; st[7] = ng; st[8] = -1; st[9] = -1; }
    __syncthreads();
}
__device__ __forceinline__ unsigned* conv_qhead(const Frame& F, int gi) { return (unsigned*)(F.ctl + CW_CONVQ + (gi * 8 + (F.bid & (CV_SH - 1))) * 32); }
__device__ __forceinline__ int conv_claim_finish(const Frame& F, unsigned l) {
    CV_PTRS(F);
    int cg = st[6]; const int ng = st[7], sh = F.bid & (CV_SH - 1); int res = -1;
    while (cg < ng) {
        const int r = (int)((l + (cg == 0 ? (unsigned)(F.G / CV_SH) : 0u)) * (unsigned)CV_SH) + sh;
        if (r < gst[cg + 1] - gst[cg]) { res = gst[cg] + r; break; }
        if (++cg < ng) l = xb_add(conv_qhead(F, cg), 1u);
    }
    st[6] = cg; return res;
}
struct ConvRegs { f32x4 v[8]; f32x4 sn; float gk[8]; bf16_t* WT; int K, kb, n0, f8; };
__device__ __forceinline__ void conv_load(const Frame& F, int g, int j, ConvRegs& R) {
    CV_PTRS(F);
    const float* W = (const float*)jp[j * 4 + 0]; const float* gain = (const float*)jp[j * 4 + 2]; const float* scale = (const float*)jp[j * 4 + 3];
    const int N = ji[j * 4 + 1], mode = ji[j * 4 + 2], it = g - ji[j * 4 + 3], nblk = N >> 7;
    R.WT = (bf16_t*)jp[j * 4 + 1]; R.K = ji[j * 4 + 0]; R.kb = it / nblk; R.n0 = (it % nblk) << 7; R.f8 = (mode >> 8) & 1;
    const int sc = conv_src_col(mode & 255, N, R.n0 + 4 * (F.lane & 31)), k0 = R.kb * 128 + F.wave * 16 + 8 * (F.lane >> 5);
#pragma unroll
    for (int r = 0; r < 8; ++r) R.v[r] = *(const GAS f32x4*)(W + (size_t)(k0 + r) * N + sc);
    R.sn = scale ? *(const GAS f32x4*)(scale + sc) : (f32x4){1.f, 1.f, 1.f, 1.f};
#pragma unroll
    for (int r = 0; r < 8; ++r) R.gk[r] = gain ? ((const GAS float*)gain)[k0 + r] : 1.f;
}
__device__ __forceinline__ void conv_pack(const Frame& F, const ConvRegs& R, LAS unsigned* tile) {
    const int nl = 4 * (F.lane & 31), kl = F.wave * 16 + 8 * (F.lane >> 5);
    if (R.f8) {
#pragma unroll
        for (int hh = 0; hh < 2; ++hh)
#pragma unroll
            for (int q = 0; q < 4; ++q) { const float s_ = R.sn[q] * W8_SCALE;
                tile[(nl + q) * 33 + (kl >> 2) + hh] = pk4_fp8(R.v[4 * hh][q] * (R.gk[4 * hh] * s_), R.v[4 * hh + 1][q] * (R.gk[4 * hh + 1] * s_), R.v[4 * hh + 2][q] * (R.gk[4 * hh + 2] * s_), R.v[4 * hh + 3][q] * (R.gk[4 * hh + 3] * s_)); }
    } else {
#pragma unroll
        for (int rp = 0; rp < 4; ++rp)
#pragma unroll
            for (int q = 0; q < 4; ++q) tile[(nl + q) * 65 + (kl >> 1) + rp] = pk2(R.v[2 * rp][q] * (R.gk[2 * rp] * R.sn[q]), R.v[2 * rp + 1][q] * (R.gk[2 * rp + 1] * R.sn[q]));
    }
}
__device__ __forceinline__ void conv_store(const Frame& F, const LAS unsigned* tile, bf16_t* WT, int K, int kb, int n0, int f8) {
    if (f8) {
#pragma unroll
        for (int p = 0; p < 2; ++p) { const int row = p * 64 + (F.tid >> 3), c = F.tid & 7; const LAS unsigned* s = tile + row * 33 + 4 * c;
            u32x4 o; o.x = s[0]; o.y = s[1]; o.z = s[2]; o.w = s[3];
            *(GAS u32x4*)((unsigned char*)WT + (size_t)(n0 + row) * K + kb * 128 + 16 * c) = o; }
    } else {
#pragma unroll
        for (int p = 0; p < 4; ++p) { const int row = p * 32 + (F.tid >> 4), c = F.tid & 15; const LAS unsigned* s = tile + row * 65 + 4 * c;
            u32x4 o; o.x = s[0]; o.y = s[1]; o.z = s[2]; o.w = s[3];
            *(GAS u32x4*)(WT + (size_t)(n0 + row) * K + kb * 128 + 8 * c) = o; }
    }
}
__device__ __forceinline__ int conv_run(const Frame& F0, int max_phase, int extra) {
    Frame F = F0; { int t_ = threadIdx.x; asm volatile("" : "+v"(t_)); F.tid = t_; F.lane = t_ & 63; F.wave = __builtin_amdgcn_readfirstlane(t_ >> 6); }
    CV_PTRS(F);
    __syncthreads();
    int g = st[5], j = st[2], par = st[3], slot = 0, n = 0; const bool t0 = (F.tid == 0);
#define CV_ELIGIBLE(g_) ({ bool ok_ = false; if ((g_) >= 0) { while ((g_) >= ji[j * 4 + 3] + (ji[j * 4 + 0] >> 7) * (ji[j * 4 + 1] >> 7)) ++j; ok_ = jd[j] <= max_phase; if (!ok_ && extra > 0) { --extra; ok_ = true; } } ok_; })
    ConvRegs R; unsigned cl = 0u;
    bool have = CV_ELIGIBLE(g);
    if (have) { if (t0 && st[6] < st[7]) cl = xb_add(conv_qhead(F, st[6]), 1u); conv_load(F, g, j, R); if (t0) st[8] = conv_claim_finish(F, cl); }
    while (have) {
        LAS unsigned* tile = (LAS unsigned*)(F.lds + RING_OFF) + par * (128 * 65);
        conv_pack(F, R, tile);
        bf16_t* const WTc = R.WT; const int Kc = R.K, kbc = R.kb, n0c = R.n0, f8c = R.f8;
        ++n; par ^= 1;
        __syncthreads();
        g = st[8 + slot];
        have = CV_ELIGIBLE(g);
        if (have) { if (t0 && st[6] < st[7]) cl = xb_add(conv_qhead(F, st[6]), 1u); conv_load(F, g, j, R); }
        conv_store(F, tile, WTc, Kc, kbc, n0c, f8c);
        if (have && t0) st[8 + (slot ^ 1)] = conv_claim_finish(F, cl);
        slot ^= 1;
    }
#undef CV_ELIGIBLE
    __syncthreads();
    if (t0) { st[5] = g; st[2] = j; st[3] = par; }
    return n;
}
__device__ __forceinline__ void p_prologue(const Frame& F) {
    conv_init(F);
    const int gw = F.bid * NWAVES + F.wave, NGW = F.G * NWAVES; bf16_t* HB = wsp<bf16_t>(F, WS_HB); ssq_t* ssq0 = (ssq_t*)(F.ctl + CW_SSQ);
    for (int m0 = gw; m0 < MTOK; m0 += 2 * NGW) {
        f32x4 xv[2][8];
#pragma unroll
        for (int u = 0; u < 2; ++u) { const int m = (m0 + u * NGW < MTOK) ? m0 + u * NGW : m0; const GAS f32x4* xr = (const GAS f32x4*)(F.in[0] + (size_t)m * DM) + F.lane;
#pragma unroll
            for (int jj = 0; jj < 8; ++jj) xv[u][jj] = xr[64 * jj]; }
#pragma unroll
        for (int u = 0; u < 2; ++u) { const int m = m0 + u * NGW; if (m >= MTOK) continue; GAS u32x2* o = (GAS u32x2*)(HB + (size_t)m * DM) + F.lane; float q = 0.f;
#pragma unroll
            for (int jj = 0; jj < 8; ++jj) { const f32x4 vv = xv[u][jj]; q += (vv[0] * vv[0] + vv[1] * vv[1]) + (vv[2] * vv[2] + vv[3] * vv[3]); u32x2 w; w.x = pk2(vv[0], vv[1]); w.y = pk2(vv[2], vv[3]); o[64 * jj] = w;
                if (f8_ein(0)) ((GAS unsigned*)(wsp<unsigned char>(F, WS_HB8) + (size_t)m * DM))[64 * jj + F.lane] = pk4_fp8(vv[0], vv[1], vv[2], vv[3]); }
            q = wave_sum(q); if (F.lane == 0) ((GAS ssq_t*)ssq0)[m] = ssq_fix(q); } }
}
#define PP_ACC(s_, v_, op_) do { s_[0] op_ bflo(v_.x); s_[1] op_ bfhi(v_.x); s_[2] op_ bflo(v_.y); s_[3] op_ bfhi(v_.y); s_[4] op_ bflo(v_.z); s_[5] op_ bfhi(v_.z); s_[6] op_ bflo(v_.w); s_[7] op_ bfhi(v_.w); } while (0)
__device__ __forceinline__ void t_pool_p(const Frame& F, const bf16_t* U, bf16_t* PP) {
    const int gw = F.bid * NWAVES + F.wave, NGW = F.G * NWAVES; constexpr int RUN = 16;
    for (int it = gw; it < (MTOK / RUN) * 2; it += NGW) { const int row0 = (it >> 1) * RUN, c0 = (it & 1) * 512 + F.lane * 8, g = c0 >> 8, w = 2 << g, t0 = row0 & (SEQ - 1);
        const GAS u32x4* up = (const GAS u32x4*)(U + (size_t)row0 * 1024 + c0); GAS u32x4* pp = (GAS u32x4*)(PP + (size_t)row0 * 1024 + c0);
        float s[8];
#pragma unroll
        for (int j = 0; j < 8; ++j) s[j] = 0.f;
#pragma unroll
        for (int k = 1; k < 16; ++k) if (k < w && t0 > 0) { const u32x4 v = up[-128 * k]; PP_ACC(s, v, +=); }
#pragma unroll 8
        for (int i = 0; i < RUN; ++i) { const u32x4 v = up[128 * i]; PP_ACC(s, v, +=);
            const int t = t0 + i, cnt = (t + 1) < w ? (t + 1) : w; const float ic = 1.f / (float)cnt;
            u32x4 o; o.x = pk2(s[0] * ic - bflo(v.x), s[1] * ic - bfhi(v.x)); o.y = pk2(s[2] * ic - bflo(v.y), s[3] * ic - bfhi(v.y));
            o.z = pk2(s[4] * ic - bflo(v.z), s[5] * ic - bfhi(v.z)); o.w = pk2(s[6] * ic - bflo(v.w), s[7] * ic - bfhi(v.w));
            pp[128 * i] = o;
            if (t - w + 1 >= 0) { const u32x4 d = up[128 * (i - w + 1)]; PP_ACC(s, d, -=); } }
    }
}
#undef PP_ACC
__device__ __forceinline__ void t_scan(const Frame& F, const bf16_t* LT, bf16_t* VS) {
    for (int gid = F.bid * (NWAVES * 64) + F.tid; gid < 8 * 16384; gid += F.G * NWAVES * 64) {
        const int bh = gid >> 14, rem = gid & 16383, e = rem >> 6, d4 = (rem & 63) * 4, b = bh >> 2, h = bh & 3; const float cd = __builtin_amdgcn_exp2f(lg_gamma(h) * 256.f);
        f32x4 s = (f32x4){0.f, 0.f, 0.f, 0.f};
#pragma unroll
        for (int g = 0; g < 32; ++g) { const size_t unit = (size_t)((b * 32 + g) * 4 + h);
            u32x2 w; w.x = pk2(s[0], s[1]); w.y = pk2(s[2], s[3]); *(GAS u32x2*)(VS + (unit * 256 + e) * 512 + 256 + d4) = w;
            const u32x2 l = *(const GAS u32x2*)(LT + (unit * 256 + e) * 256 + d4); s = s * cd + (f32x4){bflo(l.x), bfhi(l.x), bflo(l.y), bfhi(l.y)}; }
    }
}
__device__ __forceinline__ void t_conv(const Frame& F, const bf16_t* BG, const bf16_t* Z, const float* cw, bf16_t* Y, unsigned char* Y8) {
    const int gw = F.bid * NWAVES + F.wave, NGW = F.G * NWAVES; constexpr int RUN = 32;
    for (int it = gw; it < (MTOK / RUN) * 4; it += NGW) { const int row0 = (it >> 2) * RUN, c0 = (it & 3) * 512 + F.lane * 8, t0 = row0 & (SEQ - 1);
        float w0[8], w1[8], w2[8];
#pragma unroll
        for (int h = 0; h < 2; ++h) { const f32x4 a = *(const GAS f32x4*)(cw + c0 + 4 * h), b = *(const GAS f32x4*)(cw + DM + c0 + 4 * h), c = *(const GAS f32x4*)(cw + 2 * DM + c0 + 4 * h);
#pragma unroll
            for (int j = 0; j < 4; ++j) { w0[4 * h + j] = a[j]; w1[4 * h + j] = b[j]; w2[4 * h + j] = c[j]; } }
        u32x4 z0 = (u32x4){0u, 0u, 0u, 0u}, z1 = z0;
        if (t0 >= 2) { z0 = *(const GAS u32x4*)(Z + (size_t)(row0 - 2) * DM + c0); z1 = *(const GAS u32x4*)(Z + (size_t)(row0 - 1) * DM + c0); }
#pragma unroll 8
        for (int i = 0; i < RUN; ++i) { const size_t off = (size_t)(row0 + i) * DM + c0;
            const u32x4 z2 = *(const GAS u32x4*)(Z + off), bg = *(const GAS u32x4*)(BG + off);
            float o[8];
            o[0] = bflo(bg.x) * (bflo(z0.x) * w0[0] + bflo(z1.x) * w1[0] + bflo(z2.x) * w2[0]); o[1] = bfhi(bg.x) * (bfhi(z0.x) * w0[1] + bfhi(z1.x) * w1[1] + bfhi(z2.x) * w2[1]);
            o[2] = bflo(bg.y) * (bflo(z0.y) * w0[2] + bflo(z1.y) * w1[2] + bflo(z2.y) * w2[2]); o[3] = bfhi(bg.y) * (bfhi(z0.y) * w0[3] + bfhi(z1.y) * w1[3] + bfhi(z2.y) * w2[3]);
            o[4] = bflo(bg.z) * (bflo(z0.z) * w0[4] + bflo(z1.z) * w1[4] + bflo(z2.z) * w2[4]); o[5] = bfhi(bg.z) * (bfhi(z0.z) * w0[5] + bfhi(z1.z) * w1[5] + bfhi(z2.z) * w2[5]);
            o[6] = bflo(bg.w) * (bflo(z0.w) * w0[6] + bflo(z1.w) * w1[6] + bflo(z2.w) * w2[6]); o[7] = bfhi(bg.w) * (bfhi(z0.w) * w0[7] + bfhi(z1.w) * w1[7] + bfhi(z2.w) * w2[7]);
            u32x4 w; w.x = pk2(o[0], o[1]); w.y = pk2(o[2], o[3]); w.z = pk2(o[4], o[5]); w.w = pk2(o[6], o[7]);
            if (!Y8) *(GAS u32x4*)(Y + off) = w;
            z0 = z1; z1 = z2;
            if (Y8) { u32x2 w8; w8.x = pk4_fp8(o[0], o[1], o[2], o[3]); w8.y = pk4_fp8(o[4], o[5], o[6], o[7]); *(GAS u32x2*)(Y8 + off) = w8; } }
    }
}
__device__ __forceinline__ void t_router(const Frame& F, const bf16_t* HB, const ssq_t* ssq, const float* gain, const float* R, unsigned* cntw, int* tok_e, int* tok_pos, int* rowtok, float* er, float* ew) {
    constexpr int RPITCH = 4096 + 16;
    LAS unsigned char* Rh = F.lds + RING_OFF; LAS unsigned char* Rlo = Rh + 8 * RPITCH;
#pragma unroll
    for (int m = 0; m < DM / (NWAVES * 64); ++m) { const int k = F.tid + m * (NWAVES * 64); const f32x4 r0 = *(const GAS f32x4*)(R + (size_t)k * NEXP), r1 = *(const GAS f32x4*)(R + (size_t)k * NEXP + 4); const float gk = ((const GAS float*)gain)[k];
#pragma unroll
        for (int e = 0; e < NEXP; ++e) { const float v = (e < 4 ? r0[e & 3] : r1[e & 3]) * gk;
            const unsigned hi = pk2(v, 0.f) & 0xffffu; const float rem = v - __uint_as_float(hi << 16);
            *(LAS bf16_t*)(Rh + e * RPITCH + k * 2) = (bf16_t)hi; *(LAS bf16_t*)(Rlo + e * RPITCH + k * 2) = (bf16_t)(pk2(rem, 0.f) & 0xffffu); } }
    if (F.tid < NEXP) ((LAS unsigned*)(F.lds + RING_OFF + 16 * RPITCH + 64 + 4096))[F.tid] = 0u;
    __syncthreads();
    const int gw = F.bid * NWAVES + F.wave, NGW = F.G * NWAVES, fr = F.lane & 15, fq = F.lane >> 4, kh = F.wave & 1;
    LAS f32x4* xch = (LAS f32x4*)(F.lds + RING_OFF + 16 * RPITCH + 64) + (F.wave >> 1) * 64 + F.lane;
    LAS unsigned* lcnt = (LAS unsigned*)(F.lds + RING_OFF + 16 * RPITCH + 64 + 4096);
    for (int grp0 = 0; grp0 < MTOK / 16; grp0 += NGW >> 1) { const int grp = grp0 + (gw >> 1); const bool live = grp < MTOK / 16; const int t = (live ? grp : 0) * 16 + fr;
        const GAS bf16x8* hrow = (const GAS bf16x8*)(HB + (size_t)t * DM) + fq + kh * (DM / 16);
        const LAS bf16x8* rh = (const LAS bf16x8*)(Rh + (fr & 7) * RPITCH) + fq + kh * (DM / 16); const LAS bf16x8* rl = (const LAS bf16x8*)(Rlo + (fr & 7) * RPITCH) + fq + kh * (DM / 16);
        f32x4 ah = (f32x4){0.f, 0.f, 0.f, 0.f}, al = ah;
#pragma unroll 16
        for (int s = 0; s < DM / 64; ++s) { const bf16x8 hv = hrow[4 * s];
            ah = __builtin_amdgcn_mfma_f32_16x16x32_bf16(rh[4 * s], hv, ah, 0, 0, 0); al = __builtin_amdgcn_mfma_f32_16x16x32_bf16(rl[4 * s], hv, al, 0, 0, 0); }
        ah = ah + al;
        if (kh) *xch = ah;
        __syncthreads();
        if (!kh) ah = ah + *xch;
        __syncthreads();
        const bool act = !kh && live;
        int e1 = 0, e2 = 1; float w1 = 0.f, w2 = 0.f, r = 0.f;
        if (act) {
            r = rs_of(ssq, t);
            float p[NEXP];
#pragma unroll
            for (int j = 0; j < 4; ++j) { const float mine = ah[j] * r, other = __shfl_xor(mine, 16); p[j] = (fq & 1) ? other : mine; p[4 + j] = (fq & 1) ? mine : other; }
            float v1 = p[0];
#pragma unroll
            for (int e = 1; e < NEXP; ++e) if (p[e] > v1) { v1 = p[e]; e1 = e; }
            e2 = -1; float v2 = -3.0e38f;
#pragma unroll
            for (int e = 0; e < NEXP; ++e) if (e != e1 && p[e] > v2) { v2 = p[e]; e2 = e; }
            const float ex = __builtin_amdgcn_exp2f((v2 - v1) * 1.44269504f); w1 = 1.f / (1.f + ex); w2 = ex * w1;
        }
        unsigned l1 = 0u, l2 = 0u;
        if (act && fq == 0) { l1 = __hip_atomic_fetch_add(lcnt + e1, 1u, __ATOMIC_RELAXED, __HIP_MEMORY_SCOPE_WORKGROUP); l2 = __hip_atomic_fetch_add(lcnt + e2, 1u, __ATOMIC_RELAXED, __HIP_MEMORY_SCOPE_WORKGROUP); }
        __syncthreads();
        if (F.tid < NEXP) { const unsigned c = lcnt[F.tid]; lcnt[NEXP + F.tid] = c ? __hip_atomic_fetch_add((GAS unsigned*)cntw + 64 * F.tid, c, RLX_AGENT) : 0u; lcnt[F.tid] = 0u; }
        __syncthreads();
        if (act && fq == 0) {
            const int p1 = (int)(lcnt[NEXP + e1] + l1), p2 = (int)(lcnt[NEXP + e2] + l2);
            GAS int* te_ = (GAS int*)tok_e; GAS int* tp_ = (GAS int*)tok_pos; GAS int* rt_ = (GAS int*)rowtok; GAS float* er_ = (GAS float*)er; GAS float* ew_ = (GAS float*)ew;
            te_[2 * t] = e1; te_[2 * t + 1] = e2; tp_[2 * t] = p1; tp_[2 * t + 1] = p2;
            if (p1 < ECAP) { rt_[e1 * ECAP + p1] = t; er_[e1 * ECAP + p1] = r; ew_[e1 * ECAP + p1] = w1; }
            if (p2 < ECAP) { rt_[e2 * ECAP + p2] = t; er_[e2 * ECAP + p2] = r; ew_[e2 * ECAP + p2] = w2; } }
    }
    __syncthreads();
}
__device__ __forceinline__ void t_combine(const Frame& F, const bf16_t* HB, bf16_t* HBout, const bf16_t* YC, const unsigned* cntw, const int* tok_e, const int* tok_pos, ssq_t* ssq_next, const float* gfin, float* out, bool final_, unsigned char* HB8) {
    int tp[NEXP + 1]; tp[0] = 0;
    const unsigned cv = load_counts8(cntw);
#pragma unroll
    for (int e = 0; e < NEXP; ++e) { int v = (int)__builtin_amdgcn_readlane(cv, e); v = v < 0 ? 0 : (v > ECAP ? ECAP : v); tp[e + 1] = tp[e] + ((v + 255) >> 8); }
    const int gw = F.bid * NWAVES + F.wave, NGW = F.G * NWAVES;
    for (int t0 = gw; t0 < MTOK; t0 += 2 * NGW) {
        u32x4 rh[2][4], ra[2][4], rb[2][4]; int tt[2]; bool ok[2];
#pragma unroll
        for (int u = 0; u < 2; ++u) { const int tq = t0 + u * NGW; ok[u] = tq < MTOK; const int t = ok[u] ? tq : t0; tt[u] = t;
            const int e1 = ((const GAS int*)tok_e)[2 * t], e2 = ((const GAS int*)tok_e)[2 * t + 1], p1 = ((const GAS int*)tok_pos)[2 * t], p2 = ((const GAS int*)tok_pos)[2 * t + 1]; int b1 = 0, b2 = 0;
#pragma unroll
            for (int k = 1; k < NEXP; ++k) { b1 = (e1 == k) ? tp[k] : b1; b2 = (e2 == k) ? tp[k] : b2; }
            const size_t s1 = (size_t)b1 * 256 + p1, s2 = (size_t)b2 * 256 + p2;
            const GAS u32x4* hr = (const GAS u32x4*)(HB + (size_t)t * DM) + F.lane; const GAS u32x4* y1 = (const GAS u32x4*)(YC + s1 * DM) + F.lane; const GAS u32x4* y2 = (const GAS u32x4*)(YC + s2 * DM) + F.lane;
#pragma unroll
            for (int j = 0; j < 4; ++j) { rh[u][j] = hr[64 * j]; ra[u][j] = y1[64 * j]; rb[u][j] = y2[64 * j]; } }
#pragma unroll
        for (int u = 0; u < 2; ++u) { if (!ok[u]) continue; const int t = tt[u];
            float v[4][8]; float q = 0.f;
#pragma unroll
            for (int j = 0; j < 4; ++j) { const u32x4 h = rh[u][j], a = ra[u][j], b = rb[u][j];
                v[j][0] = bflo(h.x) + (bflo(a.x) + bflo(b.x)); v[j][1] = bfhi(h.x) + (bfhi(a.x) + bfhi(b.x)); v[j][2] = bflo(h.y) + (bflo(a.y) + bflo(b.y)); v[j][3] = bfhi(h.y) + (bfhi(a.y) + bfhi(b.y));
                v[j][4] = bflo(h.z) + (bflo(a.z) + bflo(b.z)); v[j][5] = bfhi(h.z) + (bfhi(a.z) + bfhi(b.z)); v[j][6] = bflo(h.w) + (bflo(a.w) + bflo(b.w)); v[j][7] = bfhi(h.w) + (bfhi(a.w) + bfhi(b.w));
#pragma unroll
                for (int i = 0; i < 8; ++i) q += v[j][i] * v[j][i]; }
            q = wave_sum(q);
            if (!final_) { GAS u32x4* o = (GAS u32x4*)(HBout + (size_t)t * DM) + F.lane;
#pragma unroll
                for (int j = 0; j < 4; ++j) { u32x4 w; w.x = pk2(v[j][0], v[j][1]); w.y = pk2(v[j][2], v[j][3]); w.z = pk2(v[j][4], v[j][5]); w.w = pk2(v[j][6], v[j][7]); o[64 * j] = w;
                    if (HB8) { u32x2 w8; w8.x = pk4_fp8(v[j][0], v[j][1], v[j][2], v[j][3]); w8.y = pk4_fp8(v[j][4], v[j][5], v[j][6], v[j][7]); ((GAS u32x2*)(HB8 + (size_t)t * DM))[64 * j + F.lane] = w8; } }
                if (F.lane == 0) ((GAS ssq_t*)ssq_next)[t] = ssq_fix(q);
            } else { const float r = __builtin_amdgcn_rsqf(q * (1.f / (float)DM) + RMS_EPS); GAS f32x4* o = (GAS f32x4*)(out + (size_t)t * DM) + 2 * F.lane; const GAS f32x4* gg = (const GAS f32x4*)gfin + 2 * F.lane;
#pragma unroll
                for (int j = 0; j < 4; ++j) { const f32x4 g0 = gg[128 * j], g1 = gg[128 * j + 1];
                    o[128 * j] = (f32x4){v[j][0] * r * g0[0], v[j][1] * r * g0[1], v[j][2] * r * g0[2], v[j][3] * r * g0[3]}; o[128 * j + 1] = (f32x4){v[j][4] * r * g1[0], v[j][5] * r * g1[1], v[j][6] * r * g1[2], v[j][7] * r * g1[3]}; } } }
    }
}

constexpr int N_PHASES = 29;
struct Args { const float* in[16]; float* out; unsigned char* ws; int ph_lo, ph_hi; };
__global__ void __launch_bounds__(NWAVES * 64, 2) fwd_kernel(Args args) {
    extern __shared__ __attribute__((aligned(16))) unsigned char lds_raw[];
    Frame F;
    F.lds = (LAS unsigned char*)lds_raw;
    F.MISC = (volatile LAS unsigned*)(F.lds + MISC_OFF);
    F.tid = threadIdx.x; F.lane = F.tid & 63; F.wave = __builtin_amdgcn_readfirstlane(F.tid >> 6);
    F.G = gridDim.x; F.bid = blockIdx.x;
    F.ws = args.ws; F.ctl = (gu32*)(args.ws + WS_CTL); F.in = args.in;
    for (int u = F.tid; u < (LDS_BYTES - LDSCTL_OFF) / 4; u += NWAVES * 64) ((LAS unsigned*)(F.lds + LDSCTL_OFF))[u] = 0u;
    __syncthreads();
    XcdBarrier bar; bar.bar = (unsigned*)(F.ctl + CW_BAR); bar.x = 0; bar.st = nullptr;
#if MK_ONE_LAUNCH
    bar = xcd_barrier_post((unsigned*)(F.ctl + CW_BAR), F.MISC + 8);
#endif
    const int lo = args.ph_lo, hi = args.ph_hi;
#ifndef MK_KIND_MASK
#define MK_KIND_MASK 0x7fff
#endif
#define KON(kind) (((MK_KIND_MASK) >> (kind)) & 1)
#ifndef MK_DUP_MASK
#define MK_DUP_MASK 0
#endif
#define NREP(kind) ((((MK_DUP_MASK) >> (kind)) & 1) ? 2 : 1)
#ifndef MK_DUP_BAR
#define MK_DUP_BAR 0
#endif
#define DUMMY(kind) (NREP(kind) == 2 && rep_ == 0)
#define IN(k) (lo <= (k) && (k) < hi)
#if MK_ONE_LAUNCH
#ifndef MK_BAR_REP
#define MK_BAR_REP 1
#endif
#define SEAM(k) do { if (IN(k) && IN((k) + 1)) { (void)conv_run(F, (k) + 1, cv_extra); cv_extra = 0; xcd_barrier(bar); } } while (0)
#else
#define SEAM(k) do { } while (0)
#endif
    LAS unsigned char* ring = F.lds + RING_OFF;
    int cv_extra = 0;
#define PH_WS() unsigned char* ws_ = args.ws; asm volatile("" : "+s"(ws_)); Frame Fp = F; { int t_ = threadIdx.x; asm volatile("" : "+v"(t_)); Fp.tid = t_; Fp.lane = t_ & 63; Fp.wave = __builtin_amdgcn_readfirstlane(t_ >> 6); int g_ = gridDim.x, b_ = blockIdx.x; asm volatile("" : "+s"(g_), "+s"(b_)); Fp.G = g_; Fp.bid = b_; } Fp.ws = ws_; Fp.ctl = (gu32*)(ws_ + WS_CTL); ssq_t* ssq = (ssq_t*)(Fp.ctl + CW_SSQ); (void)ssq
#define WSP(T, off) ((T*)(ws_ + (off)))
#define F8_DISPATCH(flagfn, ...) do { if constexpr (flagfn(0) == flagfn(1)) { constexpr bool F8 = flagfn(0); __VA_ARGS__ } else { if (flagfn(lp)) { constexpr bool F8 = true; __VA_ARGS__ } else { constexpr bool F8 = false; __VA_ARGS__ } } } while (0)

    if (KON(0) && IN(0)) for (int rep_ = 0; rep_ < NREP(0); ++rep_) { if (MK_DUP_BAR && rep_ == 1) { asm volatile("" ::: "memory"); xcd_barrier(bar); asm volatile("" ::: "memory"); } PH_WS(); p_prologue(Fp); } SEAM(0);

    for (int lp = 0; lp < 2; ++lp) {
        const int pb = 1 + lp * 14, a0 = lp * 4;
        if (KON(1) && IN(pb + 0)) for (int rep_ = 0; rep_ < NREP(1); ++rep_) { if (MK_DUP_BAR && rep_ == 1) { asm volatile("" ::: "memory"); xcd_barrier(bar); asm volatile("" ::: "memory"); } PH_WS();
            F8_DISPATCH(f8_ein, { constexpr int ES = F8 ? 1 : 2; constexpr float SC = F8 ? GU8_UNSCALE : 1.f;
                const char* EWIN = WSP(char, WS_EWIN) + (size_t)lp * EIN * DM * 2; const char* HBA = F8 ? WSP(char, WS_HB8) : WSP(char, WS_HB);
                { const pg8::GridOrder S = pg8::grid_order(64, 16, Fp.G, Fp.bid, HBA, 256L * DM * ES, 0, EWIN, 0, 256L * DM * ES, 12, 4);
                  const EpiEvenIn E{ssq + (size_t)a0 * MTOK, WSP(bf16_t, WS_U), WSP(bf16_t, WS_QP), WSP(bf16_t, WS_KN), WSP(bf16_t, WS_KT), WSP(bf16_t, WS_SG), SC};
                  pg8::gemm_phase<EpiEvenIn, pg8::GridOrder, true, F8>(ring, DM, DM, DM, S, E); }
                { const pg8::GridOrder S = pg8::grid_order(4, 64, Fp.G, Fp.bid, EWIN + (size_t)3072 * DM * ES, 256L * DM * ES, 0, HBA, 0, 256L * DM * ES);
                  const EpiVt E{ssq + (size_t)a0 * MTOK, WSP(bf16_t, WS_VS), SC};
                  pg8::gemm_phase<EpiVt, pg8::GridOrder, true, F8>(ring, DM, DM, DM, S, E); } });
        } SEAM(pb + 0);
        if (KON(2) && IN(pb + 1)) for (int rep_ = 0; rep_ < NREP(2); ++rep_) { if (MK_DUP_BAR && rep_ == 1) { asm volatile("" ::: "memory"); xcd_barrier(bar); asm volatile("" ::: "memory"); } PH_WS();
            t_pool_p(Fp, WSP(bf16_t, WS_U), WSP(bf16_t, WS_PP));
            { const pg8::GridOrder S = pg8::grid_order(64, 4, Fp.G, Fp.bid, WSP(bf16_t, WS_VS), 4L * 256 * 512 * 2, 256L * 512 * 2, WSP(bf16_t, WS_KT), 4L * 65536 * 2, 65536L * 2);
              const EpiBf16Unit E{WSP(bf16_t, WS_LT)};
              pg8::gemm_phase(ring, 256, 512, 256, S, E); }
        } SEAM(pb + 1);
        if (KON(3) && IN(pb + 2)) for (int rep_ = 0; rep_ < NREP(3); ++rep_) { if (MK_DUP_BAR && rep_ == 1) { asm volatile("" ::: "memory"); xcd_barrier(bar); asm volatile("" ::: "memory"); } PH_WS();
            t_scan(Fp, WSP(bf16_t, WS_LT), WSP(bf16_t, WS_VS));
            { const pg8::GridOrder S = pg8::grid_order(64, 4, Fp.G, Fp.bid, WSP(bf16_t, WS_PP), 256L * 1024 * 2, 256 * 2, WSP(bf16_t, WS_EWP) + (size_t)lp * 4 * 65536, 0, 65536L * 2);
              const EpiBf16Plain E{WSP(bf16_t, WS_YCAT), 2048, f8_eout(lp) ? WSP(unsigned char, WS_Y8) : (unsigned char*)nullptr};
              pg8::gemm_phase(ring, 256, 1024, 256, S, E); }
            { bf16_t* QP = WSP(bf16_t, WS_QP);
              const pg8::GridOrder S = pg8::grid_order(64, 4, Fp.G, Fp.bid, QP + 256, 256L * 2048 * 2, 512 * 2, WSP(bf16_t, WS_KN), 256L * 1024 * 2, 256 * 2);
              const EpiQK E{QP};
              pg8::gemm_phase(ring, 256, 2048, 1024, S, E); }
        } SEAM(pb + 2);
        if (KON(4) && IN(pb + 3)) for (int rep_ = 0; rep_ < NREP(4); ++rep_) { if (MK_DUP_BAR && rep_ == 1) { asm volatile("" ::: "memory"); xcd_barrier(bar); asm volatile("" ::: "memory"); } PH_WS();
            const pg8::GridOrder S = pg8::grid_order(64, 4, Fp.G, Fp.bid, WSP(bf16_t, WS_QP), 256L * 2048 * 2, 512 * 2, WSP(bf16_t, WS_VS), 4L * 256 * 512 * 2, 256L * 512 * 2);
            const EpiRetOut E{WSP(bf16_t, WS_SG), WSP(bf16_t, WS_YCAT), f8_eout(lp) ? WSP(unsigned char, WS_Y8) : (unsigned char*)nullptr};
            pg8::gemm_phase(ring, 512, 2048, 512, S, E);
        } SEAM(pb + 3);
        if (KON(5) && IN(pb + 4)) for (int rep_ = 0; rep_ < NREP(5); ++rep_) { PH_WS();
            F8_DISPATCH(f8_eout, { constexpr int ES = F8 ? 1 : 2; constexpr bool F8W = F8;
                const pg8::GridOrder S = pg8::grid_order(64, 8, Fp.G, Fp.bid, F8W ? WSP(char, WS_Y8) : WSP(char, WS_YCAT), 256L * DM * ES, 0, WSP(char, WS_EWOUT) + (size_t)lp * DM * DM * 2, 0, 256L * DM * ES);
                if (f8_ffn(lp)) { const EpiResidual<true> E{WSP(bf16_t, WS_HB), DUMMY(5) ? WSP(bf16_t, WS_ACTM) : WSP(bf16_t, WS_HB), ssq + (size_t)(DUMMY(5) ? 8 : a0 + 1) * MTOK, F8W ? GU8_UNSCALE : 1.f, WSP(unsigned char, WS_HB8)};
                    pg8::gemm_phase<EpiResidual<true>, pg8::GridOrder, true, F8W>(ring, DM, DM, DM, S, E); }
                else { const EpiResidual<false> E{WSP(bf16_t, WS_HB), DUMMY(5) ? WSP(bf16_t, WS_ACTM) : WSP(bf16_t, WS_HB), ssq + (size_t)(DUMMY(5) ? 8 : a0 + 1) * MTOK, F8W ? GU8_UNSCALE : 1.f, nullptr};
                    pg8::gemm_phase<EpiResidual<false>, pg8::GridOrder, true, F8W>(ring, DM, DM, DM, S, E); } });
        } SEAM(pb + 4);
        if (KON(6) && IN(pb + 5)) for (int rep_ = 0; rep_ < NREP(6); ++rep_) { if (MK_DUP_BAR && rep_ == 1) { asm volatile("" ::: "memory"); xcd_barrier(bar); asm volatile("" ::: "memory"); } PH_WS();
            F8_DISPATCH(f8_ffn, { constexpr int ES = F8 ? 1 : 2;
                const pg8::GridOrder S = pg8::grid_order(64, 44, Fp.G, Fp.bid, F8 ? WSP(char, WS_HB8) : WSP(char, WS_HB), 256L * DM * ES, 0, WSP(char, WS_FGU) + (size_t)lp * 2 * FFN * DM * 2, 0, 256L * DM * ES);
                if (f8_dn(lp)) { const EpiSwiGLU<F8, true> E{ssq + (size_t)(a0 + 1) * MTOK, WSP(void, WS_ACT), FFN}; pg8::gemm_phase<EpiSwiGLU<F8, true>, pg8::GridOrder, true, F8>(ring, DM, DM, DM, S, E); }
                else { const EpiSwiGLU<F8, false> E{ssq + (size_t)(a0 + 1) * MTOK, WSP(void, WS_ACT), FFN}; pg8::gemm_phase<EpiSwiGLU<F8, false>, pg8::GridOrder, true, F8>(ring, DM, DM, DM, S, E); } });
        } SEAM(pb + 5);
        if (KON(7) && IN(pb + 6)) for (int rep_ = 0; rep_ < NREP(7); ++rep_) { if (MK_DUP_BAR && rep_ == 1) { asm volatile("" ::: "memory"); xcd_barrier(bar); asm volatile("" ::: "memory"); } PH_WS();
            F8_DISPATCH(f8_dn, { constexpr int ES = F8 ? 1 : 2; constexpr bool F8IN = F8;
                const pg8::GridOrder S = pg8::grid_order(64, 8, Fp.G, Fp.bid, WSP(char, WS_ACT), 256L * FFN * ES, 0, WSP(char, WS_FDN) + (size_t)lp * DM * FFN * 2, 0, 256L * FFN * ES);
                if (f8_oin(lp) && !DUMMY(7)) { const EpiResidual<true> E{WSP(bf16_t, WS_HB), WSP(bf16_t, WS_HB), ssq + (size_t)(a0 + 2) * MTOK, F8IN ? DN8_UNSCALE : 1.f, WSP(unsigned char, WS_HB8)};
                    pg8::gemm_phase<EpiResidual<true>, pg8::GridOrder, true, F8IN>(ring, FFN, FFN, FFN, S, E); }
                else { const EpiResidual<false> E{WSP(bf16_t, WS_HB), DUMMY(7) ? WSP(bf16_t, WS_ACTM) : WSP(bf16_t, WS_HB), ssq + (size_t)(DUMMY(7) ? 8 : a0 + 2) * MTOK, F8IN ? DN8_UNSCALE : 1.f, nullptr};
                    pg8::gemm_phase<EpiResidual<false>, pg8::GridOrder, true, F8IN>(ring, FFN, FFN, FFN, S, E); } });
        } SEAM(pb + 6);
        if (KON(8) && IN(pb + 7)) for (int rep_ = 0; rep_ < NREP(8); ++rep_) { if (MK_DUP_BAR && rep_ == 1) { asm volatile("" ::: "memory"); xcd_barrier(bar); asm volatile("" ::: "memory"); } PH_WS();
            F8_DISPATCH(f8_oin, { constexpr int ES = F8 ? 1 : 2;
                const pg8::GridOrder S = pg8::grid_order(64, 24, Fp.G, Fp.bid, F8 ? WSP(char, WS_HB8) : WSP(char, WS_HB), 256L * DM * ES, 0, WSP(char, WS_OWIN) + (size_t)lp * OIN * DM * 2, 0, 256L * DM * ES);
                const EpiOddIn E{ssq + (size_t)(a0 + 2) * MTOK, WSP(bf16_t, WS_BG), WSP(bf16_t, WS_Z), F8 ? GU8_UNSCALE : 1.f};
                pg8::gemm_phase<EpiOddIn, pg8::GridOrder, true, F8>(ring, DM, DM, DM, S, E); });
        } SEAM(pb + 7);
        if (KON(9) && IN(pb + 8)) for (int rep_ = 0; rep_ < NREP(9); ++rep_) { if (MK_DUP_BAR && rep_ == 1) { asm volatile("" ::: "memory"); xcd_barrier(bar); asm volatile("" ::: "memory"); } PH_WS(); t_conv(Fp, WSP(bf16_t, WS_BG), WSP(bf16_t, WS_Z), args.in[9] + (size_t)lp * 3 * DM, WSP(bf16_t, WS_YCAT), f8_oout(lp) ? WSP(unsigned char, WS_Y8) : (unsigned char*)nullptr); } SEAM(pb + 8);
        if (KON(10) && IN(pb + 9)) for (int rep_ = 0; rep_ < NREP(10); ++rep_) { PH_WS();
            F8_DISPATCH(f8_oout, { constexpr int ES = F8 ? 1 : 2; constexpr bool F8W = F8;
                const pg8::GridOrder S = pg8::grid_order(64, 8, Fp.G, Fp.bid, F8W ? WSP(char, WS_Y8) : WSP(char, WS_YCAT), 256L * DM * ES, 0, WSP(char, WS_OWOUT) + (size_t)lp * DM * DM * 2, 0, 256L * DM * ES);
                if (f8_moe(lp)) { const EpiResidual<true> E{WSP(bf16_t, WS_HB), DUMMY(10) ? WSP(bf16_t, WS_ACTM) : WSP(bf16_t, WS_HB), ssq + (size_t)(DUMMY(10) ? 8 : a0 + 3) * MTOK, F8W ? GU8_UNSCALE : 1.f, WSP(unsigned char, WS_HB8)};
                    pg8::gemm_phase<EpiResidual<true>, pg8::GridOrder, true, F8W>(ring, DM, DM, DM, S, E); }
                else { const EpiResidual<false> E{WSP(bf16_t, WS_HB), DUMMY(10) ? WSP(bf16_t, WS_ACTM) : WSP(bf16_t, WS_HB), ssq + (size_t)(DUMMY(10) ? 8 : a0 + 3) * MTOK, F8W ? GU8_UNSCALE : 1.f, nullptr};
                    pg8::gemm_phase<EpiResidual<false>, pg8::GridOrder, true, F8W>(ring, DM, DM, DM, S, E); } });
        } SEAM(pb + 9);
        if (KON(11) && IN(pb + 10)) for (int rep_ = 0; rep_ < NREP(11); ++rep_) { if (MK_DUP_BAR && rep_ == 1) { asm volatile("" ::: "memory"); xcd_barrier(bar); asm volatile("" ::: "memory"); } PH_WS(); const size_t dmy_ = DUMMY(11) ? 2 * MiB : 0;
            t_router(Fp, WSP(bf16_t, WS_HB), ssq + (size_t)(a0 + 3) * MTOK, args.in[2] + (2 * lp + 1) * DM, args.in[13] + (size_t)lp * DM * NEXP, (unsigned*)(Fp.ctl + CW_CNT + (DUMMY(11) ? 2 + lp : lp) * NEXP * 64),
                     WSP(int, WS_MISC + MS_TOKE + dmy_), WSP(int, WS_MISC + MS_TOKP + dmy_), WSP(int, WS_MISC + MS_ROWTOK + dmy_), WSP(float, WS_MISC + MS_ER + dmy_), WSP(float, WS_MISC + MS_EW + dmy_)); } SEAM(pb + 10);
        if (KON(12) && IN(pb + 11)) for (int rep_ = 0; rep_ < NREP(12); ++rep_) { if (MK_DUP_BAR && rep_ == 1) { asm volatile("" ::: "memory"); xcd_barrier(bar); asm volatile("" ::: "memory"); } PH_WS();
            F8_DISPATCH(f8_moe, { constexpr int ES = F8 ? 1 : 2;
                MoeOrder<true> S; S.init((unsigned*)(Fp.ctl + CW_CNT + lp * NEXP * 64), 22, Fp.G, Fp.bid); S.A0 = F8 ? WSP(char, WS_HB8) : WSP(char, WS_HB); S.B0 = WSP(char, WS_MGU) + (size_t)lp * NEXP * 2 * EXD * DM * 2;
                S.a_rt = 0; S.b_e = 2L * EXD * DM * 2; S.b_sn = 256L * DM * ES; S.rowtok = WSP(int, WS_MISC + MS_ROWTOK); S.row_bytes = DM * ES;
                const EpiMoeGU<F8> E{WSP(float, WS_MISC + MS_ER), WSP(void, WS_ACTM)};
                pg8::gemm_phase<EpiMoeGU<F8>, MoeOrder<true>, true, F8>(ring, DM, DM, DM, S, E); });
        } SEAM(pb + 11);
        if (KON(13) && IN(pb + 12)) for (int rep_ = 0; rep_ < NREP(13); ++rep_) { if (MK_DUP_BAR && rep_ == 1) { asm volatile("" ::: "memory"); xcd_barrier(bar); asm volatile("" ::: "memory"); } PH_WS();
            F8_DISPATCH(f8_moe, { constexpr int ES = F8 ? 1 : 2;
                MoeOrder<false> S; S.init((unsigned*)(Fp.ctl + CW_CNT + lp * NEXP * 64), 8, Fp.G, Fp.bid); S.A0 = WSP(char, WS_ACTM); S.B0 = WSP(char, WS_MDN) + (size_t)lp * NEXP * DM * EXD * 2;
                S.a_rt = 256L * EXD * ES; S.b_e = (long)DM * EXD * 2; S.b_sn = 256L * EXD * ES; S.rowtok = nullptr; S.row_bytes = 0;
                const EpiMoeDown E{WSP(float, WS_MISC + MS_EW), WSP(bf16_t, WS_YC), F8 ? DN8_UNSCALE : 1.f};
                pg8::gemm_phase<EpiMoeDown, MoeOrder<false>, true, F8>(ring, EXD, EXD, EXD, S, E);
                { const int total = S.tp[NEXP] * 8, maxr = (total + Fp.G - 1) / Fp.G; if ((long)(maxr - 1) * Fp.G + Fp.bid >= total) cv_extra = MK_STEAL_N; } });
        } SEAM(pb + 12);
        if (KON(14) && IN(pb + 13)) for (int rep_ = 0; rep_ < NREP(14); ++rep_) { if (MK_DUP_BAR && rep_ == 1) { asm volatile("" ::: "memory"); xcd_barrier(bar); asm volatile("" ::: "memory"); } PH_WS();
            t_combine(Fp, WSP(bf16_t, WS_HB), DUMMY(14) ? WSP(bf16_t, WS_ACTM) : WSP(bf16_t, WS_HB), WSP(bf16_t, WS_YC), (unsigned*)(Fp.ctl + CW_CNT + lp * NEXP * 64), WSP(int, WS_MISC + MS_TOKE), WSP(int, WS_MISC + MS_TOKP), ssq + (size_t)(DUMMY(14) ? 8 : a0 + 4) * MTOK, args.in[3], DUMMY(14) ? WSP(float, WS_BG) : args.out, lp == 1, (lp == 0 && f8_ein(1) && !DUMMY(14)) ? WSP(unsigned char, WS_HB8) : (unsigned char*)nullptr); } SEAM(pb + 13);
    }
#undef PH_WS
#undef WSP
#undef F8_DISPATCH
#undef IN
#undef SEAM
}

extern "C" void kernel_launch(void* const* d_in, const int* in_sizes, int n_in, void* d_out, int out_size, void* d_ws, size_t ws_size, hipStream_t stream) {
    static int grid = 0;
    if (grid == 0) {
        if (n_in != 16 || in_sizes[0] != MTOK * DM || out_size != MTOK * DM || ws_size < WS_END) { fprintf(stderr, "kernel_launch: unexpected shapes / workspace (n_in %d, in0 %d, out %d, ws %zu < %zu); nothing launched\n", n_in, n_in > 0 ? in_sizes[0] : -1, out_size, ws_size, (size_t)WS_END); grid = -1; return; }
        int dev = 0, cus = 0, per_cu = 0;
        if (hipGetDevice(&dev) != hipSuccess || hipDeviceGetAttribute(&cus, hipDeviceAttributeMultiprocessorCount, dev) != hipSuccess) { fprintf(stderr, "kernel_launch: device query failed\n"); grid = -1; return; }
        if (hipFuncSetAttribute((const void*)fwd_kernel, hipFuncAttributeMaxDynamicSharedMemorySize, LDS_BYTES) != hipSuccess) { fprintf(stderr, "kernel_launch: hipFuncSetAttribute failed\n"); grid = -1; return; }
        if (hipOccupancyMaxActiveBlocksPerMultiprocessor(&per_cu, (const void*)fwd_kernel, NWAVES * 64, LDS_BYTES) != hipSuccess || per_cu < 1) { fprintf(stderr, "kernel_launch: occupancy query reports %d blocks per CU; nothing launched\n", per_cu); (void)hipGetLastError(); grid = -1; return; }
        if (cus != 256) { fprintf(stderr, "kernel_launch: built for a 256-CU device, found %d CUs; nothing launched\n", cus); grid = -1; return; }
        grid = cus;
    }
    if (grid < 0) return;
    if (hipMemsetAsync((char*)d_ws + WS_CTL, 0, CTL_ZERO_BYTES, stream) != hipSuccess) { fprintf(stderr, "kernel_launch: memset failed\n"); return; }
    Args a{};
    for (int i = 0; i < 16; ++i) a.in[i] = (const float*)d_in[i];
    a.out = (float*)d_out; a.ws = (unsigned char*)d_ws;
#if MK_ONE_LAUNCH
    a.ph_lo = 0; a.ph_hi = N_PHASES;
    hipLaunchKernelGGL(fwd_kernel, dim3(grid), dim3(NWAVES * 64), LDS_BYTES, stream, a);
#else
    for (int p = 0; p < N_PHASES; ++p) { a.ph_lo = p; a.ph_hi = p + 1; hipLaunchKernelGGL(fwd_kernel, dim3(grid), dim3(NWAVES * 64), LDS_BYTES, stream, a); }
#endif
    const hipError_t le = hipPeekAtLastError();
    if (le != hipSuccess) fprintf(stderr, "kernel_launch: launch failed: %s\n", hipGetErrorName(le));
}
```
